# Optimizing an MI355X kernel written in HIP

```python
import jax, jax.numpy as jnp
from jax import lax
import numpy as np

D_MODEL = 2048
BATCH = 8
SEQ = 2048
DEPTH = 1

CHUNK = 64
EPS = 1e-6
CONV_WIDTH = D_MODEL // 2
CONV_K = 3
GLA_HEADS = 4
GLA_DK = D_MODEL // 16
GLA_DV = D_MODEL // 8
GLA_LOWRANK = 16
GLA_TAU = 16.0
N_EXPERTS = 32
TOP_K = 4
D_FF = D_MODEL
SWIGLU_LIMIT = 7.0
SWIGLU_ALPHA = 1.702
EXPERT_BLOCK = 128

SPLIT_SIZES = (
    CONV_WIDTH,
    CONV_WIDTH,
    CONV_WIDTH,
    GLA_HEADS * GLA_DK,
    GLA_HEADS * GLA_DK,
    GLA_HEADS * GLA_DV,
    GLA_HEADS * GLA_DV,
    GLA_LOWRANK,
    D_MODEL,
    D_MODEL,
)
SPLIT_IDX = tuple(int(i) for i in np.cumsum(SPLIT_SIZES)[:-1])
D_IN_PROJ = int(sum(SPLIT_SIZES))

kernel_name = "hybrid_conv_gla_moe_block"


def rms_norm(x, g):
    xf = x.astype(jnp.float32)
    y = xf * lax.rsqrt(jnp.mean(xf * xf, axis=-1, keepdims=True) + EPS)
    return (y * g.astype(jnp.float32)).astype(x.dtype)


def short_gated_conv(u_c, u_b, u_x, conv_w, conv_b):
    y = u_c * u_x
    t = y.shape[1]
    yp = jnp.pad(y, ((0, 0), (CONV_K - 1, 0), (0, 0)))
    z = conv_b + sum(yp[:, j:j + t] * conv_w[j] for j in range(CONV_K))
    return u_b * z


def chunk_causal_gla(q, k, v, r, a_low, w_a2, b_a, norm_g):
    out_dtype = q.dtype
    bn, t = q.shape[:2]
    nc = t // CHUNK
    f32 = jnp.float32
    shp_k = (bn, nc, CHUNK, GLA_HEADS, GLA_DK)
    shp_v = (bn, nc, CHUNK, GLA_HEADS, GLA_DV)
    q = q.astype(f32).reshape(shp_k) * (GLA_DK ** -0.5)
    k = k.astype(f32).reshape(shp_k)
    v = v.astype(f32).reshape(shp_v)
    log_a = jax.nn.log_sigmoid((a_low @ w_a2 + b_a).astype(f32)) / GLA_TAU
    log_a = log_a.reshape(shp_k)
    bcum = jnp.cumsum(log_a, axis=2)
    a_end = bcum[:, :, -1]
    k_t = k * jnp.exp(a_end[:, :, None] - bcum)
    q_i = q * jnp.exp(a_end)[:, :, None]
    scores = jnp.einsum('bclhk,bcshk->bchls', q, k_t)
    o_intra = jnp.einsum('bchls,bcshv->bclhv', scores, v)

    def step(state, inp):
        qc, kc, vc, dc = inp
        o = jnp.einsum('blhk,bhkv->blhv', qc, state)
        state = jnp.exp(dc)[..., None] * state + jnp.einsum('blhk,blhv->bhkv', kc, vc)
        return state, o

    xs = (jnp.moveaxis(q_i, 1, 0), jnp.moveaxis(k_t, 1, 0),
          jnp.moveaxis(v, 1, 0), jnp.moveaxis(a_end, 1, 0))
    s0 = jnp.zeros((bn, GLA_HEADS, GLA_DK, GLA_DV), f32)
    _, o_inter = lax.scan(step, s0, xs)
    o = (o_intra + jnp.moveaxis(o_inter, 0, 1)).reshape(bn, t, GLA_HEADS, GLA_DV)
    o = o * lax.rsqrt(jnp.mean(o * o, axis=-1, keepdims=True) + EPS) * norm_g.astype(f32)
    o = o * jax.nn.silu(r.astype(f32)).reshape(bn, t, GLA_HEADS, GLA_DV)
    return o.reshape(bn, t, GLA_HEADS * GLA_DV).astype(out_dtype)


def moe_ffn(xt, w_router, b_router, w_gate_up, b_gate_up, w_down, b_down):
    n, d = xt.shape
    nk = n * TOP_K
    logits = (xt @ w_router + b_router).astype(jnp.float32)
    top_v, top_i = lax.top_k(logits, TOP_K)
    top_w = jax.nn.softmax(top_v, axis=-1)
    e_flat = top_i.reshape(-1)
    tok_flat = jnp.arange(nk, dtype=jnp.int32) // TOP_K
    w_flat = top_w.reshape(-1)

    order = jnp.argsort(e_flat)
    sorted_e = e_flat[order]
    counts = jnp.bincount(e_flat, length=N_EXPERTS)
    start = jnp.cumsum(counts) - counts
    padded = ((counts + EXPERT_BLOCK - 1) // EXPERT_BLOCK) * EXPERT_BLOCK
    pad_end = jnp.cumsum(padded)
    pad_start = pad_end - padded
    rank = jnp.arange(nk, dtype=jnp.int32) - start[sorted_e]
    dest = pad_start[sorted_e] + rank

    n_slots = nk + N_EXPERTS * EXPERT_BLOCK
    n_blocks = n_slots // EXPERT_BLOCK
    slot_tok = jnp.full((n_slots,), n, dtype=jnp.int32).at[dest].set(tok_flat[order])
    slot_w = jnp.zeros((n_slots,), jnp.float32).at[dest].set(w_flat[order])
    block_start = jnp.arange(n_blocks, dtype=jnp.int32) * EXPERT_BLOCK
    block_e = jnp.minimum(jnp.searchsorted(pad_end, block_start, side='right'), N_EXPERTS - 1)

    x_pad = jnp.concatenate([xt, jnp.zeros((1, d), xt.dtype)], axis=0)
    xb = x_pad[slot_tok].reshape(n_blocks, EXPERT_BLOCK, d)

    def expert_block(args):
        xblk, e = args
        gu = xblk @ w_gate_up[e] + b_gate_up[e]
        gate = jnp.minimum(gu[:, :D_FF], SWIGLU_LIMIT)
        up = jnp.clip(gu[:, D_FF:], -SWIGLU_LIMIT, SWIGLU_LIMIT)
        glu = gate * jax.nn.sigmoid(SWIGLU_ALPHA * gate)
        return ((up + 1.0) * glu) @ w_down[e] + b_down[e]

    yb = lax.map(expert_block, (xb, block_e))
    y_slots = yb.reshape(n_slots, d) * slot_w[:, None].astype(yb.dtype)
    return jax.ops.segment_sum(y_slots, slot_tok, num_segments=n + 1)[:n]


def setup_inputs(seed: int = 0) -> dict:
    key = jax.random.key(seed)
    ks = jax.random.split(key, 20)

    def nrm(k, shape, scale):
        return jax.random.normal(k, shape, jnp.float32) * scale

    L = DEPTH
    return {
        "x": nrm(ks[0], (BATCH, SEQ, D_MODEL), 1.0),
        "norm_mix_g": 1.0 + nrm(ks[1], (L, D_MODEL), 0.02),
        "w_in": nrm(ks[2], (L, D_MODEL, D_IN_PROJ), D_MODEL ** -0.5),
        "conv_w": nrm(ks[3], (L, CONV_K, CONV_WIDTH), CONV_K ** -0.5),
        "conv_b": nrm(ks[4], (L, CONV_WIDTH), 0.01),
        "w_a2": nrm(ks[5], (L, GLA_LOWRANK, GLA_HEADS * GLA_DK), GLA_LOWRANK ** -0.5),
        "b_a": nrm(ks[6], (L, GLA_HEADS * GLA_DK), 0.1),
        "gla_norm_g": 1.0 + nrm(ks[7], (L, GLA_HEADS, GLA_DV), 0.02),
        "w_br_a": nrm(ks[8], (L, CONV_WIDTH, D_MODEL), CONV_WIDTH ** -0.5),
        "w_br_b": nrm(ks[9], (L, GLA_HEADS * GLA_DV, D_MODEL), (GLA_HEADS * GLA_DV) ** -0.5),
        "w_out": nrm(ks[10], (L, D_MODEL, D_MODEL), D_MODEL ** -0.5),
        "norm_ffn_g": 1.0 + nrm(ks[11], (L, D_MODEL), 0.02),
        "w_router": nrm(ks[12], (L, D_MODEL, N_EXPERTS), D_MODEL ** -0.5),
        "b_router": nrm(ks[13], (L, N_EXPERTS), 0.01),
        "w_gate_up": nrm(ks[14], (L, N_EXPERTS, D_MODEL, 2 * D_FF), D_MODEL ** -0.5),
        "b_gate_up": nrm(ks[15], (L, N_EXPERTS, 2 * D_FF), 0.01),
        "w_down": nrm(ks[16], (L, N_EXPERTS, D_FF, D_MODEL), D_FF ** -0.5),
        "b_down": nrm(ks[17], (L, N_EXPERTS, D_MODEL), 0.01),
        "norm_final_g": 1.0 + nrm(ks[18], (D_MODEL,), 0.02),
    }


def reference(x, norm_mix_g, w_in, conv_w, conv_b, w_a2, b_a, gla_norm_g, w_br_a, w_br_b,
              w_out, norm_ffn_g, w_router, b_router, w_gate_up, b_gate_up, w_down, b_down,
              norm_final_g):
    bn, t, d = x.shape
    for l in range(DEPTH):
        h = rms_norm(x, norm_mix_g[l])
        proj = h @ w_in[l]
        u_c, u_b, u_x, q, k, v, r, a_low, g_a, g_b = jnp.split(proj, SPLIT_IDX, axis=-1)
        y_a = short_gated_conv(u_c, u_b, u_x, conv_w[l], conv_b[l]) @ w_br_a[l]
        y_b = chunk_causal_gla(q, k, v, r, a_low, w_a2[l], b_a[l], gla_norm_g[l]) @ w_br_b[l]
        mixed = jax.nn.sigmoid(g_a) * y_a + jax.nn.sigmoid(g_b) * y_b
        x = x + mixed @ w_out[l]
        h = rms_norm(x, norm_ffn_g[l]).reshape(bn * t, d)
        y = moe_ffn(h, w_router[l], b_router[l], w_gate_up[l], b_gate_up[l], w_down[l], b_down[l])
        x = x + y.reshape(bn, t, d)
    return rms_norm(x, norm_final_g)
```

```cpp
#include <hip/hip_runtime.h>
#include <cstdio>
#include <cstdint>

#ifndef DBG_STAGE
#define DBG_STAGE 3
#endif

#ifndef REP_P0
#define REP_P0 1
#endif
#ifndef REP_P2
#define REP_P2 1
#endif
#define LAS __attribute__((address_space(3)))
#define GAS __attribute__((address_space(1)))
typedef unsigned short bf16;
typedef short bf16x8 __attribute__((ext_vector_type(8)));
typedef float f32x4 __attribute__((ext_vector_type(4)));
typedef float f32x2 __attribute__((ext_vector_type(2)));
typedef unsigned u32x4 __attribute__((ext_vector_type(4)));
typedef unsigned u32x2 __attribute__((ext_vector_type(2)));

constexpr int NTOK = 16384, DM = 2048, SEQ = 2048, NBATCH = 8;
constexpr int NP = 10496;
constexpr int PC_UC = 0, PC_UB = 1024, PC_UX = 2048, PC_Q = 3072, PC_K = 3584, PC_V = 4096, PC_R = 5120, PC_AL = 6144, PC_GA = 6400, PC_GB = 8448;
constexpr int SRC_AL = 6144;
constexpr int DIN = 10256;
constexpr int NE = 32, TOPK = 4, DFF = 2048;
constexpr int MAXSLOT = NTOK * TOPK + NE * 256;
constexpr int MAXMT = MAXSLOT / 256;
constexpr float EPS = 1e-6f;

constexpr size_t MiB = 1u << 20;
constexpr size_t WS_CTL = 0, CTL_ZERO_BYTES = 1 * MiB;
constexpr size_t WS_WRF = 1 * MiB;
constexpr size_t WS_TK = 2 * MiB;
constexpr size_t WS_SLOT = 4 * MiB;
constexpr size_t WS_WIN = 8 * MiB;
constexpr size_t WS_WA = 50 * MiB;
constexpr size_t WS_WB = 54 * MiB;
constexpr size_t WS_WO = 58 * MiB;
constexpr size_t WS_WGU = 66 * MiB;
constexpr size_t WS_WD = 578 * MiB;
constexpr size_t WS_H = 834 * MiB;
constexpr size_t WS_P = 898 * MiB;
constexpr size_t WS_ZA = 1226 * MiB;
constexpr size_t WS_ZB = 1258 * MiB;
constexpr size_t WS_O = 1290 * MiB;
constexpr size_t WS_YA = 1354 * MiB;
constexpr size_t WS_MIX = 1418 * MiB;
constexpr size_t WS_X1 = 1482 * MiB;
constexpr size_t WS_XB = 1610 * MiB;
constexpr size_t WS_ACT = 1898 * MiB;
constexpr size_t WS_YS = 2186 * MiB;
constexpr size_t WS_KTT = 2474 * MiB;
constexpr size_t WS_DEC = 2490 * MiB;
constexpr size_t WS_VTT = 2492 * MiB;
constexpr size_t WS_WIN8 = 2524 * MiB;
constexpr size_t WS_HQ8 = 2532 * MiB;
constexpr size_t WS_END = 2564 * MiB;
constexpr int CW_BAR = 4096;
constexpr int CW_Q3 = 8320;
constexpr int CW_Q2 = 8256;
constexpr int CW_Q = 8192;
constexpr int NGEMM = 208, QBATCH = 8;
constexpr int CW_CNT = 16384;

constexpr int RING_BYTES = 131072;
constexpr int TOKT_OFF = 131072, TOKT_UNITS = 30;
constexpr int LDSCTL_OFF = 161792;
constexpr int MISC_OFF = LDSCTL_OFF;
constexpr int TILEE_OFF = LDSCTL_OFF + 128;
constexpr int PSTART_OFF = TILEE_OFF + 4 * 320;
constexpr int LDS_BYTES = 163840;
constexpr int NWAVES = 8;

#define LDS_WAIT() asm volatile("s_waitcnt lgkmcnt(0)" ::: "memory")
#define VM_WAIT() asm volatile("s_waitcnt vmcnt(0)" ::: "memory")
#define RLX_AGENT __ATOMIC_RELAXED, __HIP_MEMORY_SCOPE_AGENT

typedef __bf16 bf16x2_t __attribute__((ext_vector_type(2)));
__device__ __forceinline__ unsigned cvt_pk_bf16(float lo, float hi) { f32x2 v = {lo, hi}; bf16x2_t b = __builtin_convertvector(v, bf16x2_t); return __builtin_bit_cast(unsigned, b); }
__device__ __forceinline__ float clamp448(float x) { return __builtin_amdgcn_fmed3f(x, -448.0f, 448.0f); }
__device__ __forceinline__ unsigned pk4_fp8(float a, float b, float c, float d) {
    int w = 0; w = __builtin_amdgcn_cvt_pk_fp8_f32(clamp448(a), clamp448(b), w, false); w = __builtin_amdgcn_cvt_pk_fp8_f32(clamp448(c), clamp448(d), w, true); return (unsigned)w; }
__device__ __forceinline__ float bf_lo(unsigned w) { return __uint_as_float(w << 16); }
__device__ __forceinline__ float bf_hi(unsigned w) { return __uint_as_float(w & 0xffff0000u); }
__device__ __forceinline__ float bf2f(bf16 b) { return __uint_as_float(((unsigned)b) << 16); }
__device__ __forceinline__ float fast_sigmoid(float x) { return __builtin_amdgcn_rcpf(1.0f + __builtin_amdgcn_exp2f(-1.44269504089f * x)); }
__device__ __forceinline__ float wave_sum(float v) {
#pragma unroll
    for (int o = 1; o < 64; o <<= 1) v += __shfl_xor(v, o);
    return v;
}

namespace pg8 {
constexpr int BM = 256, BK = 64, HALF = 128, HTB = HALF * BK * 2, STAGE_BYTES = 8 * HTB, NXCD = 8, WGM = 8;
__host__ __device__ __forceinline__ int lds_byte(int r, int c) { const int st = (r >> 4) * 2 + (c >> 5), rr = r & 15, cc = c & 31, ob = rr * 64 + cc * 2; return st * 1024 + (ob ^ (((ob >> 9) & 1) << 5)); }
__host__ __device__ __forceinline__ void stage_rc(int b, int& R, int& C) { const int st = b / 1024, sb = b % 1024, swz = sb ^ (((sb >> 9) & 1) << 5); R = (st >> 1) * 16 + swz / 64; C = (st & 1) * 32 + (swz % 64) / 2; }
__host__ __device__ __forceinline__ int perm32(int rho) { const int n = rho >> 4, i = rho & 15; return 8 * (i >> 2) + 4 * n + (i & 3); }

struct Unit { int pm, pn, pb, e; };
struct Gemm { const void* A; const void* Bt; int ldb; const void* A2; const void* Bt2; const LAS int* tokt; };

struct StaticOrder {
    int nM, nN, nwg, G, c, wgm;
    __device__ void init(int nM_, int nN_, int G_, int c_, int wgm_ = WGM) { nM = nM_; nN = nN_; nwg = nM * nN; G = G_; c = c_; wgm = wgm_; }
    __device__ __forceinline__ bool tile(int i, int& pm, int& pn) const {
        const long L = (long)i * G + c; if (L >= nwg) return false;
        int wgid = (int)L; { const int q = nwg / NXCD, r = nwg % NXCD, xcd = wgid % NXCD, off = wgid / NXCD; wgid = (xcd < r ? xcd * (q + 1) : r * (q + 1) + (xcd - r) * q) + off; }
        const int nig = wgm * nN, gid = wgid / nig, fm = gid * wgm, gsz = (nM - fm) < wgm ? (nM - fm) : wgm;
        pm = fm + ((wgid % nig) % gsz); pn = (wgid % nig) / gsz; return true;
    }
    __device__ __forceinline__ bool next(int i, Unit& u) const { if (!tile(i, u.pm, u.pn)) return false; u.pb = u.pn; u.e = 0; return true; }
};
struct GroupedOrder : StaticOrder {
    const LAS int* tile_e;
    __device__ __forceinline__ bool next(int i, Unit& u) const { if (!tile(i, u.pm, u.pn)) return false; u.e = tile_e[u.pm]; u.pb = u.e * nN + u.pn; return true; }
};

struct EpiPlainBf16 {
    static constexpr bool PERM = true;
    bf16* O; int ldc; int colbase; float scale;
    __device__ __forceinline__ void operator()(const f32x4 (&acc)[2][2][4][2], const Unit& u, int wr, int wc, int fr, int fq) const {
        const int row0 = u.pm * BM + wr * 64 + fr, col0 = colbase + u.pn * BM + wc * 32 + 8 * fq;
#pragma unroll
        for (int ai = 0; ai < 2; ++ai)
#pragma unroll
            for (int m = 0; m < 4; ++m) { bf16* rowp = O + (size_t)(row0 + ai * HALF + m * 16) * ldc + col0;
#pragma unroll
                for (int bj = 0; bj < 2; ++bj) { const f32x4 v0 = acc[ai][bj][m][0] * scale, v1 = acc[ai][bj][m][1] * scale;
                    u32x4 w; w.x = cvt_pk_bf16(v0[0], v0[1]); w.y = cvt_pk_bf16(v0[2], v0[3]); w.z = cvt_pk_bf16(v1[0], v1[1]); w.w = cvt_pk_bf16(v1[2], v1[3]);
                    *(u32x4*)(rowp + bj * HALF) = w; } }
    }
};
struct EpiPlainFp8 {
    static constexpr bool PERM = true;
    unsigned char* O8; int ldc; float scale;
    __device__ __forceinline__ void operator()(const f32x4 (&acc)[2][2][4][2], const Unit& u, int wr, int wc, int fr, int fq) const {
        const int row0 = u.pm * BM + wr * 64 + fr, col0 = u.pn * BM + wc * 32 + 8 * fq;
#pragma unroll
        for (int ai = 0; ai < 2; ++ai)
#pragma unroll
            for (int m = 0; m < 4; ++m) { unsigned char* rowp = O8 + (size_t)(row0 + ai * HALF + m * 16) * ldc + col0;
#pragma unroll
                for (int bj = 0; bj < 2; ++bj) { const f32x4 v0 = acc[ai][bj][m][0] * scale, v1 = acc[ai][bj][m][1] * scale;
                    u32x2 w; w.x = pk4_fp8(v0[0], v0[1], v0[2], v0[3]); w.y = pk4_fp8(v1[0], v1[1], v1[2], v1[3]);
                    *(u32x2*)(rowp + bj * HALF) = w; } }
    }
};
struct EpiGate2 {
    static constexpr bool PERM = true;
    const unsigned char* G8; bf16* O;
    __device__ __forceinline__ void mid(f32x4 (&acc)[2][2][4][2], const Unit& u, int wr, int wc, int fr, int fq) const {
        int opq = 0; asm volatile("" : "+v"(opq));
        const int row0 = u.pm * BM + wr * 64 + fr + opq, col0 = u.pn * BM + wc * 32 + 8 * fq;
#pragma unroll
        for (int ai = 0; ai < 2; ++ai)
#pragma unroll
            for (int m = 0; m < 4; ++m) { const size_t row = (size_t)(row0 + ai * HALF + m * 16);
#pragma unroll
                for (int bj = 0; bj < 2; ++bj) { const int col = col0 + bj * HALF;
                    const u32x2 ga = *(const u32x2*)(G8 + row * 4096 + col), gb = *(const u32x2*)(G8 + row * 4096 + 2048 + col);
#pragma unroll
                    for (int q = 0; q < 4; ++q) {
                        const int gaw_ = (int)(q < 2 ? ga.x : ga.y), gbw_ = (int)(q < 2 ? gb.x : gb.y);
                        const f32x2 a2 = (q & 1) ? __builtin_amdgcn_cvt_pk_f32_fp8(gaw_, true) : __builtin_amdgcn_cvt_pk_f32_fp8(gaw_, false), b2 = (q & 1) ? __builtin_amdgcn_cvt_pk_f32_fp8(gbw_, true) : __builtin_amdgcn_cvt_pk_f32_fp8(gbw_, false);
                        const float r0 = (1.0f + __builtin_amdgcn_exp2f(-0.0901684400556f * b2.x)) * __builtin_amdgcn_rcpf(1.0f + __builtin_amdgcn_exp2f(-0.0901684400556f * a2.x));
                        const float r1 = (1.0f + __builtin_amdgcn_exp2f(-0.0901684400556f * b2.y)) * __builtin_amdgcn_rcpf(1.0f + __builtin_amdgcn_exp2f(-0.0901684400556f * a2.y));
                        acc[ai][bj][m][q >> 1][2 * (q & 1)] *= r0; acc[ai][bj][m][q >> 1][2 * (q & 1) + 1] *= r1; } }
                asm volatile("" ::: "memory"); }
    }
    __device__ __forceinline__ void operator()(const f32x4 (&acc)[2][2][4][2], const Unit& u, int wr, int wc, int fr, int fq) const {
        const int row0 = u.pm * BM + wr * 64 + fr, col0 = u.pn * BM + wc * 32 + 8 * fq;
#pragma unroll
        for (int ai = 0; ai < 2; ++ai)
#pragma unroll
            for (int m = 0; m < 4; ++m) { const size_t row = (size_t)(row0 + ai * HALF + m * 16);
#pragma unroll
                for (int bj = 0; bj < 2; ++bj) { const int col = col0 + bj * HALF;
                    const u32x2 g = *(const u32x2*)(G8 + row * 4096 + 2048 + col);
                    f32x4 v0 = acc[ai][bj][m][0], v1 = acc[ai][bj][m][1];
                    { const f32x2 g0 = __builtin_amdgcn_cvt_pk_f32_fp8((int)g.x, false), g1 = __builtin_amdgcn_cvt_pk_f32_fp8((int)g.x, true), g2 = __builtin_amdgcn_cvt_pk_f32_fp8((int)g.y, false), g3 = __builtin_amdgcn_cvt_pk_f32_fp8((int)g.y, true);
                      v0[0] *= fast_sigmoid(0.0625f * g0.x); v0[1] *= fast_sigmoid(0.0625f * g0.y); v0[2] *= fast_sigmoid(0.0625f * g1.x); v0[3] *= fast_sigmoid(0.0625f * g1.y);
                      v1[0] *= fast_sigmoid(0.0625f * g2.x); v1[1] *= fast_sigmoid(0.0625f * g2.y); v1[2] *= fast_sigmoid(0.0625f * g3.x); v1[3] *= fast_sigmoid(0.0625f * g3.y); }
                    u32x4 w; w.x = cvt_pk_bf16(v0[0], v0[1]); w.y = cvt_pk_bf16(v0[2], v0[3]); w.z = cvt_pk_bf16(v1[0], v1[1]); w.w = cvt_pk_bf16(v1[2], v1[3]);
                    *(u32x4*)(O + row * DM + col) = w; } }
    }
};
struct EpiResF32 {
    static constexpr bool PERM = false;
    const float* base; float* C;
    __device__ __forceinline__ void operator()(const f32x4 (&acc)[2][2][4][2], const Unit& u, int wr, int wc, int fr, int fq) const {
        const int row0 = u.pm * BM + wr * 64 + fr, col0 = u.pn * BM + wc * 32 + 4 * fq;
#pragma unroll
        for (int ai = 0; ai < 2; ++ai)
#pragma unroll
            for (int m = 0; m < 4; ++m) { const size_t off = (size_t)(row0 + ai * HALF + m * 16) * DM + col0;
#pragma unroll
                for (int bj = 0; bj < 2; ++bj)
#pragma unroll
                    for (int n = 0; n < 2; ++n) { const f32x4 b = *(const f32x4*)(base + off + bj * HALF + n * 16); *(f32x4*)(C + off + bj * HALF + n * 16) = acc[ai][bj][m][n] + b; } }
    }
};
struct EpiSwiglu8 {
    static constexpr bool PERM = true;
    const float* bgu; const float* slot_rs; unsigned char* ACT8;
    __device__ __forceinline__ void operator()(const f32x4 (&acc)[2][2][4][2], const Unit& u, int wr, int wc, int fr, int fq) const {
        const int row0 = u.pm * BM + wr * 64 + fr, cl = u.pn * HALF + wc * 32 + 8 * fq;
        const float* bg = bgu + (size_t)u.e * (2 * DFF) + cl;
        const f32x4 bg0 = *(const f32x4*)(bg), bg1 = *(const f32x4*)(bg + 4), bu0 = *(const f32x4*)(bg + DFF), bu1 = *(const f32x4*)(bg + DFF + 4);
#pragma unroll
        for (int ai = 0; ai < 2; ++ai)
#pragma unroll
            for (int m = 0; m < 4; ++m) { const size_t row = (size_t)(row0 + ai * HALF + m * 16); const float rs = slot_rs[row] * (1.0f / 16384.0f);
                const f32x4 g0 = acc[ai][0][m][0] * rs + bg0, g1 = acc[ai][0][m][1] * rs + bg1, u0 = acc[ai][1][m][0] * rs + bu0, u1 = acc[ai][1][m][1] * rs + bu1;
                float o[8];
#pragma unroll
                for (int j = 0; j < 4; ++j) {
                    float g = fminf(g0[j], 7.0f), up = __builtin_amdgcn_fmed3f(u0[j], -7.0f, 7.0f);
                    o[j] = (up * 4.0f + 4.0f) * (g * __builtin_amdgcn_rcpf(1.0f + __builtin_amdgcn_exp2f(-2.45546696f * g)));
                    g = fminf(g1[j], 7.0f); up = __builtin_amdgcn_fmed3f(u1[j], -7.0f, 7.0f);
                    o[4 + j] = (up * 4.0f + 4.0f) * (g * __builtin_amdgcn_rcpf(1.0f + __builtin_amdgcn_exp2f(-2.45546696f * g))); }
                u32x2 w; { int t_ = 0; t_ = __builtin_amdgcn_cvt_pk_fp8_f32(o[0], o[1], t_, false); t_ = __builtin_amdgcn_cvt_pk_fp8_f32(o[2], o[3], t_, true); w.x = (unsigned)t_;
                           t_ = 0; t_ = __builtin_amdgcn_cvt_pk_fp8_f32(o[4], o[5], t_, false); t_ = __builtin_amdgcn_cvt_pk_fp8_f32(o[6], o[7], t_, true); w.y = (unsigned)t_; }
                *(u32x2*)(ACT8 + row * DFF + cl) = w; }
    }
};
struct EpiDown8 {
    static constexpr bool PERM = true;
    const float* bd; const float* slot_w; unsigned char* YS8;
    __device__ __forceinline__ void operator()(const f32x4 (&acc)[2][2][4][2], const Unit& u, int wr, int wc, int fr, int fq) const {
        const int row0 = u.pm * BM + wr * 64 + fr, col0 = u.pn * BM + wc * 32 + 8 * fq;
        const float* bp = bd + (size_t)u.e * DM + col0;
        f32x4 bv[2][2];
#pragma unroll
        for (int bj = 0; bj < 2; ++bj)
#pragma unroll
            for (int n = 0; n < 2; ++n) bv[bj][n] = *(const f32x4*)(bp + bj * HALF + 4 * n);
#pragma unroll
        for (int ai = 0; ai < 2; ++ai)
#pragma unroll
            for (int m = 0; m < 4; ++m) { const size_t row = (size_t)(row0 + ai * HALF + m * 16); const float sw = slot_w[row] * 64.0f;
#pragma unroll
                for (int bj = 0; bj < 2; ++bj) { const f32x4 v0 = (acc[ai][bj][m][0] * (1.0f / 4096.0f) + bv[bj][0]) * sw, v1 = (acc[ai][bj][m][1] * (1.0f / 4096.0f) + bv[bj][1]) * sw;
                    u32x2 w; w.x = pk4_fp8(v0[0], v0[1], v0[2], v0[3]); w.y = pk4_fp8(v1[0], v1[1], v1[2], v1[3]);
                    *(u32x2*)(YS8 + row * DM + col0 + bj * HALF) = w; } }
    }
};

typedef int v4i_t __attribute__((ext_vector_type(4)));
typedef int v8i_t __attribute__((ext_vector_type(8)));
template <bool F8, int NSEG, bool GATHER, class Epi, class Sched>
__device__ __forceinline__ void gemm_phase(LAS unsigned char* lds, const Gemm g, const Sched& S, const Epi& E) {
    const int tid = threadIdx.x, wid = __builtin_amdgcn_readfirstlane(tid >> 6), lane = tid & 63, wr = wid >> 2, wc = wid & 3, fr = lane & 15, fq = lane >> 4;
    const int ldb = g.ldb, nt = ldb / 128;
    unsigned voffA[2], voffB[2];
#pragma unroll
    for (int i = 0; i < 2; ++i) { int R, C; stage_rc(tid * 16 + i * 8192, R, C); const int Rb = Epi::PERM ? ((R & ~31) + perm32(R & 31)) : R;
        voffA[i] = (unsigned)(R * ldb + C * 2); voffB[i] = (unsigned)(Rb * ldb + C * 2); }
    const size_t kstep = (size_t)128;
    const size_t hstep = (size_t)HALF * ldb;
    const size_t tstep = 2 * hstep;
    const unsigned ldsw = (unsigned)wid * 1024u;
    const int aoff = lds_byte(wr * 64 + fr, fq * 8), boff = lds_byte(wc * 32 + fr, fq * 8);
#define PG8_SA(b, h) (((b) * 2 + (h)) * HTB)
#define PG8_SB(b, h) ((4 + (b) * 2 + (h)) * HTB)
#define PG8_STAGE(bufoff, gbase, voff) do { _Pragma("unroll") for (int _i = 0; _i < 2; ++_i) \
        __builtin_amdgcn_global_load_lds((const unsigned*)((const char*)(gbase) + (voff)[_i]), (LAS unsigned*)(lds + (bufoff) + ldsw + _i * 8192), 16, 0, 0); } while (0)
#define PG8_STAGE_A(bufoff, gbase, h, nx) do { if constexpr (GATHER) { unsigned vv_[2]; vv_[0] = (nx) ? offAn[h][0] : offA[h][0]; vv_[1] = (nx) ? offAn[h][1] : offA[h][1]; PG8_STAGE(bufoff, gbase, vv_); } \
        else { PG8_STAGE(bufoff, (gbase) + ((h) ? hstep : (size_t)0), voffA); } } while (0)
#define PG8_LDA(dst, b, h) do { _Pragma("unroll") for (int m = 0; m < 4; ++m) _Pragma("unroll") for (int k = 0; k < 2; ++k) dst[m][k] = *(const LAS bf16x8*)(lds + PG8_SA(b, h) + aoff + m * 2048 + k * 1024); } while (0)
#define PG8_LDB(dst, b, h) do { _Pragma("unroll") for (int n = 0; n < 2; ++n) _Pragma("unroll") for (int k = 0; k < 2; ++k) dst[n][k] = *(const LAS bf16x8*)(lds + PG8_SB(b, h) + boff + n * 2048 + k * 1024); } while (0)
#define PG8_MMA(ai, bj, At, Bt) do { __builtin_amdgcn_s_setprio(1); if constexpr (F8) { asm volatile("s_nop 1"); _Pragma("unroll") for (int m = 0; m < 4; ++m) _Pragma("unroll") for (int n = 0; n < 2; ++n) \
        { const v8i_t b8_ = __builtin_shufflevector(__builtin_bit_cast(v4i_t, Bt[n][0]), __builtin_bit_cast(v4i_t, Bt[n][1]), 0, 1, 2, 3, 4, 5, 6, 7); \
          const v8i_t a8_ = __builtin_shufflevector(__builtin_bit_cast(v4i_t, At[m][0]), __builtin_bit_cast(v4i_t, At[m][1]), 0, 1, 2, 3, 4, 5, 6, 7); \
          asm volatile("v_mfma_scale_f32_16x16x128_f8f6f4 %0, %1, %2, %0, %3, %3 op_sel_hi:[0,0,0]" : "+v"(acc[ai][bj][m][n]) : "v"(b8_), "v"(a8_), "v"(sc8)); } } \
      else { _Pragma("unroll") for (int m = 0; m < 4; ++m) _Pragma("unroll") for (int n = 0; n < 2; ++n) _Pragma("unroll") for (int k = 0; k < 2; ++k) \
        acc[ai][bj][m][n] = __builtin_amdgcn_mfma_f32_16x16x32_bf16(Bt[n][k], At[m][k], acc[ai][bj][m][n], 0, 0, 0); } __builtin_amdgcn_s_setprio(0); } while (0)
#define PG8_WAIT_V(n) asm volatile("s_waitcnt vmcnt(" #n ")" ::: "memory")
#define PG8_WAIT_L(n) asm volatile("s_waitcnt lgkmcnt(" #n ")" ::: "memory")
#define PG8_BAR __builtin_amdgcn_s_barrier()
#define PG8_SCHED __builtin_amdgcn_sched_barrier(0)
    Unit cur, nxt; int ui = 0;
    if (!S.next(0, cur)) return;
    int sc8 = 0; if constexpr (F8) { asm volatile("v_mov_b32 %0, 0x7f7f7f7f\n\ts_nop 1" : "=v"(sc8)); }
    f32x4 acc[2][2][4][2];
#pragma unroll
    for (int a = 0; a < 2; ++a)
#pragma unroll
        for (int b = 0; b < 2; ++b)
#pragma unroll
            for (int m = 0; m < 4; ++m)
#pragma unroll
                for (int n = 0; n < 2; ++n) acc[a][b][m][n] = (f32x4){0.f, 0.f, 0.f, 0.f};
    bf16x8 At[4][2], B0[2][2], B1[2][2];
    const char* cA = (const char*)g.A + (GATHER ? (size_t)0 : (size_t)cur.pm * tstep); const char* cB = (const char*)g.Bt + (size_t)cur.pb * tstep;
    constexpr bool DUAL = (NSEG == 2);
    unsigned offA[2][2] = {{0u, 0u}, {0u, 0u}}, offAn[2][2] = {{0u, 0u}, {0u, 0u}};
    int gR0 = 0, gC2 = 0; if constexpr (GATHER) { int R, C; stage_rc(tid * 16, R, C); gR0 = R; gC2 = C * 2;
#pragma unroll
        for (int h = 0; h < 2; ++h)
#pragma unroll
            for (int i = 0; i < 2; ++i) offA[h][i] = (unsigned)(g.tokt[128 * h + gR0 + 64 * i] * ldb + gC2);
        asm volatile("s_waitcnt lgkmcnt(0)" ::: "memory"); }
    PG8_STAGE(PG8_SB(0, 0), cB, voffB); PG8_STAGE_A(PG8_SA(0, 0), cA, 0, false); PG8_STAGE(PG8_SB(0, 1), cB + hstep, voffB); PG8_STAGE_A(PG8_SA(0, 1), cA, 1, false);
    if (wr == 1) PG8_BAR;
    PG8_WAIT_V(4); PG8_BAR;
    PG8_STAGE(PG8_SB(1, 0), cB + kstep, voffB); PG8_STAGE_A(PG8_SA(1, 0), cA + kstep, 0, false); PG8_STAGE(PG8_SB(1, 1), cB + hstep + kstep, voffB);
    PG8_WAIT_V(6); PG8_BAR;
    for (;;) {
        const bool has_next = S.next(ui + 1, nxt);
        if constexpr (GATHER) { if (has_next) {
#pragma unroll
            for (int h = 0; h < 2; ++h)
#pragma unroll
                for (int i = 0; i < 2; ++i) offAn[h][i] = (unsigned)(g.tokt[(ui + 1) * 256 + 128 * h + gR0 + 64 * i] * ldb + gC2); }
            asm volatile("s_waitcnt lgkmcnt(0)" ::: "memory"); }
        const char* nA = (has_next && !GATHER) ? (const char*)g.A + (size_t)nxt.pm * tstep : cA; const char* nB = has_next ? (const char*)g.Bt + (size_t)nxt.pb * tstep : cB;
        for (int t = 0; t < NSEG * nt; t += 2) {
            const bool last = (t == NSEG * nt - 2); const bool nx = last && has_next;
            const bool seg2 = DUAL && (t >= nt), cross = DUAL && (t == nt - 2);
            const char* sA_ = seg2 ? (const char*)g.A2 + (size_t)cur.pm * tstep - (size_t)nt * kstep : cA; const char* sB_ = seg2 ? (const char*)g.Bt2 + (size_t)cur.pb * tstep - (size_t)nt * kstep : cB;
            if constexpr (DUAL) { if (t == nt) E.mid(acc, cur, wr, wc, fr, fq); }
            const char* a1 = sA_ + (size_t)(t + 1) * kstep;
            const char* a2 = last ? nA : cross ? (const char*)g.A2 + (size_t)cur.pm * tstep : sA_ + (size_t)(t + 2) * kstep; const char* b2 = last ? nB : cross ? (const char*)g.Bt2 + (size_t)cur.pb * tstep : sB_ + (size_t)(t + 2) * kstep;
            const char* a3 = a2 + kstep; const char* b3 = b2 + kstep;
            PG8_LDB(B0, 0, 0); PG8_SCHED; PG8_LDA(At, 0, 0); PG8_STAGE_A(PG8_SA(1, 1), a1, 1, false);
            PG8_WAIT_L(8); PG8_BAR; PG8_WAIT_L(0); PG8_MMA(0, 0, At, B0); PG8_BAR; PG8_SCHED;
            PG8_LDB(B1, 0, 1); PG8_STAGE(PG8_SB(0, 0), b2, voffB);
            PG8_BAR; PG8_WAIT_L(0); PG8_MMA(0, 1, At, B1); PG8_BAR;
            PG8_LDA(At, 0, 1); PG8_STAGE_A(PG8_SA(0, 0), a2, 0, nx);
            PG8_BAR; PG8_WAIT_L(0); PG8_MMA(1, 0, At, B0); PG8_BAR; PG8_SCHED;
            PG8_STAGE(PG8_SB(0, 1), b2 + hstep, voffB);
            PG8_WAIT_V(6); PG8_BAR; PG8_MMA(1, 1, At, B1); PG8_BAR;
            PG8_LDB(B0, 1, 0); PG8_SCHED; PG8_LDA(At, 1, 0); PG8_STAGE_A(PG8_SA(0, 1), a2, 1, nx);
            PG8_WAIT_L(8); PG8_BAR; PG8_WAIT_L(0); PG8_MMA(0, 0, At, B0); PG8_BAR; PG8_SCHED;
            PG8_LDB(B1, 1, 1); PG8_STAGE(PG8_SB(1, 0), b3, voffB);
            PG8_BAR; PG8_WAIT_L(0); PG8_MMA(0, 1, At, B1); PG8_BAR;
            PG8_LDA(At, 1, 1); PG8_STAGE_A(PG8_SA(1, 0), a3, 0, nx);
            PG8_BAR; PG8_WAIT_L(0); PG8_MMA(1, 0, At, B0); PG8_BAR; PG8_SCHED;
            PG8_STAGE(PG8_SB(1, 1), b3 + hstep, voffB);
            PG8_WAIT_V(6); PG8_BAR; PG8_MMA(1, 1, At, B1); PG8_BAR;
        }
        if constexpr (F8) { asm volatile("s_nop 15\n\ts_nop 15" : "+v"(acc[1][1][0][0]), "+v"(acc[1][1][0][1]), "+v"(acc[1][1][1][0]), "+v"(acc[1][1][1][1]), "+v"(acc[1][1][2][0]), "+v"(acc[1][1][2][1]), "+v"(acc[1][1][3][0]), "+v"(acc[1][1][3][1])); }
        E(acc, cur, wr, wc, fr, fq);
        if (!has_next) break;
#pragma unroll
        for (int a = 0; a < 2; ++a)
#pragma unroll
            for (int b = 0; b < 2; ++b)
#pragma unroll
                for (int m = 0; m < 4; ++m)
#pragma unroll
                    for (int n = 0; n < 2; ++n) acc[a][b][m][n] = (f32x4){0.f, 0.f, 0.f, 0.f};
        cur = nxt; cA = nA; cB = nB; ++ui;
        if constexpr (GATHER) {
#pragma unroll
            for (int h = 0; h < 2; ++h)
#pragma unroll
                for (int i = 0; i < 2; ++i) offA[h][i] = offAn[h][i]; }
    }
    PG8_WAIT_V(0);
    if (wr == 0) PG8_BAR;
    PG8_BAR;
#undef PG8_SA
#undef PG8_SB
#undef PG8_STAGE
#undef PG8_STAGE_A
#undef PG8_LDA
#undef PG8_LDB
#undef PG8_MMA
#undef PG8_WAIT_V
#undef PG8_WAIT_L
#undef PG8_BAR
#undef PG8_SCHED
}
}

#define XB_TMO      128
#define XB_XCNT(j)  (256  + 64 * (j))
#define XB_XSUB(j)  (1280 + 64 * (j))
#define XB_XGEN(j)  (2304 + 64 * (j))
#define XB_TOP      3328
#define XB_TOPGEN   3392
#define XCD_BAR_WORDS 3456
#define XB_SPIN_CAP (1u << 18)

__device__ __forceinline__ unsigned xb_ld(unsigned* p)              { return __hip_atomic_load(p, __ATOMIC_RELAXED, __HIP_MEMORY_SCOPE_AGENT); }
__device__ __forceinline__ unsigned xb_add(unsigned* p, unsigned v) { return __hip_atomic_fetch_add(p, v, __ATOMIC_RELAXED, __HIP_MEMORY_SCOPE_AGENT); }
__device__ __forceinline__ unsigned xb_xcc_id() { return (unsigned)__builtin_amdgcn_s_getreg((3 << 11) | 20) & 0xFu; }
#define XB_SPIN(cond, bar) do { unsigned _sp = 0; while (cond) { __builtin_amdgcn_s_sleep(1); \
    if ((++_sp & 255u) == 0u) { if (xb_ld(&(bar)[XB_TMO])) break; if (_sp > XB_SPIN_CAP) { atomicAdd(&(bar)[XB_TMO], 1u); break; } } } } while (0)

struct XcdBarrier { unsigned* bar; unsigned x; volatile LAS unsigned* st; };

__device__ __forceinline__ XcdBarrier xcd_barrier_post(unsigned* bar, volatile LAS unsigned* st) {
    XcdBarrier b; b.bar = bar; b.x = xb_xcc_id(); b.st = st;
    if (threadIdx.x == 0) (void)xb_add(&bar[XB_XCNT(b.x)], 1u);
    return b;
}
__device__ __forceinline__ void xcd_barrier_complete(unsigned* bar, unsigned x, unsigned& nloc, unsigned& nx) {
    const unsigned G = gridDim.x * gridDim.y * gridDim.z;
    unsigned sum, cnt, mine, sp = 0u;
    for (;;) {
        sum = 0u; cnt = 0u; mine = 0u;
#pragma unroll
        for (unsigned j = 0; j < 16; ++j) { const unsigned c = xb_ld(&bar[XB_XCNT(j)]); sum += c; cnt += (c > 0u) ? 1u : 0u; mine = (j == x) ? c : mine; }
        if (sum == G) break;
        __builtin_amdgcn_s_sleep(1);
        if ((++sp & 255u) == 0u) { if (xb_ld(&bar[XB_TMO])) break; if (sp > XB_SPIN_CAP) { atomicAdd(&bar[XB_TMO], 1u); break; } }
    }
    nloc = mine > 0u ? mine : 1u; nx = cnt > 0u ? cnt : 1u;
}
__device__ __forceinline__ void xcd_barrier(const XcdBarrier& b) {
    asm volatile("s_waitcnt vmcnt(0)" ::: "memory");
    __syncthreads();
    if (threadIdx.x == 0) {
        unsigned* bar = b.bar;
        __builtin_amdgcn_s_waitcnt(0);
        unsigned nloc = b.st[0], nx = b.st[1];
        if (nloc == 0u) { xcd_barrier_complete(bar, b.x, nloc, nx); b.st[0] = nloc; b.st[1] = nx; }
        const unsigned old = xb_add(&bar[XB_XSUB(b.x)], 1u);
        const unsigned gen = old / nloc;
        if (old + 1u == (gen + 1u) * nloc) {
            __builtin_amdgcn_fence(__ATOMIC_RELEASE, "agent");
            asm volatile("s_waitcnt vmcnt(0)" ::: "memory");
            const unsigned og = xb_add(&bar[XB_TOP], 1u);
            const unsigned tg = og / nx;
            if (og + 1u == (tg + 1u) * nx) xb_add(&bar[XB_TOPGEN], 1u);
            else XB_SPIN(xb_ld(&bar[XB_TOPGEN]) == tg, bar);
            __builtin_amdgcn_fence(__ATOMIC_ACQUIRE, "agent");
            xb_add(&bar[XB_XGEN(b.x)], 1u);
            asm volatile("s_waitcnt vmcnt(0)" ::: "memory");
        } else {
            XB_SPIN(xb_ld(&bar[XB_XGEN(b.x)]) == gen, bar);
            __builtin_amdgcn_fence(__ATOMIC_ACQUIRE, "agent");
            asm volatile("s_waitcnt vmcnt(0)" ::: "memory");
        }
    }
    __syncthreads();
}

struct Args {
    const float* x; const float* norm_mix_g; const float* w_in; const float* conv_w; const float* conv_b; const float* w_a2; const float* b_a; const float* gla_norm_g;
    const float* w_br_a; const float* w_br_b; const float* w_out; const float* norm_ffn_g; const float* w_router; const float* b_router; const float* w_gate_up; const float* b_gate_up;
    const float* w_down; const float* b_down; const float* norm_final_g; float* out; unsigned char* ws; int ph_lo, ph_hi;
};

__device__ __forceinline__ void tr_item(const float* W, size_t ldw, int k0, int sn0, bf16* WT, int K, size_t drow0, LAS float* scr, int lane) {
#pragma unroll 8
    for (int i = 0; i < 32; ++i) { const int kk = 2 * i + (lane >> 5); scr[kk * 33 + (lane & 31)] = W[(size_t)(k0 + kk) * ldw + sn0 + (lane & 31)]; }
    LDS_WAIT(); asm volatile("" ::: "memory");
    const int c = lane & 7;
#pragma unroll
    for (int j = 0; j < 4; ++j) { const int n = (lane >> 3) + 8 * j; const LAS float* s = scr + (8 * c) * 33 + n;
        u32x4 o; o.x = cvt_pk_bf16(s[0 * 33], s[1 * 33]); o.y = cvt_pk_bf16(s[2 * 33], s[3 * 33]); o.z = cvt_pk_bf16(s[4 * 33], s[5 * 33]); o.w = cvt_pk_bf16(s[6 * 33], s[7 * 33]);
        *(u32x4*)(WT + (drow0 + n) * K + k0 + 8 * c) = o; }
    LDS_WAIT(); asm volatile("" ::: "memory");
}

struct TrItem { const float* W; size_t ldw; unsigned char* dst; int Kb; };
__device__ __forceinline__ void tr8_load(const TrItem& t, f32x4 (&r)[16]) {
#pragma unroll
    for (int i = 0; i < 16; ++i) r[i] = __builtin_nontemporal_load((const f32x4*)(t.W + (size_t)i * t.ldw));
}
__device__ __forceinline__ void tr8_store(const TrItem& t, const f32x4 (&r)[16], float scale) {
#pragma unroll
    for (int q = 0; q < 4; ++q) { u32x4 o;
        o.x = pk4_fp8(r[0][q] * scale, r[1][q] * scale, r[2][q] * scale, r[3][q] * scale); o.y = pk4_fp8(r[4][q] * scale, r[5][q] * scale, r[6][q] * scale, r[7][q] * scale);
        o.z = pk4_fp8(r[8][q] * scale, r[9][q] * scale, r[10][q] * scale, r[11][q] * scale); o.w = pk4_fp8(r[12][q] * scale, r[13][q] * scale, r[14][q] * scale, r[15][q] * scale);
        __builtin_nontemporal_store(o, (u32x4*)(t.dst + (size_t)q * t.Kb)); }
}
__device__ __forceinline__ TrItem moe_item(int it, const float* w_gate_up, const float* w_down, unsigned char* WGU8, unsigned char* WD8, int lane) {
    constexpr int NQ_GU = NE * 16 * 128; const int kr = lane >> 3, c4 = lane & 7; TrItem t;
    if (it < NQ_GU) { const int e = it / (16 * 128), r = it % (16 * 128), kb = r / 128, nb = r % 128; const int n0 = 32 * nb, isup = n0 / DFF, j = n0 % DFF;
        t.ldw = 2 * DFF; t.Kb = DM; t.W = w_gate_up + (size_t)e * DM * 2 * DFF + (size_t)(128 * kb + 16 * kr) * (2 * DFF) + n0 + 4 * c4;
        t.dst = WGU8 + ((size_t)e * 4096 + 256 * (j / 128) + 128 * isup + (j % 128) + 4 * c4) * DM + 128 * kb + 16 * kr; }
    else { const int i2 = it - NQ_GU; const int e = i2 / (16 * 64), r = i2 % (16 * 64), kb = r / 64, nb = r % 64;
        t.ldw = DM; t.Kb = DFF; t.W = w_down + (size_t)e * DFF * DM + (size_t)(128 * kb + 16 * kr) * DM + 32 * nb + 4 * c4;
        t.dst = WD8 + ((size_t)e * DM + 32 * nb + 4 * c4) * DFF + 128 * kb + 16 * kr; }
    return t;
}

constexpr int NQ_MOE = NE * 16 * 128 + NE * 16 * 64;
constexpr int NG9 = 232;
constexpr int NQ_SCAN = 0;
constexpr int NQ_TAIL = 32768;
static_assert(QBATCH % 2 == 0 && NQ_MOE % QBATCH == 0 && NQ_TAIL % QBATCH == 0, "queue batches");
__device__ __forceinline__ void moe_convert_queue(unsigned* head, int first, int last, const float* w_gate_up, const float* w_down, unsigned char* WGU8, unsigned char* WD8, int lane) {
    int nbase = 0; if (lane == 0) nbase = (int)__hip_atomic_fetch_add(head, (unsigned)QBATCH, RLX_AGENT);
    for (;;) {
        const int base = first + __builtin_amdgcn_readfirstlane(nbase);
        if (base >= last) break;
        if (lane == 0) nbase = (int)__hip_atomic_fetch_add(head, (unsigned)QBATCH, RLX_AGENT);
        f32x4 ra[16], rb[16];
        TrItem ta = moe_item(base, w_gate_up, w_down, WGU8, WD8, lane), tb;
        tr8_load(ta, ra);
#pragma unroll
        for (int j = 0; j < QBATCH; j += 2) {
            tb = moe_item(base + j + 1, w_gate_up, w_down, WGU8, WD8, lane); tr8_load(tb, rb);
            tr8_store(ta, ra, 1024.0f);
            if (j + 2 < QBATCH) { ta = moe_item(base + j + 2, w_gate_up, w_down, WGU8, WD8, lane); tr8_load(ta, ra); }
            tr8_store(tb, rb, 1024.0f);
        }
    }
}

__global__ void __launch_bounds__(NWAVES * 64, 2) mega_fwd(Args a) {
    extern __shared__ __attribute__((aligned(16))) unsigned char lds_raw[];
    LAS unsigned char* lds = (LAS unsigned char*)lds_raw;
    volatile LAS unsigned* MISC = (volatile LAS unsigned*)(lds + MISC_OFF);
    LAS int* tile_e = (LAS int*)(lds + TILEE_OFF);
    LAS int* pstart = (LAS int*)(lds + PSTART_OFF);
    const int tid = threadIdx.x, lane = tid & 63, wave = __builtin_amdgcn_readfirstlane(tid >> 6);
    const int G = gridDim.x; const int bx = blockIdx.x; const int vcu = (G % 8 == 0) ? (bx % 8) * (G / 8) + bx / 8 : bx;
    const int gw = vcu * NWAVES + wave, NGW = G * NWAVES;
    unsigned char* ws = a.ws;
    unsigned* ctl = (unsigned*)(ws + WS_CTL);
    float* WRF = (float*)(ws + WS_WRF);
    int* tk_e = (int*)(ws + WS_TK); int* tk_rank = tk_e + NTOK * 4; float* tk_w = (float*)(tk_rank + NTOK * 4); int* tk_slot = (int*)(tk_w + NTOK * 4); float* rs_tok = (float*)(tk_slot + NTOK * 4);
    float* slot_w = (float*)(ws + WS_SLOT); float* slot_rs = slot_w + MAXSLOT; int* slot_tok = (int*)(slot_rs + MAXSLOT);
    bf16* WIN = (bf16*)(ws + WS_WIN); bf16* WA = (bf16*)(ws + WS_WA); bf16* WB = (bf16*)(ws + WS_WB); bf16* WO = (bf16*)(ws + WS_WO); unsigned char* WGU8 = ws + WS_WGU; unsigned char* WD8 = ws + WS_WD;
    bf16* Hb = (bf16*)(ws + WS_H); bf16* P = (bf16*)(ws + WS_P); bf16* ZA = (bf16*)(ws + WS_ZA); bf16* ZB = (bf16*)(ws + WS_ZB); bf16* Ob = (bf16*)(ws + WS_O);
    bf16* YA = (bf16*)(ws + WS_YA); bf16* MIX = (bf16*)(ws + WS_MIX); float* X1 = (float*)(ws + WS_X1); unsigned char* G8 = ws + WS_XB; unsigned char* ACT8 = ws + WS_ACT; unsigned char* YS8 = ws + WS_YS; unsigned char* H8 = ws + WS_H; unsigned char* WIN8 = ws + WS_WIN8; unsigned char* HQ8 = ws + WS_HQ8;

    for (int u = tid; u < (LDS_BYTES - LDSCTL_OFF) / 4; u += NWAVES * 64) ((LAS unsigned*)(lds + LDSCTL_OFF))[u] = 0u;
    __syncthreads();
    XcdBarrier bar = xcd_barrier_post(ctl + CW_BAR, MISC + 8);
    const int lo = a.ph_lo, hi = a.ph_hi;
#define IN(k) (lo <= (k) && (k) < hi)
#define BOTH(k) (IN(k) && IN((k) + 1))
#define GRID_BAR() xcd_barrier(bar)

    if (IN(0)) {
      for (int rep = 0; rep < REP_P0; ++rep) {
        {
            f32x4 gv[8];
#pragma unroll
            for (int j = 0; j < 8; ++j) gv[j] = *((const f32x4*)a.norm_mix_g + lane + 64 * j);
            for (int m = gw; m < NTOK; m += NGW) {
                const f32x4* xr = (const f32x4*)(a.x + (size_t)m * DM) + lane; f32x4 v[8]; float s = 0.f;
#pragma unroll
                for (int j = 0; j < 8; ++j) { v[j] = xr[64 * j]; s += (v[j].x * v[j].x + v[j].y * v[j].y) + (v[j].z * v[j].z + v[j].w * v[j].w); }
                const float rs = 1.0f / sqrtf(wave_sum(s) * (1.0f / DM) + EPS);
                u32x2* o8 = (u32x2*)(Hb + (size_t)m * DM) + lane;
                unsigned* q8 = (unsigned*)(HQ8 + (size_t)m * DM) + lane;
#pragma unroll
                for (int j = 0; j < 8; ++j) { const float h0 = v[j].x * rs * gv[j].x, h1 = v[j].y * rs * gv[j].y, h2 = v[j].z * rs * gv[j].z, h3 = v[j].w * rs * gv[j].w;
                    u32x2 w; w.x = cvt_pk_bf16(h0, h1); w.y = cvt_pk_bf16(h2, h3); o8[64 * j] = w; q8[64 * j] = pk4_fp8(8.0f * h0, 8.0f * h1, 8.0f * h2, 8.0f * h3); }
            }
        }
#if DBG_STAGE >= 1
        {
            LAS float* scr = (LAS float*)(lds + wave * 16896);
            for (int it = gw; it < 192 * 32; it += NGW) { const int kb = it / 192, db = it % 192; const int d0 = 32 * db; tr_item(a.w_in, DIN, 64 * kb, d0, WIN, DM, d0, scr, lane); }
            for (int it = gw; it < 16 * 128; it += NGW) { const int kb = it / 128, nb = it % 128; const int kr = lane >> 3, c4 = lane & 7; TrItem t; t.ldw = DIN; t.Kb = DM;
                t.W = a.w_in + (size_t)(128 * kb + 16 * kr) * DIN + 6160 + 32 * nb + 4 * c4; t.dst = WIN8 + ((size_t)32 * nb + 4 * c4) * DM + 128 * kb + 16 * kr;
                f32x4 r8[16]; tr8_load(t, r8); tr8_store(t, r8, 512.0f); }
            for (int i = gw * 64 + lane; i < 256 * DM; i += NGW * 64) { const int r = i / DM, k = i % DM; WIN[(size_t)(PC_AL + r) * DM + k] = r < 16 ? (bf16)(cvt_pk_bf16(a.w_in[(size_t)k * DIN + SRC_AL + r], 0.f) & 0xffffu) : (bf16)0; }
#if DBG_STAGE >= 3
            for (int i = gw * 64 + lane; i < 128 * 2 * 64 * 4; i += NGW * 64) { const int ii = i & 3, l = (i >> 2) & 63, t = (i >> 8) & 1, j = i >> 9; const int k = 32 * (j >> 1) + 8 * (l >> 4) + 4 * (j & 1) + ii;
                WRF[i] = a.norm_ffn_g[k] * a.w_router[(size_t)k * NE + 16 * t + (l & 15)]; }
#endif
        }
#endif
      }
        if (BOTH(0)) GRID_BAR();
    }

#if DBG_STAGE >= 1
    if (IN(1)) {
        const int ngemm = (G == 256) ? NGEMM : G;
        if (bx < ngemm) {
            { pg8::Gemm g{Hb, WIN, 2 * DM, nullptr, nullptr, nullptr}; pg8::StaticOrder S; S.init(NTOK / 256, 25, ngemm, bx, 4); pg8::EpiPlainBf16 E{P, NP, 0, 1.0f}; pg8::gemm_phase<false, 1, false>(lds, g, S, E); }
            { pg8::Gemm g{HQ8, WIN8, DM, nullptr, nullptr, nullptr}; pg8::StaticOrder S; S.init(NTOK / 256, 16, ngemm, bx, 4); pg8::EpiPlainFp8 E{G8, 4096, 16.0f / 4096.0f}; pg8::gemm_phase<true, 1, false>(lds, g, S, E); }
        }
#if DBG_STAGE >= 3
        moe_convert_queue(ctl + CW_Q, 0, NQ_MOE - NQ_TAIL - NQ_SCAN, a.w_gate_up, a.w_down, WGU8, WD8, lane);
#endif
        if (BOTH(1)) GRID_BAR();
    }

    if (IN(2)) {
        bf16* KTT = (bf16*)(ws + WS_KTT);
        float* DECB = (float*)(ws + WS_DEC);
        bf16* VTT = (bf16*)(ws + WS_VTT);
        {
            LAS float* AL = (LAS float*)(lds);
            LAS float* CUMG = (LAS float*)(lds + 4096);
            LAS bf16* KL = (LAS bf16*)(lds + 8192);
            LAS unsigned char* VT = lds + 32768;
            for (int item = vcu; item < 1024; item += G) {
                const int b = item >> 7, c = (item >> 2) & 31, h = item & 3;
                const size_t t0 = (size_t)b * SEQ + 64 * c;
                const int dk = tid & 127, sg = tid >> 7;
                float wa2[16];
#pragma unroll
                for (int j = 0; j < 16; ++j) wa2[j] = a.w_a2[j * 512 + h * 128 + dk];
                const float ba = a.b_a[h * 128 + dk];
                if (tid < 128) { const int s = tid >> 1, hf = tid & 1; const u32x4 w = *(const u32x4*)(P + (t0 + s) * NP + PC_AL + 8 * hf);
                    LAS float* d = AL + s * 16 + 8 * hf; d[0] = bf_lo(w.x); d[1] = bf_hi(w.x); d[2] = bf_lo(w.y); d[3] = bf_hi(w.y); d[4] = bf_lo(w.z); d[5] = bf_hi(w.z); d[6] = bf_lo(w.w); d[7] = bf_hi(w.w); }
#pragma unroll
                for (int i = 0; i < 2; ++i) { const int p = tid + 512 * i, row = p >> 4, c16 = p & 15; *(LAS u32x4*)(KL + row * 136 + c16 * 8) = *(const u32x4*)(P + (t0 + row) * NP + PC_K + h * 128 + c16 * 8); }
                if (tid < 256) { const int vb = tid & 31, sb = tid >> 5; u32x4 Lr[8];
#pragma unroll
                  for (int i = 0; i < 8; ++i) Lr[i] = *(const u32x4*)(P + (t0 + 8 * sb + i) * NP + PC_V + h * 256 + 8 * vb);
#pragma unroll
                  for (int j = 0; j < 8; ++j) { const unsigned sel = (j & 1) ? 0x07060302u : 0x05040100u; u32x4 w;
                      w.x = __builtin_amdgcn_perm(Lr[1][j >> 1], Lr[0][j >> 1], sel); w.y = __builtin_amdgcn_perm(Lr[3][j >> 1], Lr[2][j >> 1], sel);
                      w.z = __builtin_amdgcn_perm(Lr[5][j >> 1], Lr[4][j >> 1], sel); w.w = __builtin_amdgcn_perm(Lr[7][j >> 1], Lr[6][j >> 1], sel);
                      *(LAS u32x4*)(VT + (8 * vb + j) * 128 + ((sb ^ (vb & 7)) << 4)) = w; } }
                __syncthreads();
#pragma unroll
                for (int i = 0; i < 4; ++i) { const int q = tid + 512 * i, v = q >> 3, slot = q & 7; *(u32x4*)(VTT + ((size_t)item * 256 + v) * 64 + 8 * (slot ^ ((v >> 3) & 7))) = *(const LAS u32x4*)(VT + q * 16); }
                float cs[16]; float run = 0.f;
#pragma unroll
                for (int i = 0; i < 16; ++i) { const LAS float* al = AL + (16 * sg + i) * 16; float z = ba;
#pragma unroll
                    for (int j = 0; j < 16; ++j) z += al[j] * wa2[j];
                    const float la = -(fmaxf(-z, 0.f) + __logf(1.0f + __expf(-fabsf(z)))) * (1.0f / 16.0f); run += la; cs[i] = run; }
                CUMG[sg * 128 + dk] = run;
                __syncthreads();
                float pre = 0.f, tot = 0.f;
#pragma unroll
                for (int gq = 0; gq < 4; ++gq) { const float v = CUMG[gq * 128 + dk]; tot += v; if (gq < sg) pre += v; }
                if (sg == 0) DECB[item * 128 + dk] = __expf(tot);
                { unsigned pk[8];
#pragma unroll
                  for (int i = 0; i < 8; ++i) { const float f0 = __expf(tot - (pre + cs[2 * i])), f1 = __expf(tot - (pre + cs[2 * i + 1])); pk[i] = cvt_pk_bf16(bf2f(KL[(16 * sg + 2 * i) * 136 + dk]) * f0, bf2f(KL[(16 * sg + 2 * i + 1) * 136 + dk]) * f1); }
                  u32x4 w0, w1; w0.x = pk[0]; w0.y = pk[1]; w0.z = pk[2]; w0.w = pk[3]; w1.x = pk[4]; w1.y = pk[5]; w1.z = pk[6]; w1.w = pk[7];
                  u32x4* dst = (u32x4*)(KTT + ((size_t)item * 128 + dk) * 64 + 16 * sg); dst[0] = w0; dst[1] = w1; }
                __syncthreads();
            }
        }
        GRID_BAR();
        {
            LAS bf16* SB = (LAS bf16*)(lds + 8192);
            LAS float* OT = (LAS float*)(lds + 43008);
            LAS bf16* VTS = (LAS bf16*)(lds + 77824);
            LAS bf16* QS = (LAS bf16*)(lds + 96256);
            const int fr = lane & 15, fq = lane >> 4, mi = wave >> 1, ni = wave & 1;
            struct GlaRegs { bf16x8 af[2]; u32x4 q[2]; u32x4 vt; f32x4 dec; };
            const bool split = (G == 256);
            for (int rep = 0; rep < REP_P2; ++rep)
            if (!split || !(vcu & 1))
            for (int it = split ? (vcu >> 1) : vcu; it < 128; it += split ? 128 : G) {
                const int b = it >> 4, h = (it >> 2) & 3, vs = it & 3;
                f32x4 Sacc[4];
#pragma unroll
                for (int n = 0; n < 4; ++n) Sacc[n] = (f32x4){0.f, 0.f, 0.f, 0.f};
                GlaRegs R[3];
#define GLA_LOAD(X, cc) do { const int item_ = (b * 32 + (cc)) * 4 + h; const size_t t0_ = (size_t)b * SEQ + 64 * (cc); \
                    _Pragma("unroll") for (int ks = 0; ks < 2; ++ks) X.af[ks] = *(const bf16x8*)(KTT + ((size_t)item_ * 128 + 16 * wave + fr) * 64 + 32 * ks + 8 * fq); \
                    X.vt = *(const u32x4*)(VTT + ((size_t)item_ * 256 + vs * 64 + 8 * wave + (lane >> 3)) * 64 + 8 * (lane & 7)); \
                    _Pragma("unroll") for (int i = 0; i < 2; ++i) X.q[i] = *(const u32x4*)(P + (t0_ + 8 * wave + (lane >> 3)) * NP + PC_Q + h * 128 + 8 * (lane & 7) + 64 * i); \
                    X.dec = *(const f32x4*)(DECB + item_ * 128 + 16 * wave + 4 * fq); } while (0)
#define GLA_PUT_VT(X, cc) do { *(LAS u32x4*)(VTS + ((cc) & 1) * (64 * 72) + (8 * wave + (lane >> 3)) * 72 + 8 * (lane & 7)) = X.vt; } while (0)
                GLA_LOAD(R[0], 0); GLA_LOAD(R[1], 1); GLA_LOAD(R[2], 2);
                GLA_PUT_VT(R[0], 0);
                __syncthreads();
                for (int c0 = 0; c0 < 32; c0 += 3) {
#pragma unroll
                    for (int u = 0; u < 3; ++u) {
                        const int c = c0 + u; if (c >= 32) break;
                        const size_t t0 = (size_t)b * SEQ + 64 * c;
                        LAS bf16* SBc = SB + (c & 1) * (64 * 136); LAS bf16* QSc = QS + (c & 1) * (64 * 136); const LAS bf16* VTc = VTS + (c & 1) * (64 * 72);
#pragma unroll
                        for (int n = 0; n < 4; ++n) Sacc[n] *= R[u].dec;
#pragma unroll
                        for (int ks = 0; ks < 2; ++ks)
#pragma unroll
                            for (int n = 0; n < 4; ++n) { const bf16x8 bvf = *(const LAS bf16x8*)(VTc + (16 * n + fr) * 72 + 32 * ks + 8 * fq); Sacc[n] = __builtin_amdgcn_mfma_f32_16x16x32_bf16(R[u].af[ks], bvf, Sacc[n], 0, 0, 0); }
#pragma unroll
                        for (int n = 0; n < 4; ++n) { u32x2 w; w.x = cvt_pk_bf16(Sacc[n][0], Sacc[n][1]); w.y = cvt_pk_bf16(Sacc[n][2], Sacc[n][3]); *(LAS u32x2*)(SBc + (16 * n + fr) * 136 + 16 * wave + 4 * fq) = w; }
#pragma unroll
                        for (int i = 0; i < 2; ++i) *(LAS u32x4*)(QSc + (8 * wave + (lane >> 3)) * 136 + 8 * (lane & 7) + 64 * i) = R[u].q[i];
                        if (c + 1 < 32) GLA_PUT_VT(R[(u + 1) % 3], c + 1);
                        if (c + 3 < 32) GLA_LOAD(R[u], c + 3);
                        __syncthreads();
                        f32x4 oa[2] = {(f32x4){0.f, 0.f, 0.f, 0.f}, (f32x4){0.f, 0.f, 0.f, 0.f}};
#pragma unroll
                        for (int kk = 0; kk < 4; ++kk) { const bf16x8 qf = *(const LAS bf16x8*)(QSc + (16 * mi + fr) * 136 + 32 * kk + 8 * fq);
#pragma unroll
                            for (int n2 = 0; n2 < 2; ++n2) { const bf16x8 sf = *(const LAS bf16x8*)(SBc + (16 * (2 * ni + n2) + fr) * 136 + 32 * kk + 8 * fq); oa[n2] = __builtin_amdgcn_mfma_f32_16x16x32_bf16(qf, sf, oa[n2], 0, 0, 0); } }
                        LAS float* OTc = OT + (c & 1) * (64 * 68);
#pragma unroll
                        for (int n2 = 0; n2 < 2; ++n2)
#pragma unroll
                            for (int j = 0; j < 4; ++j) OTc[(16 * mi + 4 * fq + j) * 68 + 16 * (2 * ni + n2) + fr] = oa[n2][j] * 0.08838834764831845f;
                        if (c > 0) {
                            const LAS f32x4* op = (const LAS f32x4*)(OT + ((c - 1) & 1) * (64 * 68) + (8 * wave + (lane >> 3)) * 68 + 8 * (lane & 7)); const f32x4 ov0 = op[0], ov1 = op[1];
                            u32x4 ow; ow.x = cvt_pk_bf16(ov0[0], ov0[1]); ow.y = cvt_pk_bf16(ov0[2], ov0[3]); ow.z = cvt_pk_bf16(ov1[0], ov1[1]); ow.w = cvt_pk_bf16(ov1[2], ov1[3]);
                            *(u32x4*)(Ob + (t0 - 64 + 8 * wave + (lane >> 3)) * 1024 + h * 256 + vs * 64 + 8 * (lane & 7)) = ow; }
                    }
                }
                __syncthreads();
                { const size_t t0 = (size_t)b * SEQ + 64 * 31; const LAS f32x4* op = (const LAS f32x4*)(OT + (31 & 1) * (64 * 68) + (8 * wave + (lane >> 3)) * 68 + 8 * (lane & 7)); const f32x4 ov0 = op[0], ov1 = op[1];
                  u32x4 ow; ow.x = cvt_pk_bf16(ov0[0], ov0[1]); ow.y = cvt_pk_bf16(ov0[2], ov0[3]); ow.z = cvt_pk_bf16(ov1[0], ov1[1]); ow.w = cvt_pk_bf16(ov1[2], ov1[3]);
                  *(u32x4*)(Ob + (t0 + 8 * wave + (lane >> 3)) * 1024 + h * 256 + vs * 64 + 8 * (lane & 7)) = ow; }
                __syncthreads();
#undef GLA_LOAD
#undef GLA_PUT_VT
            }
            if (!split || (vcu & 1)) { const int hw = split ? (vcu >> 1) * NWAVES + wave : gw, nhw = split ? 128 * NWAVES : NGW;
            for (int wi = hw; wi < 2048; wi += nhw) {
                const int tb = wi >> 1, hf = wi & 1, c0 = 512 * hf + 8 * lane; const int t0 = 16 * tb;
                float w0[8], w1[8], w2[8], cb[8];
#pragma unroll
                for (int j = 0; j < 8; ++j) { w0[j] = a.conv_w[c0 + j]; w1[j] = a.conv_w[1024 + c0 + j]; w2[j] = a.conv_w[2048 + c0 + j]; cb[j] = a.conv_b[c0 + j]; }
                float y2[8], y1[8];
#pragma unroll
                for (int j = 0; j < 8; ++j) { y2[j] = 0.f; y1[j] = 0.f; }
                if ((t0 % SEQ) != 0) {
                    const bf16* pr = P + (size_t)(t0 - 2) * NP + c0; const u32x4 c2 = *(const u32x4*)(pr + PC_UC), x2 = *(const u32x4*)(pr + PC_UX), c1 = *(const u32x4*)(pr + NP + PC_UC), x1 = *(const u32x4*)(pr + NP + PC_UX);
                    y2[0] = bf_lo(c2.x) * bf_lo(x2.x); y2[1] = bf_hi(c2.x) * bf_hi(x2.x); y2[2] = bf_lo(c2.y) * bf_lo(x2.y); y2[3] = bf_hi(c2.y) * bf_hi(x2.y); y2[4] = bf_lo(c2.z) * bf_lo(x2.z); y2[5] = bf_hi(c2.z) * bf_hi(x2.z); y2[6] = bf_lo(c2.w) * bf_lo(x2.w); y2[7] = bf_hi(c2.w) * bf_hi(x2.w);
                    y1[0] = bf_lo(c1.x) * bf_lo(x1.x); y1[1] = bf_hi(c1.x) * bf_hi(x1.x); y1[2] = bf_lo(c1.y) * bf_lo(x1.y); y1[3] = bf_hi(c1.y) * bf_hi(x1.y); y1[4] = bf_lo(c1.z) * bf_lo(x1.z); y1[5] = bf_hi(c1.z) * bf_hi(x1.z); y1[6] = bf_lo(c1.w) * bf_lo(x1.w); y1[7] = bf_hi(c1.w) * bf_hi(x1.w);
                }
#pragma unroll 4
                for (int t = 0; t < 16; ++t) {
                    const bf16* pr = P + (size_t)(t0 + t) * NP + c0; const u32x4 uc = *(const u32x4*)(pr + PC_UC), ub = *(const u32x4*)(pr + PC_UB), ux = *(const u32x4*)(pr + PC_UX);
                    float y0[8], bb[8];
                    y0[0] = bf_lo(uc.x) * bf_lo(ux.x); y0[1] = bf_hi(uc.x) * bf_hi(ux.x); y0[2] = bf_lo(uc.y) * bf_lo(ux.y); y0[3] = bf_hi(uc.y) * bf_hi(ux.y); y0[4] = bf_lo(uc.z) * bf_lo(ux.z); y0[5] = bf_hi(uc.z) * bf_hi(ux.z); y0[6] = bf_lo(uc.w) * bf_lo(ux.w); y0[7] = bf_hi(uc.w) * bf_hi(ux.w);
                    bb[0] = bf_lo(ub.x); bb[1] = bf_hi(ub.x); bb[2] = bf_lo(ub.y); bb[3] = bf_hi(ub.y); bb[4] = bf_lo(ub.z); bb[5] = bf_hi(ub.z); bb[6] = bf_lo(ub.w); bb[7] = bf_hi(ub.w);
                    float z[8];
#pragma unroll
                    for (int j = 0; j < 8; ++j) { z[j] = bb[j] * (cb[j] + w0[j] * y2[j] + w1[j] * y1[j] + w2[j] * y0[j]); y2[j] = y1[j]; y1[j] = y0[j]; }
                    u32x4 w; w.x = cvt_pk_bf16(z[0], z[1]); w.y = cvt_pk_bf16(z[2], z[3]); w.z = cvt_pk_bf16(z[4], z[5]); w.w = cvt_pk_bf16(z[6], z[7]);
                    *(u32x4*)(ZA + (size_t)(t0 + t) * 1024 + c0) = w;
                }
            }
            { LAS float* scr = (LAS float*)(lds + wave * 16896);
              for (int it = hw; it < 16 * 64; it += nhw) { const int kb = it / 64, nb = it % 64; tr_item(a.w_br_a, DM, 64 * kb, 32 * nb, WA, 1024, 32 * nb, scr, lane); }
              for (int it = hw; it < 16 * 64; it += nhw) { const int kb = it / 64, nb = it % 64; tr_item(a.w_br_b, DM, 64 * kb, 32 * nb, WB, 1024, 32 * nb, scr, lane); }
              for (int it = hw; it < 32 * 64; it += nhw) { const int kb = it / 64, nb = it % 64; tr_item(a.w_out, DM, 64 * kb, 32 * nb, WO, DM, 32 * nb, scr, lane); } }
            }
#if DBG_STAGE >= 3
            moe_convert_queue(ctl + CW_Q3, NQ_MOE - NQ_TAIL - NQ_SCAN, NQ_MOE - NQ_TAIL, a.w_gate_up, a.w_down, WGU8, WD8, lane);
#endif
        }
        if (BOTH(2)) GRID_BAR();
    }

    if (IN(3)) {
        {
            f32x4 gg[4];
#pragma unroll
            for (int j = 0; j < 4; ++j) gg[j] = *((const f32x4*)(a.gla_norm_g + 16 * lane) + j);
            for (int m = gw; m < NTOK; m += NGW) {
                const u32x4* op = (const u32x4*)(Ob + (size_t)m * 1024 + 16 * lane); const u32x4 ob0 = op[0], ob1 = op[1]; f32x4 o[4]; float s = 0.f;
                o[0] = (f32x4){bf_lo(ob0.x), bf_hi(ob0.x), bf_lo(ob0.y), bf_hi(ob0.y)}; o[1] = (f32x4){bf_lo(ob0.z), bf_hi(ob0.z), bf_lo(ob0.w), bf_hi(ob0.w)};
                o[2] = (f32x4){bf_lo(ob1.x), bf_hi(ob1.x), bf_lo(ob1.y), bf_hi(ob1.y)}; o[3] = (f32x4){bf_lo(ob1.z), bf_hi(ob1.z), bf_lo(ob1.w), bf_hi(ob1.w)};
#pragma unroll
                for (int j = 0; j < 4; ++j) { s += (o[j].x * o[j].x + o[j].y * o[j].y) + (o[j].z * o[j].z + o[j].w * o[j].w); }
                s += __shfl_xor(s, 1); s += __shfl_xor(s, 2); s += __shfl_xor(s, 4); s += __shfl_xor(s, 8);
                const float rs = 1.0f / sqrtf(s * (1.0f / 256.0f) + EPS);
                const u32x4* rp = (const u32x4*)(P + (size_t)m * NP + PC_R + 16 * lane); const u32x4 r0 = rp[0], r1 = rp[1];
                float rr[16];
                rr[0] = bf_lo(r0.x); rr[1] = bf_hi(r0.x); rr[2] = bf_lo(r0.y); rr[3] = bf_hi(r0.y); rr[4] = bf_lo(r0.z); rr[5] = bf_hi(r0.z); rr[6] = bf_lo(r0.w); rr[7] = bf_hi(r0.w);
                rr[8] = bf_lo(r1.x); rr[9] = bf_hi(r1.x); rr[10] = bf_lo(r1.y); rr[11] = bf_hi(r1.y); rr[12] = bf_lo(r1.z); rr[13] = bf_hi(r1.z); rr[14] = bf_lo(r1.w); rr[15] = bf_hi(r1.w);
                float z[16];
#pragma unroll
                for (int j = 0; j < 4; ++j)
#pragma unroll
                    for (int q = 0; q < 4; ++q) { const float r = rr[4 * j + q]; z[4 * j + q] = o[j][q] * rs * gg[j][q] * (r * fast_sigmoid(r)); }
                u32x4 w0, w1; w0.x = cvt_pk_bf16(z[0], z[1]); w0.y = cvt_pk_bf16(z[2], z[3]); w0.z = cvt_pk_bf16(z[4], z[5]); w0.w = cvt_pk_bf16(z[6], z[7]);
                w1.x = cvt_pk_bf16(z[8], z[9]); w1.y = cvt_pk_bf16(z[10], z[11]); w1.z = cvt_pk_bf16(z[12], z[13]); w1.w = cvt_pk_bf16(z[14], z[15]);
                u32x4* zp = (u32x4*)(ZB + (size_t)m * 1024 + 16 * lane); zp[0] = w0; zp[1] = w1;
            }
        }
        if (BOTH(3)) GRID_BAR();
    }

    if (IN(4)) {
        { pg8::Gemm g{ZA, WA, 2048, ZB, WB, nullptr}; pg8::StaticOrder S; S.init(NTOK / 256, DM / 256, G, bx); pg8::EpiGate2 E{G8, MIX}; pg8::gemm_phase<false, 2, false>(lds, g, S, E); }
        if (BOTH(4)) GRID_BAR();
    }

    if (IN(6)) {
        pg8::Gemm g{MIX, WO, 2 * DM, nullptr, nullptr, nullptr}; pg8::StaticOrder S; S.init(NTOK / 256, DM / 256, G, bx); pg8::EpiResF32 E{a.x, X1};
        pg8::gemm_phase<false, 1, false>(lds, g, S, E);
        if (BOTH(6)) GRID_BAR();
    }
#endif

#if DBG_STAGE >= 3
    if (IN(7)) {
        for (int i = gw * 64 + lane; i < MAXSLOT; i += NGW * 64) slot_tok[i] = 0;
        LAS float* comb = (LAS float*)(lds);
        LAS float* lgb = (LAS float*)(lds + 16384);
        LAS int* hist = (LAS int*)(lds + 40960);
        const int r16 = lane & 15, kq = lane >> 4, gi = wave & 3, kh = wave >> 2;
        for (int rg0 = 0; rg0 < 1024; rg0 += 4 * G) {
            const int rg = rg0 + gi * G + vcu; const bool active = rg < 1024;
            const size_t row = (size_t)(active ? rg : 0) * 16 + r16;
            const f32x4* xp = (const f32x4*)(X1 + row * DM + 8 * kq); const f32x4* gp = (const f32x4*)(a.norm_ffn_g + 8 * kq);
            unsigned* hp = (unsigned*)(H8 + row * DM + 8 * kq);
            f32x4 acc0 = (f32x4){0.f, 0.f, 0.f, 0.f}, acc1 = (f32x4){0.f, 0.f, 0.f, 0.f}; float ssq = 0.f;
            for (int h = 0; h < 2; ++h) {
                { const u32x4* src = (const u32x4*)WRF + (size_t)h * 8192 + tid; LAS u32x4* dst = (LAS u32x4*)lds + tid;
#pragma unroll
                  for (int i = 0; i < 16; ++i) dst[512 * i] = src[512 * i]; }
                __syncthreads();
                if (active) {
                    const LAS f32x4* wl = (const LAS f32x4*)lds + (size_t)(2 * 32 * kh) * 64 + lane;
                    const int jb = 64 * h + 32 * kh;
#pragma unroll 4
                    for (int jj = 0; jj < 32; ++jj) { const int j = jb + jj;
                        const int ko = 8 * (j >> 1) + (j & 1);
                        const f32x4 av = xp[ko], gv = gp[ko], b0 = wl[(2 * jj) * 64], b1 = wl[(2 * jj + 1) * 64];
                        ssq += (av.x * av.x + av.y * av.y) + (av.z * av.z + av.w * av.w);
                        hp[ko] = pk4_fp8(av.x * gv.x * 16.0f, av.y * gv.y * 16.0f, av.z * gv.z * 16.0f, av.w * gv.w * 16.0f);
                        acc0 = __builtin_amdgcn_mfma_f32_16x16x4f32(av.x, b0.x, acc0, 0, 0, 0); acc1 = __builtin_amdgcn_mfma_f32_16x16x4f32(av.x, b1.x, acc1, 0, 0, 0);
                        acc0 = __builtin_amdgcn_mfma_f32_16x16x4f32(av.y, b0.y, acc0, 0, 0, 0); acc1 = __builtin_amdgcn_mfma_f32_16x16x4f32(av.y, b1.y, acc1, 0, 0, 0);
                        acc0 = __builtin_amdgcn_mfma_f32_16x16x4f32(av.z, b0.z, acc0, 0, 0, 0); acc1 = __builtin_amdgcn_mfma_f32_16x16x4f32(av.z, b1.z, acc1, 0, 0, 0);
                        acc0 = __builtin_amdgcn_mfma_f32_16x16x4f32(av.w, b0.w, acc0, 0, 0, 0); acc1 = __builtin_amdgcn_mfma_f32_16x16x4f32(av.w, b1.w, acc1, 0, 0, 0); }
                }
                __syncthreads();
            }
            ssq += __shfl_xor(ssq, 16); ssq += __shfl_xor(ssq, 32);
            if (kh == 1) { LAS float* c = comb + (gi * 64 + lane) * 12;
#pragma unroll
                for (int j = 0; j < 4; ++j) { c[j] = acc0[j]; c[4 + j] = acc1[j]; }
                c[8] = ssq; }
            if (tid < 64) hist[tid] = 0;
            __syncthreads();
            int te[4] = {0, 0, 0, 0}, lr[4] = {0, 0, 0, 0}; float tw[4] = {0.f, 0.f, 0.f, 0.f}; float rs = 0.f;
            if (active && kh == 0) {
                const LAS float* c = comb + (gi * 64 + lane) * 12;
#pragma unroll
                for (int j = 0; j < 4; ++j) { acc0[j] += c[j]; acc1[j] += c[4 + j]; }
                ssq += c[8];
                rs = 1.0f / sqrtf(ssq * (1.0f / DM) + EPS);
                LAS float* lg = lgb + gi * (16 * 36);
#pragma unroll
                for (int j = 0; j < 4; ++j) { lg[(4 * kq + j) * 36 + r16] = acc0[j]; lg[(4 * kq + j) * 36 + 16 + r16] = acc1[j]; }
                LDS_WAIT(); asm volatile("" ::: "memory");
                if (lane < 16) {
                    float l[32];
#pragma unroll
                    for (int n = 0; n < 32; ++n) l[n] = lg[lane * 36 + n] * rs + a.b_router[n];
                    float tv[4];
#pragma unroll
                    for (int k = 0; k < 4; ++k) { float bv = -3.0e38f; int bi = 0;
#pragma unroll
                        for (int n = 0; n < 32; ++n) if (l[n] > bv) { bv = l[n]; bi = n; }
                        tv[k] = bv; te[k] = bi;
#pragma unroll
                        for (int n = 0; n < 32; ++n) l[n] = (n == bi) ? -3.0e38f : l[n]; }
                    float den = 0.f;
#pragma unroll
                    for (int k = 0; k < 4; ++k) { tw[k] = expf(tv[k] - tv[0]); den += tw[k]; }
                    const float inv = 1.0f / den;
#pragma unroll
                    for (int k = 0; k < 4; ++k) { tw[k] *= inv; lr[k] = __hip_atomic_fetch_add(&hist[te[k]], 1, __ATOMIC_RELAXED, __HIP_MEMORY_SCOPE_WORKGROUP); }
                }
            }
            __syncthreads();
            if (tid < 32) { const int c = hist[tid]; hist[32 + tid] = c ? (int)__hip_atomic_fetch_add(ctl + CW_CNT + 64 * tid, (unsigned)c, RLX_AGENT) : 0; }
            __syncthreads();
            if (active && kh == 0 && lane < 16) { const size_t orow = (size_t)rg * 16 + lane;
#pragma unroll
                for (int k = 0; k < 4; ++k) { tk_e[orow * 4 + k] = te[k]; tk_rank[orow * 4 + k] = hist[32 + te[k]] + lr[k]; tk_w[orow * 4 + k] = tw[k]; }
                rs_tok[orow] = rs; }
            __syncthreads();
        }
        if (BOTH(7)) GRID_BAR();
    }

    if (IN(8)) {
        if (tid == 0) { int ps = 0, mt = 0;
            for (int e = 0; e < NE; ++e) { const int c = (int)__hip_atomic_load(ctl + CW_CNT + 64 * e, RLX_AGENT); pstart[e] = ps; const int nt = (c + 255) >> 8; for (int i = 0; i < nt; ++i) tile_e[mt + i] = e; mt += nt; ps += nt << 8; }
            pstart[NE] = ps; MISC[16] = (unsigned)mt; }
        __syncthreads();
        for (int p0 = gw * 64; p0 < NTOK * 4; p0 += NGW * 64) { const int p = p0 + lane;
            const int tok = p >> 2; const int e = tk_e[p], rk = tk_rank[p]; const int slot = pstart[e] + rk;
            { tk_slot[p] = slot; slot_w[slot] = tk_w[p]; slot_rs[slot] = rs_tok[tok]; slot_tok[slot] = tok; }
        }
        if (BOTH(8)) GRID_BAR();
    }

    if (IN(9)) {
        const int MT = (int)MISC[16];
        LAS int* tokt = (LAS int*)(lds + TOKT_OFF);
        const int ng9 = (G == 256) ? NG9 : G;
        if (bx < ng9) {
        pg8::GroupedOrder S; S.init(MT, 16, ng9, bx); S.tile_e = tile_e;
        { pg8::Unit u; for (int i = 0; i < TOKT_UNITS && S.next(i, u); ++i) if (tid < 256) tokt[i * 256 + tid] = slot_tok[u.pm * 256 + tid]; }
        __syncthreads();
        pg8::Gemm g{H8, WGU8, DM, nullptr, nullptr, tokt}; pg8::EpiSwiglu8 E{a.b_gate_up, slot_rs, ACT8};
        pg8::gemm_phase<true, 1, true>(lds, g, S, E);
        }
        moe_convert_queue(ctl + CW_Q2, NQ_MOE - NQ_TAIL, NQ_MOE, a.w_gate_up, a.w_down, WGU8, WD8, lane);
        if (BOTH(9)) GRID_BAR();
    }
    if (IN(10)) {
        const int MT = (int)MISC[16];
        pg8::Gemm g{ACT8, WD8, DFF, nullptr, nullptr, nullptr}; pg8::GroupedOrder S; S.init(MT, 8, G, bx); S.tile_e = tile_e; pg8::EpiDown8 E{a.b_down, slot_w, YS8};
        pg8::gemm_phase<true, 1, false>(lds, g, S, E);
        if (BOTH(10)) GRID_BAR();
    }
#endif

    if (IN(11)) {
        f32x4 gv[8];
#pragma unroll
        for (int j = 0; j < 8; ++j) gv[j] = *((const f32x4*)a.norm_final_g + lane + 64 * j);
        for (int m = gw; m < NTOK; m += NGW) {
#if DBG_STAGE >= 1
            const f32x4* xr = (const f32x4*)(X1 + (size_t)m * DM) + lane;
#else
            const f32x4* xr = (const f32x4*)(a.x + (size_t)m * DM) + lane;
#endif
            f32x4 v[8];
#pragma unroll
            for (int j = 0; j < 8; ++j) v[j] = xr[64 * j];
#if DBG_STAGE >= 3
#pragma unroll
            for (int k = 0; k < 4; ++k) { const int slot = tk_slot[m * 4 + k]; const unsigned* yp = (const unsigned*)(YS8 + (size_t)slot * DM) + lane;
#pragma unroll
                for (int j = 0; j < 8; ++j) { const int w = (int)yp[64 * j]; const f32x2 lo = __builtin_amdgcn_cvt_pk_f32_fp8(w, false), hi = __builtin_amdgcn_cvt_pk_f32_fp8(w, true);
                    v[j].x += lo.x * (1.0f / 64.0f); v[j].y += lo.y * (1.0f / 64.0f); v[j].z += hi.x * (1.0f / 64.0f); v[j].w += hi.y * (1.0f / 64.0f); } }
#endif
            float s = 0.f;
#pragma unroll
            for (int j = 0; j < 8; ++j) s += (v[j].x * v[j].x + v[j].y * v[j].y) + (v[j].z * v[j].z + v[j].w * v[j].w);
            const float rs = 1.0f / sqrtf(wave_sum(s) * (1.0f / DM) + EPS);
            f32x4* o = (f32x4*)(a.out + (size_t)m * DM) + lane;
#pragma unroll
            for (int j = 0; j < 8; ++j) o[64 * j] = v[j] * rs * gv[j];
        }
    }
#undef IN
#undef BOTH
#undef GRID_BAR
}

extern "C" void kernel_launch(void* const* d_in, const int* in_sizes, int n_in, void* d_out, int out_size, void* d_ws, size_t ws_size, hipStream_t stream) {
    static int grid = 0;
    if (grid == 0) {
        if (n_in != 19 || in_sizes[0] != NTOK * DM || out_size != NTOK * DM || ws_size < WS_END) { fprintf(stderr, "kernel_launch: unexpected shapes (n_in %d, in0 %d, out %d, ws %zu); nothing launched\n", n_in, n_in > 0 ? in_sizes[0] : -1, out_size, ws_size); grid = -1; return; }
        int dev = 0, cus = 0, per_cu = 0;
        if (hipGetDevice(&dev) != hipSuccess || hipDeviceGetAttribute(&cus, hipDeviceAttributeMultiprocessorCount, dev) != hipSuccess) { grid = -1; return; }
        if (hipFuncSetAttribute((const void*)mega_fwd, hipFuncAttributeMaxDynamicSharedMemorySize, LDS_BYTES) != hipSuccess) { fprintf(stderr, "kernel_launch: hipFuncSetAttribute failed\n"); grid = -1; return; }
        if (hipOccupancyMaxActiveBlocksPerMultiprocessor(&per_cu, (const void*)mega_fwd, NWAVES * 64, LDS_BYTES) != hipSuccess || per_cu < 1) { fprintf(stderr, "kernel_launch: occupancy query reports %d blocks per CU\n", per_cu); per_cu = 1; }
        (void)hipGetLastError();
        grid = cus;
    }
    if (grid < 0) return;
    if (hipMemsetAsync((char*)d_ws + WS_CTL, 0, CTL_ZERO_BYTES, stream) != hipSuccess) { fprintf(stderr, "kernel_launch: memset failed\n"); return; }
    Args a{};
    a.x = (const float*)d_in[0]; a.norm_mix_g = (const float*)d_in[1]; a.w_in = (const float*)d_in[2]; a.conv_w = (const float*)d_in[3]; a.conv_b = (const float*)d_in[4]; a.w_a2 = (const float*)d_in[5];
    a.b_a = (const float*)d_in[6]; a.gla_norm_g = (const float*)d_in[7]; a.w_br_a = (const float*)d_in[8]; a.w_br_b = (const float*)d_in[9]; a.w_out = (const float*)d_in[10]; a.norm_ffn_g = (const float*)d_in[11];
    a.w_router = (const float*)d_in[12]; a.b_router = (const float*)d_in[13]; a.w_gate_up = (const float*)d_in[14]; a.b_gate_up = (const float*)d_in[15]; a.w_down = (const float*)d_in[16]; a.b_down = (const float*)d_in[17];
    a.norm_final_g = (const float*)d_in[18]; a.out = (float*)d_out; a.ws = (unsigned char*)d_ws; a.ph_lo = 0; a.ph_hi = 12;
    hipLaunchKernelGGL(mega_fwd, dim3(grid), dim3(NWAVES * 64), LDS_BYTES, stream, a);
    const hipError_t le = hipPeekAtLastError();
    if (le != hipSuccess) fprintf(stderr, "kernel_launch: launch failed: %s\n", hipGetErrorName(le));
}
```

```cpp
#include <hip/hip_runtime.h>
#include <cstdio>
#include <cstdint>

#ifndef DBG_STAGE
#define DBG_STAGE 3
#endif

#ifndef REP_P0
#define REP_P0 1
#endif
#ifndef REP_P2
#define REP_P2 1
#endif
#define LAS __attribute__((address_space(3)))
#define GAS __attribute__((address_space(1)))
typedef unsigned short bf16;
typedef short bf16x8 __attribute__((ext_vector_type(8)));
typedef float f32x4 __attribute__((ext_vector_type(4)));
typedef float f32x2 __attribute__((ext_vector_type(2)));
typedef unsigned u32x4 __attribute__((ext_vector_type(4)));
typedef unsigned u32x2 __attribute__((ext_vector_type(2)));

constexpr int NTOK = 16384, DM = 2048, SEQ = 2048, NBATCH = 8;
constexpr int NP = 10496;
constexpr int PC_UC = 0, PC_UB = 1024, PC_UX = 2048, PC_Q = 3072, PC_K = 3584, PC_V = 4096, PC_R = 5120, PC_AL = 6144, PC_GA = 6400, PC_GB = 8448;
constexpr int SRC_AL = 6144;
constexpr int DIN = 10256;
constexpr int NE = 32, TOPK = 4, DFF = 2048;
constexpr int MAXSLOT = NTOK * TOPK + NE * 256;
constexpr int MAXMT = MAXSLOT / 256;
constexpr float EPS = 1e-6f;

constexpr size_t MiB = 1u << 20;
constexpr size_t WS_CTL = 0, CTL_ZERO_BYTES = 1 * MiB;
constexpr size_t WS_WRF = 1 * MiB;
constexpr size_t WS_TK = 2 * MiB;
constexpr size_t WS_SLOT = 4 * MiB;
constexpr size_t WS_WIN = 8 * MiB;
constexpr size_t WS_WA = 50 * MiB;
constexpr size_t WS_WB = 54 * MiB;
constexpr size_t WS_WO = 58 * MiB;
constexpr size_t WS_WGU = 66 * MiB;
constexpr size_t WS_WD = 578 * MiB;
constexpr size_t WS_H = 834 * MiB;
constexpr size_t WS_P = 898 * MiB;
constexpr size_t WS_ZA = 1226 * MiB;
constexpr size_t WS_ZB = 1258 * MiB;
constexpr size_t WS_O = 1290 * MiB;
constexpr size_t WS_YA = 1354 * MiB;
constexpr size_t WS_MIX = 1418 * MiB;
constexpr size_t WS_X1 = 1482 * MiB;
constexpr size_t WS_XB = 1610 * MiB;
constexpr size_t WS_ACT = 1898 * MiB;
constexpr size_t WS_YS = 2186 * MiB;
constexpr size_t WS_KTT = 2474 * MiB;
constexpr size_t WS_DEC = 2490 * MiB;
constexpr size_t WS_VTT = 2492 * MiB;
constexpr size_t WS_WIN8 = 2524 * MiB;
constexpr size_t WS_HQ8 = 2532 * MiB;
constexpr size_t WS_END = 2564 * MiB;
constexpr int CW_BAR = 4096;
constexpr int CW_Q3 = 8320;
constexpr int CW_Q2 = 8256;
constexpr int CW_Q = 8192;
constexpr int NGEMM = 208, QBATCH = 8;
constexpr int CW_CNT = 16384;

constexpr int RING_BYTES = 131072;
constexpr int TOKT_OFF = 131072, TOKT_UNITS = 30;
constexpr int LDSCTL_OFF = 161792;
constexpr int MISC_OFF = LDSCTL_OFF;
constexpr int TILEE_OFF = LDSCTL_OFF + 128;
constexpr int PSTART_OFF = TILEE_OFF + 4 * 320;
constexpr int LDS_BYTES = 163840;
constexpr int NWAVES = 8;

#define LDS_WAIT() asm volatile("s_waitcnt lgkmcnt(0)" ::: "memory")
#define VM_WAIT() asm volatile("s_waitcnt vmcnt(0)" ::: "memory")
#define RLX_AGENT __ATOMIC_RELAXED, __HIP_MEMORY_SCOPE_AGENT

typedef __bf16 bf16x2_t __attribute__((ext_vector_type(2)));
__device__ __forceinline__ unsigned cvt_pk_bf16(float lo, float hi) { f32x2 v = {lo, hi}; bf16x2_t b = __builtin_convertvector(v, bf16x2_t); return __builtin_bit_cast(unsigned, b); }
__device__ __forceinline__ float clamp448(float x) { return __builtin_amdgcn_fmed3f(x, -448.0f, 448.0f); }
__device__ __forceinline__ unsigned pk4_fp8(float a, float b, float c, float d) {
    int w = 0; w = __builtin_amdgcn_cvt_pk_fp8_f32(clamp448(a), clamp448(b), w, false); w = __builtin_amdgcn_cvt_pk_fp8_f32(clamp448(c), clamp448(d), w, true); return (unsigned)w; }
__device__ __forceinline__ float bf_lo(unsigned w) { return __uint_as_float(w << 16); }
__device__ __forceinline__ float bf_hi(unsigned w) { return __uint_as_float(w & 0xffff0000u); }
__device__ __forceinline__ float bf2f(bf16 b) { return __uint_as_float(((unsigned)b) << 16); }
__device__ __forceinline__ float fast_sigmoid(float x) { return __builtin_amdgcn_rcpf(1.0f + __builtin_amdgcn_exp2f(-1.44269504089f * x)); }
__device__ __forceinline__ float wave_sum(float v) {
#pragma unroll
    for (int o = 1; o < 64; o <<= 1) v += __shfl_xor(v, o);
    return v;
}

namespace pg8 {
constexpr int BM = 256, BK = 64, HALF = 128, HTB = HALF * BK * 2, STAGE_BYTES = 8 * HTB, NXCD = 8, WGM = 8;
__host__ __device__ __forceinline__ int lds_byte(int r, int c) { const int st = (r >> 4) * 2 + (c >> 5), rr = r & 15, cc = c & 31, ob = rr * 64 + cc * 2; return st * 1024 + (ob ^ (((ob >> 9) & 1) << 5)); }
__host__ __device__ __forceinline__ void stage_rc(int b, int& R, int& C) { const int st = b / 1024, sb = b % 1024, swz = sb ^ (((sb >> 9) & 1) << 5); R = (st >> 1) * 16 + swz / 64; C = (st & 1) * 32 + (swz % 64) / 2; }
__host__ __device__ __forceinline__ int perm32(int rho) { const int n = rho >> 4, i = rho & 15; return 8 * (i >> 2) + 4 * n + (i & 3); }

struct Unit { int pm, pn, pb, e; };
struct Gemm { const void* A; const void* Bt; int ldb; const void* A2; const void* Bt2; const LAS int* tokt; };

struct StaticOrder {
    int nM, nN, nwg, G, c, wgm;
    __device__ void init(int nM_, int nN_, int G_, int c_, int wgm_ = WGM) { nM = nM_; nN = nN_; nwg = nM * nN; G = G_; c = c_; wgm = wgm_; }
    __device__ __forceinline__ bool tile(int i, int& pm, int& pn) const {
        const long L = (long)i * G + c; if (L >= nwg) return false;
        int wgid = (int)L; { const int q = nwg / NXCD, r = nwg % NXCD, xcd = wgid % NXCD, off = wgid / NXCD; wgid = (xcd < r ? xcd * (q + 1) : r * (q + 1) + (xcd - r) * q) + off; }
        const int nig = wgm * nN, gid = wgid / nig, fm = gid * wgm, gsz = (nM - fm) < wgm ? (nM - fm) : wgm;
        pm = fm + ((wgid % nig) % gsz); pn = (wgid % nig) / gsz; return true;
    }
    __device__ __forceinline__ bool next(int i, Unit& u) const { if (!tile(i, u.pm, u.pn)) return false; u.pb = u.pn; u.e = 0; return true; }
};
struct GroupedOrder : StaticOrder {
    const LAS int* tile_e;
    __device__ __forceinline__ bool next(int i, Unit& u) const { if (!tile(i, u.pm, u.pn)) return false; u.e = tile_e[u.pm]; u.pb = u.e * nN + u.pn; return true; }
};

struct EpiPlainBf16 {
    static constexpr bool HASPRE = false; struct Pre {};
    static constexpr bool PERM = true;
    bf16* O; int ldc; int colbase; float scale;
    __device__ __forceinline__ void operator()(const f32x4 (&acc)[2][2][4][2], const Unit& u, int wr, int wc, int fr, int fq) const {
        const int row0 = u.pm * BM + wr * 64 + fr, col0 = colbase + u.pn * BM + wc * 32 + 8 * fq;
#pragma unroll
        for (int ai = 0; ai < 2; ++ai)
#pragma unroll
            for (int m = 0; m < 4; ++m) { bf16* rowp = O + (size_t)(row0 + ai * HALF + m * 16) * ldc + col0;
#pragma unroll
                for (int bj = 0; bj < 2; ++bj) { const f32x4 v0 = acc[ai][bj][m][0] * scale, v1 = acc[ai][bj][m][1] * scale;
                    u32x4 w; w.x = cvt_pk_bf16(v0[0], v0[1]); w.y = cvt_pk_bf16(v0[2], v0[3]); w.z = cvt_pk_bf16(v1[0], v1[1]); w.w = cvt_pk_bf16(v1[2], v1[3]);
                    *(u32x4*)(rowp + bj * HALF) = w; } }
    }
};
struct EpiPlainFp8 {
    static constexpr bool HASPRE = false; struct Pre {};
    static constexpr bool PERM = true;
    unsigned char* O8; int ldc; float scale;
    __device__ __forceinline__ void operator()(const f32x4 (&acc)[2][2][4][2], const Unit& u, int wr, int wc, int fr, int fq) const {
        const int row0 = u.pm * BM + wr * 64 + fr, col0 = u.pn * BM + wc * 32 + 8 * fq;
#pragma unroll
        for (int ai = 0; ai < 2; ++ai)
#pragma unroll
            for (int m = 0; m < 4; ++m) { unsigned char* rowp = O8 + (size_t)(row0 + ai * HALF + m * 16) * ldc + col0;
#pragma unroll
                for (int bj = 0; bj < 2; ++bj) { const f32x4 v0 = acc[ai][bj][m][0] * scale, v1 = acc[ai][bj][m][1] * scale;
                    u32x2 w; w.x = pk4_fp8(v0[0], v0[1], v0[2], v0[3]); w.y = pk4_fp8(v1[0], v1[1], v1[2], v1[3]);
                    *(u32x2*)(rowp + bj * HALF) = w; } }
    }
};
struct EpiGate2 {
    static constexpr bool HASPRE = false; struct Pre {};
    static constexpr bool PERM = true;
    const unsigned char* G8; bf16* O;
    __device__ __forceinline__ void mid(f32x4 (&acc)[2][2][4][2], const Unit& u, int wr, int wc, int fr, int fq) const {
        int opq = 0; asm volatile("" : "+v"(opq));
        const int row0 = u.pm * BM + wr * 64 + fr + opq, col0 = u.pn * BM + wc * 32 + 8 * fq;
#pragma unroll
        for (int ai = 0; ai < 2; ++ai)
#pragma unroll
            for (int m = 0; m < 4; ++m) { const size_t row = (size_t)(row0 + ai * HALF + m * 16);
#pragma unroll
                for (int bj = 0; bj < 2; ++bj) { const int col = col0 + bj * HALF;
                    const u32x2 ga = *(const u32x2*)(G8 + row * 4096 + col), gb = *(const u32x2*)(G8 + row * 4096 + 2048 + col);
#pragma unroll
                    for (int q = 0; q < 4; ++q) {
                        const int gaw_ = (int)(q < 2 ? ga.x : ga.y), gbw_ = (int)(q < 2 ? gb.x : gb.y);
                        const f32x2 a2 = (q & 1) ? __builtin_amdgcn_cvt_pk_f32_fp8(gaw_, true) : __builtin_amdgcn_cvt_pk_f32_fp8(gaw_, false), b2 = (q & 1) ? __builtin_amdgcn_cvt_pk_f32_fp8(gbw_, true) : __builtin_amdgcn_cvt_pk_f32_fp8(gbw_, false);
                        const float r0 = (1.0f + __builtin_amdgcn_exp2f(-0.0901684400556f * b2.x)) * __builtin_amdgcn_rcpf(1.0f + __builtin_amdgcn_exp2f(-0.0901684400556f * a2.x));
                        const float r1 = (1.0f + __builtin_amdgcn_exp2f(-0.0901684400556f * b2.y)) * __builtin_amdgcn_rcpf(1.0f + __builtin_amdgcn_exp2f(-0.0901684400556f * a2.y));
                        acc[ai][bj][m][q >> 1][2 * (q & 1)] *= r0; acc[ai][bj][m][q >> 1][2 * (q & 1) + 1] *= r1; } }
                asm volatile("" ::: "memory"); }
    }
    __device__ __forceinline__ void operator()(const f32x4 (&acc)[2][2][4][2], const Unit& u, int wr, int wc, int fr, int fq) const {
        const int row0 = u.pm * BM + wr * 64 + fr, col0 = u.pn * BM + wc * 32 + 8 * fq;
#pragma unroll
        for (int ai = 0; ai < 2; ++ai)
#pragma unroll
            for (int m = 0; m < 4; ++m) { const size_t row = (size_t)(row0 + ai * HALF + m * 16);
#pragma unroll
                for (int bj = 0; bj < 2; ++bj) { const int col = col0 + bj * HALF;
                    const u32x2 g = *(const u32x2*)(G8 + row * 4096 + 2048 + col);
                    f32x4 v0 = acc[ai][bj][m][0], v1 = acc[ai][bj][m][1];
                    { const f32x2 g0 = __builtin_amdgcn_cvt_pk_f32_fp8((int)g.x, false), g1 = __builtin_amdgcn_cvt_pk_f32_fp8((int)g.x, true), g2 = __builtin_amdgcn_cvt_pk_f32_fp8((int)g.y, false), g3 = __builtin_amdgcn_cvt_pk_f32_fp8((int)g.y, true);
                      v0[0] *= fast_sigmoid(0.0625f * g0.x); v0[1] *= fast_sigmoid(0.0625f * g0.y); v0[2] *= fast_sigmoid(0.0625f * g1.x); v0[3] *= fast_sigmoid(0.0625f * g1.y);
                      v1[0] *= fast_sigmoid(0.0625f * g2.x); v1[1] *= fast_sigmoid(0.0625f * g2.y); v1[2] *= fast_sigmoid(0.0625f * g3.x); v1[3] *= fast_sigmoid(0.0625f * g3.y); }
                    u32x4 w; w.x = cvt_pk_bf16(v0[0], v0[1]); w.y = cvt_pk_bf16(v0[2], v0[3]); w.z = cvt_pk_bf16(v1[0], v1[1]); w.w = cvt_pk_bf16(v1[2], v1[3]);
                    *(u32x4*)(O + row * DM + col) = w; } }
    }
};
struct EpiResF32 {
    static constexpr bool HASPRE = false; struct Pre {};
    static constexpr bool PERM = false;
    const float* base; float* C;
    __device__ __forceinline__ void operator()(const f32x4 (&acc)[2][2][4][2], const Unit& u, int wr, int wc, int fr, int fq) const {
        const int row0 = u.pm * BM + wr * 64 + fr, col0 = u.pn * BM + wc * 32 + 4 * fq;
#pragma unroll
        for (int ai = 0; ai < 2; ++ai)
#pragma unroll
            for (int m = 0; m < 4; ++m) { const size_t off = (size_t)(row0 + ai * HALF + m * 16) * DM + col0;
#pragma unroll
                for (int bj = 0; bj < 2; ++bj)
#pragma unroll
                    for (int n = 0; n < 2; ++n) { const f32x4 b = *(const f32x4*)(base + off + bj * HALF + n * 16); *(f32x4*)(C + off + bj * HALF + n * 16) = acc[ai][bj][m][n] + b; } }
    }
};
struct EpiSwiglu8 {
    static constexpr bool PERM = true;
    static constexpr bool HASPRE = true;
    struct Pre { f32x4 bg0, bg1, bu0, bu1; float rs[4]; };
    const float* bgu; const float* slot_rs; unsigned char* ACT8;
    __device__ __forceinline__ void prefetch(Pre& p, const Unit& u, int wr, int wc, int fr, int fq) const {
        const int row0 = u.pm * BM + wr * 64 + fr, cl = u.pn * HALF + wc * 32 + 8 * fq;
        const float* bg = bgu + (size_t)u.e * (2 * DFF) + cl;
        p.bg0 = *(const f32x4*)(bg); p.bg1 = *(const f32x4*)(bg + 4); p.bu0 = *(const f32x4*)(bg + DFF); p.bu1 = *(const f32x4*)(bg + DFF + 4);
#pragma unroll
        for (int m = 0; m < 4; ++m) p.rs[m] = slot_rs[(size_t)(row0 + m * 16)];
    }
    __device__ __forceinline__ void operator()(const f32x4 (&acc)[2][2][4][2], const Unit& u, int wr, int wc, int fr, int fq, const Pre& p) const {
        const int row0 = u.pm * BM + wr * 64 + fr, cl = u.pn * HALF + wc * 32 + 8 * fq;
        const f32x4 bg0 = p.bg0, bg1 = p.bg1, bu0 = p.bu0, bu1 = p.bu1;
        float rs1[4];
#pragma unroll
        for (int m = 0; m < 4; ++m) rs1[m] = slot_rs[(size_t)(row0 + HALF + m * 16)];
#pragma unroll
        for (int ai = 0; ai < 2; ++ai)
#pragma unroll
            for (int m = 0; m < 4; ++m) { const size_t row = (size_t)(row0 + ai * HALF + m * 16); const float rs = (ai ? rs1[m] : p.rs[m]) * (1.0f / 16384.0f);
                const f32x4 g0 = acc[ai][0][m][0] * rs + bg0, g1 = acc[ai][0][m][1] * rs + bg1, u0 = acc[ai][1][m][0] * rs + bu0, u1 = acc[ai][1][m][1] * rs + bu1;
                float o[8];
#pragma unroll
                for (int j = 0; j < 4; ++j) {
                    float g = fminf(g0[j], 7.0f), up = __builtin_amdgcn_fmed3f(u0[j], -7.0f, 7.0f);
                    o[j] = (up * 4.0f + 4.0f) * (g * __builtin_amdgcn_rcpf(1.0f + __builtin_amdgcn_exp2f(-2.45546696f * g)));
                    g = fminf(g1[j], 7.0f); up = __builtin_amdgcn_fmed3f(u1[j], -7.0f, 7.0f);
                    o[4 + j] = (up * 4.0f + 4.0f) * (g * __builtin_amdgcn_rcpf(1.0f + __builtin_amdgcn_exp2f(-2.45546696f * g))); }
                u32x2 w; { int t_ = 0; t_ = __builtin_amdgcn_cvt_pk_fp8_f32(o[0], o[1], t_, false); t_ = __builtin_amdgcn_cvt_pk_fp8_f32(o[2], o[3], t_, true); w.x = (unsigned)t_;
                           t_ = 0; t_ = __builtin_amdgcn_cvt_pk_fp8_f32(o[4], o[5], t_, false); t_ = __builtin_amdgcn_cvt_pk_fp8_f32(o[6], o[7], t_, true); w.y = (unsigned)t_; }
                *(u32x2*)(ACT8 + row * DFF + cl) = w; }
    }
};
struct EpiDown8 {
    static constexpr bool PERM = true;
    static constexpr bool HASPRE = true;
    struct Pre { f32x4 bv[2][2]; float sw[8]; };
    const float* bd; const float* slot_w; unsigned char* YS8;
    __device__ __forceinline__ void prefetch(Pre& p, const Unit& u, int wr, int wc, int fr, int fq) const {
        const int row0 = u.pm * BM + wr * 64 + fr, col0 = u.pn * BM + wc * 32 + 8 * fq;
        const float* bp = bd + (size_t)u.e * DM + col0;
#pragma unroll
        for (int bj = 0; bj < 2; ++bj)
#pragma unroll
            for (int n = 0; n < 2; ++n) p.bv[bj][n] = *(const f32x4*)(bp + bj * HALF + 4 * n);
#pragma unroll
        for (int ai = 0; ai < 2; ++ai)
#pragma unroll
            for (int m = 0; m < 4; ++m) p.sw[ai * 4 + m] = slot_w[(size_t)(row0 + ai * HALF + m * 16)];
    }
    __device__ __forceinline__ void operator()(const f32x4 (&acc)[2][2][4][2], const Unit& u, int wr, int wc, int fr, int fq, const Pre& p) const {
        const int row0 = u.pm * BM + wr * 64 + fr, col0 = u.pn * BM + wc * 32 + 8 * fq;
#pragma unroll
        for (int ai = 0; ai < 2; ++ai)
#pragma unroll
            for (int m = 0; m < 4; ++m) { const size_t row = (size_t)(row0 + ai * HALF + m * 16); const float sw = p.sw[ai * 4 + m] * 64.0f;
#pragma unroll
                for (int bj = 0; bj < 2; ++bj) { const f32x4 v0 = (acc[ai][bj][m][0] * (1.0f / 4096.0f) + p.bv[bj][0]) * sw, v1 = (acc[ai][bj][m][1] * (1.0f / 4096.0f) + p.bv[bj][1]) * sw;
                    u32x2 w; w.x = pk4_fp8(v0[0], v0[1], v0[2], v0[3]); w.y = pk4_fp8(v1[0], v1[1], v1[2], v1[3]);
                    *(u32x2*)(YS8 + row * DM + col0 + bj * HALF) = w; } }
    }
};

typedef int v4i_t __attribute__((ext_vector_type(4)));
typedef int v8i_t __attribute__((ext_vector_type(8)));
template <bool F8, int NSEG, bool GATHER, class Epi, class Sched>
__device__ __forceinline__ void gemm_phase(LAS unsigned char* lds, const Gemm g, const Sched& S, const Epi& E) {
    const int tid = threadIdx.x, wid = __builtin_amdgcn_readfirstlane(tid >> 6), lane = tid & 63, wr = wid >> 2, wc = wid & 3, fr = lane & 15, fq = lane >> 4;
    const int ldb = g.ldb, nt = ldb / 128;
    unsigned voffA[2], voffB[2];
#pragma unroll
    for (int i = 0; i < 2; ++i) { int R, C; stage_rc(tid * 16 + i * 8192, R, C); const int Rb = Epi::PERM ? ((R & ~31) + perm32(R & 31)) : R;
        voffA[i] = (unsigned)(R * ldb + C * 2); voffB[i] = (unsigned)(Rb * ldb + C * 2); }
    const size_t kstep = (size_t)128;
    const size_t hstep = (size_t)HALF * ldb;
    const size_t tstep = 2 * hstep;
    const unsigned ldsw = (unsigned)wid * 1024u;
    const int aoff = lds_byte(wr * 64 + fr, fq * 8), boff = lds_byte(wc * 32 + fr, fq * 8);
#define PG8_SA(b, h) (((b) * 2 + (h)) * HTB)
#define PG8_SB(b, h) ((4 + (b) * 2 + (h)) * HTB)
#define PG8_STAGE(bufoff, gbase, voff) do { _Pragma("unroll") for (int _i = 0; _i < 2; ++_i) \
        __builtin_amdgcn_global_load_lds((const unsigned*)((const char*)(gbase) + (voff)[_i]), (LAS unsigned*)(lds + (bufoff) + ldsw + _i * 8192), 16, 0, 0); } while (0)
#define PG8_STAGE_A(bufoff, gbase, h, nx) do { if constexpr (GATHER) { unsigned vv_[2]; vv_[0] = (nx) ? offAn[h][0] : offA[h][0]; vv_[1] = (nx) ? offAn[h][1] : offA[h][1]; PG8_STAGE(bufoff, gbase, vv_); } \
        else { PG8_STAGE(bufoff, (gbase) + ((h) ? hstep : (size_t)0), voffA); } } while (0)
#define PG8_LDA(dst, b, h) do { _Pragma("unroll") for (int m = 0; m < 4; ++m) _Pragma("unroll") for (int k = 0; k < 2; ++k) dst[m][k] = *(const LAS bf16x8*)(lds + PG8_SA(b, h) + aoff + m * 2048 + k * 1024); } while (0)
#define PG8_LDB(dst, b, h) do { _Pragma("unroll") for (int n = 0; n < 2; ++n) _Pragma("unroll") for (int k = 0; k < 2; ++k) dst[n][k] = *(const LAS bf16x8*)(lds + PG8_SB(b, h) + boff + n * 2048 + k * 1024); } while (0)
#define PG8_MMA(ai, bj, At, Bt) do { __builtin_amdgcn_s_setprio(1); if constexpr (F8) { asm volatile("s_nop 1"); _Pragma("unroll") for (int m = 0; m < 4; ++m) _Pragma("unroll") for (int n = 0; n < 2; ++n) \
        { const v8i_t b8_ = __builtin_shufflevector(__builtin_bit_cast(v4i_t, Bt[n][0]), __builtin_bit_cast(v4i_t, Bt[n][1]), 0, 1, 2, 3, 4, 5, 6, 7); \
          const v8i_t a8_ = __builtin_shufflevector(__builtin_bit_cast(v4i_t, At[m][0]), __builtin_bit_cast(v4i_t, At[m][1]), 0, 1, 2, 3, 4, 5, 6, 7); \
          asm volatile("v_mfma_scale_f32_16x16x128_f8f6f4 %0, %1, %2, %0, %3, %3 op_sel_hi:[0,0,0]" : "+v"(acc[ai][bj][m][n]) : "v"(b8_), "v"(a8_), "v"(sc8)); } } \
      else { _Pragma("unroll") for (int m = 0; m < 4; ++m) _Pragma("unroll") for (int n = 0; n < 2; ++n) _Pragma("unroll") for (int k = 0; k < 2; ++k) \
        acc[ai][bj][m][n] = __builtin_amdgcn_mfma_f32_16x16x32_bf16(Bt[n][k], At[m][k], acc[ai][bj][m][n], 0, 0, 0); } __builtin_amdgcn_s_setprio(0); } while (0)
#define PG8_WAIT_V(n) asm volatile("s_waitcnt vmcnt(" #n ")" ::: "memory")
#define PG8_WAIT_L(n) asm volatile("s_waitcnt lgkmcnt(" #n ")" ::: "memory")
#define PG8_BAR __builtin_amdgcn_s_barrier()
#define PG8_SCHED __builtin_amdgcn_sched_barrier(0)
    Unit cur, nxt; int ui = 0;
    if (!S.next(0, cur)) return;
    typename Epi::Pre pre; if constexpr (Epi::HASPRE) E.prefetch(pre, cur, wr, wc, fr, fq);
    int sc8 = 0; if constexpr (F8) { asm volatile("v_mov_b32 %0, 0x7f7f7f7f\n\ts_nop 1" : "=v"(sc8)); }
    f32x4 acc[2][2][4][2];
#pragma unroll
    for (int a = 0; a < 2; ++a)
#pragma unroll
        for (int b = 0; b < 2; ++b)
#pragma unroll
            for (int m = 0; m < 4; ++m)
#pragma unroll
                for (int n = 0; n < 2; ++n) acc[a][b][m][n] = (f32x4){0.f, 0.f, 0.f, 0.f};
    bf16x8 At[4][2], B0[2][2], B1[2][2];
    const char* cA = (const char*)g.A + (GATHER ? (size_t)0 : (size_t)cur.pm * tstep); const char* cB = (const char*)g.Bt + (size_t)cur.pb * tstep;
    constexpr bool DUAL = (NSEG == 2);
    unsigned offA[2][2] = {{0u, 0u}, {0u, 0u}}, offAn[2][2] = {{0u, 0u}, {0u, 0u}};
    int gR0 = 0, gC2 = 0; if constexpr (GATHER) { int R, C; stage_rc(tid * 16, R, C); gR0 = R; gC2 = C * 2;
#pragma unroll
        for (int h = 0; h < 2; ++h)
#pragma unroll
            for (int i = 0; i < 2; ++i) offA[h][i] = (unsigned)(g.tokt[128 * h + gR0 + 64 * i] * ldb + gC2);
        asm volatile("s_waitcnt lgkmcnt(0)" ::: "memory"); }
    PG8_STAGE(PG8_SB(0, 0), cB, voffB); PG8_STAGE_A(PG8_SA(0, 0), cA, 0, false); PG8_STAGE(PG8_SB(0, 1), cB + hstep, voffB); PG8_STAGE_A(PG8_SA(0, 1), cA, 1, false);
    if (wr == 1) PG8_BAR;
    PG8_WAIT_V(4); PG8_BAR;
    PG8_STAGE(PG8_SB(1, 0), cB + kstep, voffB); PG8_STAGE_A(PG8_SA(1, 0), cA + kstep, 0, false); PG8_STAGE(PG8_SB(1, 1), cB + hstep + kstep, voffB);
    PG8_WAIT_V(6); PG8_BAR;
    for (;;) {
        const bool has_next = S.next(ui + 1, nxt);
        if constexpr (GATHER) { if (has_next) {
#pragma unroll
            for (int h = 0; h < 2; ++h)
#pragma unroll
                for (int i = 0; i < 2; ++i) offAn[h][i] = (unsigned)(g.tokt[(ui + 1) * 256 + 128 * h + gR0 + 64 * i] * ldb + gC2); }
            asm volatile("s_waitcnt lgkmcnt(0)" ::: "memory"); }
        const char* nA = (has_next && !GATHER) ? (const char*)g.A + (size_t)nxt.pm * tstep : cA; const char* nB = has_next ? (const char*)g.Bt + (size_t)nxt.pb * tstep : cB;
        for (int t = 0; t < NSEG * nt; t += 2) {
            const bool last = (t == NSEG * nt - 2); const bool nx = last && has_next;
            const bool seg2 = DUAL && (t >= nt), cross = DUAL && (t == nt - 2);
            const char* sA_ = seg2 ? (const char*)g.A2 + (size_t)cur.pm * tstep - (size_t)nt * kstep : cA; const char* sB_ = seg2 ? (const char*)g.Bt2 + (size_t)cur.pb * tstep - (size_t)nt * kstep : cB;
            if constexpr (DUAL) { if (t == nt) E.mid(acc, cur, wr, wc, fr, fq); }
            const char* a1 = sA_ + (size_t)(t + 1) * kstep;
            const char* a2 = last ? nA : cross ? (const char*)g.A2 + (size_t)cur.pm * tstep : sA_ + (size_t)(t + 2) * kstep; const char* b2 = last ? nB : cross ? (const char*)g.Bt2 + (size_t)cur.pb * tstep : sB_ + (size_t)(t + 2) * kstep;
            const char* a3 = a2 + kstep; const char* b3 = b2 + kstep;
            PG8_LDB(B0, 0, 0); PG8_SCHED; PG8_LDA(At, 0, 0); PG8_STAGE_A(PG8_SA(1, 1), a1, 1, false);
            PG8_WAIT_L(8); PG8_BAR; PG8_WAIT_L(0); PG8_MMA(0, 0, At, B0); PG8_BAR; PG8_SCHED;
            PG8_LDB(B1, 0, 1); PG8_STAGE(PG8_SB(0, 0), b2, voffB);
            PG8_BAR; PG8_WAIT_L(0); PG8_MMA(0, 1, At, B1); PG8_BAR;
            PG8_LDA(At, 0, 1); PG8_STAGE_A(PG8_SA(0, 0), a2, 0, nx);
            PG8_BAR; PG8_WAIT_L(0); PG8_MMA(1, 0, At, B0); PG8_BAR; PG8_SCHED;
            PG8_STAGE(PG8_SB(0, 1), b2 + hstep, voffB);
            PG8_WAIT_V(6); PG8_BAR; PG8_MMA(1, 1, At, B1); PG8_BAR;
            PG8_LDB(B0, 1, 0); PG8_SCHED; PG8_LDA(At, 1, 0); PG8_STAGE_A(PG8_SA(0, 1), a2, 1, nx);
            PG8_WAIT_L(8); PG8_BAR; PG8_WAIT_L(0); PG8_MMA(0, 0, At, B0); PG8_BAR; PG8_SCHED;
            PG8_LDB(B1, 1, 1); PG8_STAGE(PG8_SB(1, 0), b3, voffB);
            PG8_BAR; PG8_WAIT_L(0); PG8_MMA(0, 1, At, B1); PG8_BAR;
            PG8_LDA(At, 1, 1); PG8_STAGE_A(PG8_SA(1, 0), a3, 0, nx);
            PG8_BAR; PG8_WAIT_L(0); PG8_MMA(1, 0, At, B0); PG8_BAR; PG8_SCHED;
            PG8_STAGE(PG8_SB(1, 1), b3 + hstep, voffB);
            PG8_WAIT_V(6); PG8_BAR; PG8_MMA(1, 1, At, B1); PG8_BAR;
        }
        if constexpr (F8) { asm volatile("s_nop 15\n\ts_nop 15" : "+v"(acc[1][1][0][0]), "+v"(acc[1][1][0][1]), "+v"(acc[1][1][1][0]), "+v"(acc[1][1][1][1]), "+v"(acc[1][1][2][0]), "+v"(acc[1][1][2][1]), "+v"(acc[1][1][3][0]), "+v"(acc[1][1][3][1])); }
        if constexpr (Epi::HASPRE) E(acc, cur, wr, wc, fr, fq, pre); else E(acc, cur, wr, wc, fr, fq);
        if (!has_next) break;
#pragma unroll
        for (int a = 0; a < 2; ++a)
#pragma unroll
            for (int b = 0; b < 2; ++b)
#pragma unroll
                for (int m = 0; m < 4; ++m)
#pragma unroll
                    for (int n = 0; n < 2; ++n) acc[a][b][m][n] = (f32x4){0.f, 0.f, 0.f, 0.f};
        cur = nxt; cA = nA; cB = nB; ++ui;
        if constexpr (Epi::HASPRE) E.prefetch(pre, cur, wr, wc, fr, fq);
        if constexpr (GATHER) {
#pragma unroll
            for (int h = 0; h < 2; ++h)
#pragma unroll
                for (int i = 0; i < 2; ++i) offA[h][i] = offAn[h][i]; }
    }
    PG8_WAIT_V(0);
    if (wr == 0) PG8_BAR;
    PG8_BAR;
#undef PG8_SA
#undef PG8_SB
#undef PG8_STAGE
#undef PG8_STAGE_A
#undef PG8_LDA
#undef PG8_LDB
#undef PG8_MMA
#undef PG8_WAIT_V
#undef PG8_WAIT_L
#undef PG8_BAR
#undef PG8_SCHED
}
}

#define XB_TMO      128
#define XB_XCNT(j)  (256  + 64 * (j))
#define XB_XSUB(j)  (1280 + 64 * (j))
#define XB_XGEN(j)  (2304 + 64 * (j))
#define XB_TOP      3328
#define XB_TOPGEN   3392
#define XCD_BAR_WORDS 3456
#define XB_SPIN_CAP (1u << 18)

__device__ __forceinline__ unsigned xb_ld(unsigned* p)              { return __hip_atomic_load(p, __ATOMIC_RELAXED, __HIP_MEMORY_SCOPE_AGENT); }
__device__ __forceinline__ unsigned xb_add(unsigned* p, unsigned v) { return __hip_atomic_fetch_add(p, v, __ATOMIC_RELAXED, __HIP_MEMORY_SCOPE_AGENT); }
__device__ __forceinline__ unsigned xb_xcc_id() { return (unsigned)__builtin_amdgcn_s_getreg((3 << 11) | 20) & 0xFu; }
#define XB_SPIN(cond, bar) do { unsigned _sp = 0; while (cond) { __builtin_amdgcn_s_sleep(1); \
    if ((++_sp & 255u) == 0u) { if (xb_ld(&(bar)[XB_TMO])) break; if (_sp > XB_SPIN_CAP) { atomicAdd(&(bar)[XB_TMO], 1u); break; } } } } while (0)

struct XcdBarrier { unsigned* bar; unsigned x; volatile LAS unsigned* st; };

__device__ __forceinline__ XcdBarrier xcd_barrier_post(unsigned* bar, volatile LAS unsigned* st) {
    XcdBarrier b; b.bar = bar; b.x = xb_xcc_id(); b.st = st;
    if (threadIdx.x == 0) (void)xb_add(&bar[XB_XCNT(b.x)], 1u);
    return b;
}
__device__ __forceinline__ void xcd_barrier_complete(unsigned* bar, unsigned x, unsigned& nloc, unsigned& nx) {
    const unsigned G = gridDim.x * gridDim.y * gridDim.z;
    unsigned sum, cnt, mine, sp = 0u;
    for (;;) {
        sum = 0u; cnt = 0u; mine = 0u;
#pragma unroll
        for (unsigned j = 0; j < 16; ++j) { const unsigned c = xb_ld(&bar[XB_XCNT(j)]); sum += c; cnt += (c > 0u) ? 1u : 0u; mine = (j == x) ? c : mine; }
        if (sum == G) break;
        __builtin_amdgcn_s_sleep(1);
        if ((++sp & 255u) == 0u) { if (xb_ld(&bar[XB_TMO])) break; if (sp > XB_SPIN_CAP) { atomicAdd(&bar[XB_TMO], 1u); break; } }
    }
    nloc = mine > 0u ? mine : 1u; nx = cnt > 0u ? cnt : 1u;
}
__device__ __forceinline__ void xcd_barrier(const XcdBarrier& b) {
    asm volatile("s_waitcnt vmcnt(0)" ::: "memory");
    __syncthreads();
    if (threadIdx.x == 0) {
        unsigned* bar = b.bar;
        __builtin_amdgcn_s_waitcnt(0);
        unsigned nloc = b.st[0], nx = b.st[1];
        if (nloc == 0u) { xcd_barrier_complete(bar, b.x, nloc, nx); b.st[0] = nloc; b.st[1] = nx; }
        const unsigned old = xb_add(&bar[XB_XSUB(b.x)], 1u);
        const unsigned gen = old / nloc;
        if (old + 1u == (gen + 1u) * nloc) {
            __builtin_amdgcn_fence(__ATOMIC_RELEASE, "agent");
            asm volatile("s_waitcnt vmcnt(0)" ::: "memory");
            const unsigned og = xb_add(&bar[XB_TOP], 1u);
            const unsigned tg = og / nx;
            if (og + 1u == (tg + 1u) * nx) xb_add(&bar[XB_TOPGEN], 1u);
            else XB_SPIN(xb_ld(&bar[XB_TOPGEN]) == tg, bar);
            __builtin_amdgcn_fence(__ATOMIC_ACQUIRE, "agent");
            xb_add(&bar[XB_XGEN(b.x)], 1u);
            asm volatile("s_waitcnt vmcnt(0)" ::: "memory");
        } else {
            XB_SPIN(xb_ld(&bar[XB_XGEN(b.x)]) == gen, bar);
            __builtin_amdgcn_fence(__ATOMIC_ACQUIRE, "agent");
            asm volatile("s_waitcnt vmcnt(0)" ::: "memory");
        }
    }
    __syncthreads();
}

struct Args {
    const float* x; const float* norm_mix_g; const float* w_in; const float* conv_w; const float* conv_b; const float* w_a2; const float* b_a; const float* gla_norm_g;
    const float* w_br_a; const float* w_br_b; const float* w_out; const float* norm_ffn_g; const float* w_router; const float* b_router; const float* w_gate_up; const float* b_gate_up;
    const float* w_down; const float* b_down; const float* norm_final_g; float* out; unsigned char* ws; int ph_lo, ph_hi;
};

__device__ __forceinline__ void tr_item(const float* W, size_t ldw, int k0, int sn0, bf16* WT, int K, size_t drow0, LAS float* scr, int lane) {
#pragma unroll 8
    for (int i = 0; i < 32; ++i) { const int kk = 2 * i + (lane >> 5); scr[kk * 33 + (lane & 31)] = W[(size_t)(k0 + kk) * ldw + sn0 + (lane & 31)]; }
    LDS_WAIT(); asm volatile("" ::: "memory");
    const int c = lane & 7;
#pragma unroll
    for (int j = 0; j < 4; ++j) { const int n = (lane >> 3) + 8 * j; const LAS float* s = scr + (8 * c) * 33 + n;
        u32x4 o; o.x = cvt_pk_bf16(s[0 * 33], s[1 * 33]); o.y = cvt_pk_bf16(s[2 * 33], s[3 * 33]); o.z = cvt_pk_bf16(s[4 * 33], s[5 * 33]); o.w = cvt_pk_bf16(s[6 * 33], s[7 * 33]);
        *(u32x4*)(WT + (drow0 + n) * K + k0 + 8 * c) = o; }
    LDS_WAIT(); asm volatile("" ::: "memory");
}

struct TrItem { const float* W; size_t ldw; unsigned char* dst; int Kb; };
__device__ __forceinline__ void tr8_load(const TrItem& t, f32x4 (&r)[16]) {
#pragma unroll
    for (int i = 0; i < 16; ++i) r[i] = __builtin_nontemporal_load((const f32x4*)(t.W + (size_t)i * t.ldw));
}
__device__ __forceinline__ void tr8_store(const TrItem& t, const f32x4 (&r)[16], float scale) {
#pragma unroll
    for (int q = 0; q < 4; ++q) { u32x4 o;
        o.x = pk4_fp8(r[0][q] * scale, r[1][q] * scale, r[2][q] * scale, r[3][q] * scale); o.y = pk4_fp8(r[4][q] * scale, r[5][q] * scale, r[6][q] * scale, r[7][q] * scale);
        o.z = pk4_fp8(r[8][q] * scale, r[9][q] * scale, r[10][q] * scale, r[11][q] * scale); o.w = pk4_fp8(r[12][q] * scale, r[13][q] * scale, r[14][q] * scale, r[15][q] * scale);
        __builtin_nontemporal_store(o, (u32x4*)(t.dst + (size_t)q * t.Kb)); }
}
__device__ __forceinline__ TrItem moe_item(int it, const float* w_gate_up, const float* w_down, unsigned char* WGU8, unsigned char* WD8, int lane) {
    constexpr int NQ_GU = NE * 16 * 128; const int kr = lane >> 3, c4 = lane & 7; TrItem t;
    if (it < NQ_GU) { const int e = it / (16 * 128), r = it % (16 * 128), kb = r / 128, nb = r % 128; const int n0 = 32 * nb, isup = n0 / DFF, j = n0 % DFF;
        t.ldw = 2 * DFF; t.Kb = DM; t.W = w_gate_up + (size_t)e * DM * 2 * DFF + (size_t)(128 * kb + 16 * kr) * (2 * DFF) + n0 + 4 * c4;
        t.dst = WGU8 + ((size_t)e * 4096 + 256 * (j / 128) + 128 * isup + (j % 128) + 4 * c4) * DM + 128 * kb + 16 * kr; }
    else { const int i2 = it - NQ_GU; const int e = i2 / (16 * 64), r = i2 % (16 * 64), kb = r / 64, nb = r % 64;
        t.ldw = DM; t.Kb = DFF; t.W = w_down + (size_t)e * DFF * DM + (size_t)(128 * kb + 16 * kr) * DM + 32 * nb + 4 * c4;
        t.dst = WD8 + ((size_t)e * DM + 32 * nb + 4 * c4) * DFF + 128 * kb + 16 * kr; }
    return t;
}

constexpr int NQ_MOE = NE * 16 * 128 + NE * 16 * 64;
constexpr int NG9 = 232;
constexpr int NQ_SCAN = 0;
constexpr int NQ_TAIL = 32768;
static_assert(QBATCH % 2 == 0 && NQ_MOE % QBATCH == 0 && NQ_TAIL % QBATCH == 0, "queue batches");
__device__ __forceinline__ void moe_convert_queue(unsigned* head, int first, int last, const float* w_gate_up, const float* w_down, unsigned char* WGU8, unsigned char* WD8, int lane) {
    int nbase = 0; if (lane == 0) nbase = (int)__hip_atomic_fetch_add(head, (unsigned)QBATCH, RLX_AGENT);
    for (;;) {
        const int base = first + __builtin_amdgcn_readfirstlane(nbase);
        if (base >= last) break;
        if (lane == 0) nbase = (int)__hip_atomic_fetch_add(head, (unsigned)QBATCH, RLX_AGENT);
        f32x4 ra[16], rb[16];
        TrItem ta = moe_item(base, w_gate_up, w_down, WGU8, WD8, lane), tb;
        tr8_load(ta, ra);
#pragma unroll
        for (int j = 0; j < QBATCH; j += 2) {
            tb = moe_item(base + j + 1, w_gate_up, w_down, WGU8, WD8, lane); tr8_load(tb, rb);
            tr8_store(ta, ra, 1024.0f);
            if (j + 2 < QBATCH) { ta = moe_item(base + j + 2, w_gate_up, w_down, WGU8, WD8, lane); tr8_load(ta, ra); }
            tr8_store(tb, rb, 1024.0f);
        }
    }
}

__global__ void __launch_bounds__(NWAVES * 64, 2) mega_fwd(Args a) {
    extern __shared__ __attribute__((aligned(16))) unsigned char lds_raw[];
    LAS unsigned char* lds = (LAS unsigned char*)lds_raw;
    volatile LAS unsigned* MISC = (volatile LAS unsigned*)(lds + MISC_OFF);
    LAS int* tile_e = (LAS int*)(lds + TILEE_OFF);
    LAS int* pstart = (LAS int*)(lds + PSTART_OFF);
    const int tid = threadIdx.x, lane = tid & 63, wave = __builtin_amdgcn_readfirstlane(tid >> 6);
    const int G = gridDim.x; const int bx = blockIdx.x; const int vcu = (G % 8 == 0) ? (bx % 8) * (G / 8) + bx / 8 : bx;
    const int gw = vcu * NWAVES + wave, NGW = G * NWAVES;
    unsigned char* ws = a.ws;
    unsigned* ctl = (unsigned*)(ws + WS_CTL);
    float* WRF = (float*)(ws + WS_WRF);
    int* tk_e = (int*)(ws + WS_TK); int* tk_rank = tk_e + NTOK * 4; float* tk_w = (float*)(tk_rank + NTOK * 4); int* tk_slot = (int*)(tk_w + NTOK * 4); float* rs_tok = (float*)(tk_slot + NTOK * 4);
    float* slot_w = (float*)(ws + WS_SLOT); float* slot_rs = slot_w + MAXSLOT; int* slot_tok = (int*)(slot_rs + MAXSLOT);
    bf16* WIN = (bf16*)(ws + WS_WIN); bf16* WA = (bf16*)(ws + WS_WA); bf16* WB = (bf16*)(ws + WS_WB); bf16* WO = (bf16*)(ws + WS_WO); unsigned char* WGU8 = ws + WS_WGU; unsigned char* WD8 = ws + WS_WD;
    bf16* Hb = (bf16*)(ws + WS_H); bf16* P = (bf16*)(ws + WS_P); bf16* ZA = (bf16*)(ws + WS_ZA); bf16* ZB = (bf16*)(ws + WS_ZB); bf16* Ob = (bf16*)(ws + WS_O);
    bf16* YA = (bf16*)(ws + WS_YA); bf16* MIX = (bf16*)(ws + WS_MIX); float* X1 = (float*)(ws + WS_X1); unsigned char* G8 = ws + WS_XB; unsigned char* ACT8 = ws + WS_ACT; unsigned char* YS8 = ws + WS_YS; unsigned char* H8 = ws + WS_H; unsigned char* WIN8 = ws + WS_WIN8; unsigned char* HQ8 = ws + WS_HQ8;

    for (int u = tid; u < (LDS_BYTES - LDSCTL_OFF) / 4; u += NWAVES * 64) ((LAS unsigned*)(lds + LDSCTL_OFF))[u] = 0u;
    __syncthreads();
    XcdBarrier bar = xcd_barrier_post(ctl + CW_BAR, MISC + 8);
    const int lo = a.ph_lo, hi = a.ph_hi;
#define IN(k) (lo <= (k) && (k) < hi)
#define BOTH(k) (IN(k) && IN((k) + 1))
#define GRID_BAR() xcd_barrier(bar)

    if (IN(0)) {
      for (int rep = 0; rep < REP_P0; ++rep) {
        {
            f32x4 gv[8];
#pragma unroll
            for (int j = 0; j < 8; ++j) gv[j] = *((const f32x4*)a.norm_mix_g + lane + 64 * j);
            for (int m = gw; m < NTOK; m += NGW) {
                const f32x4* xr = (const f32x4*)(a.x + (size_t)m * DM) + lane; f32x4 v[8]; float s = 0.f;
#pragma unroll
                for (int j = 0; j < 8; ++j) { v[j] = xr[64 * j]; s += (v[j].x * v[j].x + v[j].y * v[j].y) + (v[j].z * v[j].z + v[j].w * v[j].w); }
                const float rs = 1.0f / sqrtf(wave_sum(s) * (1.0f / DM) + EPS);
                u32x2* o8 = (u32x2*)(Hb + (size_t)m * DM) + lane;
                unsigned* q8 = (unsigned*)(HQ8 + (size_t)m * DM) + lane;
#pragma unroll
                for (int j = 0; j < 8; ++j) { const float h0 = v[j].x * rs * gv[j].x, h1 = v[j].y * rs * gv[j].y, h2 = v[j].z * rs * gv[j].z, h3 = v[j].w * rs * gv[j].w;
                    u32x2 w; w.x = cvt_pk_bf16(h0, h1); w.y = cvt_pk_bf16(h2, h3); o8[64 * j] = w; q8[64 * j] = pk4_fp8(8.0f * h0, 8.0f * h1, 8.0f * h2, 8.0f * h3); }
            }
        }
#if DBG_STAGE >= 1
        {
            LAS float* scr = (LAS float*)(lds + wave * 16896);
            for (int it = gw; it < 192 * 32; it += NGW) { const int kb = it / 192, db = it % 192; const int d0 = 32 * db; tr_item(a.w_in, DIN, 64 * kb, d0, WIN, DM, d0, scr, lane); }
            for (int it = gw; it < 16 * 128; it += NGW) { const int kb = it / 128, nb = it % 128; const int kr = lane >> 3, c4 = lane & 7; TrItem t; t.ldw = DIN; t.Kb = DM;
                t.W = a.w_in + (size_t)(128 * kb + 16 * kr) * DIN + 6160 + 32 * nb + 4 * c4; t.dst = WIN8 + ((size_t)32 * nb + 4 * c4) * DM + 128 * kb + 16 * kr;
                f32x4 r8[16]; tr8_load(t, r8); tr8_store(t, r8, 512.0f); }
            for (int i = gw * 64 + lane; i < 256 * DM; i += NGW * 64) { const int r = i / DM, k = i % DM; WIN[(size_t)(PC_AL + r) * DM + k] = r < 16 ? (bf16)(cvt_pk_bf16(a.w_in[(size_t)k * DIN + SRC_AL + r], 0.f) & 0xffffu) : (bf16)0; }
#if DBG_STAGE >= 3
            for (int i = gw * 64 + lane; i < 128 * 2 * 64 * 4; i += NGW * 64) { const int ii = i & 3, l = (i >> 2) & 63, t = (i >> 8) & 1, j = i >> 9; const int k = 32 * (j >> 1) + 8 * (l >> 4) + 4 * (j & 1) + ii;
                WRF[i] = a.norm_ffn_g[k] * a.w_router[(size_t)k * NE + 16 * t + (l & 15)]; }
#endif
        }
#endif
      }
        if (BOTH(0)) GRID_BAR();
    }

#if DBG_STAGE >= 1
    if (IN(1)) {
        const int ngemm = (G == 256) ? NGEMM : G;
        if (bx < ngemm) {
            { pg8::Gemm g{Hb, WIN, 2 * DM, nullptr, nullptr, nullptr}; pg8::StaticOrder S; S.init(NTOK / 256, 25, ngemm, bx, 4); pg8::EpiPlainBf16 E{P, NP, 0, 1.0f}; pg8::gemm_phase<false, 1, false>(lds, g, S, E); }
            { pg8::Gemm g{HQ8, WIN8, DM, nullptr, nullptr, nullptr}; pg8::StaticOrder S; S.init(NTOK / 256, 16, ngemm, bx, 4); pg8::EpiPlainFp8 E{G8, 4096, 16.0f / 4096.0f}; pg8::gemm_phase<true, 1, false>(lds, g, S, E); }
        }
#if DBG_STAGE >= 3
        moe_convert_queue(ctl + CW_Q, 0, NQ_MOE - NQ_TAIL - NQ_SCAN, a.w_gate_up, a.w_down, WGU8, WD8, lane);
#endif
        if (BOTH(1)) GRID_BAR();
    }

    if (IN(2)) {
        bf16* KTT = (bf16*)(ws + WS_KTT);
        float* DECB = (float*)(ws + WS_DEC);
        bf16* VTT = (bf16*)(ws + WS_VTT);
        {
            LAS float* AL = (LAS float*)(lds);
            LAS float* CUMG = (LAS float*)(lds + 4096);
            LAS bf16* KL = (LAS bf16*)(lds + 8192);
            LAS unsigned char* VT = lds + 32768;
            for (int item = vcu; item < 1024; item += G) {
                const int b = item >> 7, c = (item >> 2) & 31, h = item & 3;
                const size_t t0 = (size_t)b * SEQ + 64 * c;
                const int dk = tid & 127, sg = tid >> 7;
                float wa2[16];
#pragma unroll
                for (int j = 0; j < 16; ++j) wa2[j] = a.w_a2[j * 512 + h * 128 + dk];
                const float ba = a.b_a[h * 128 + dk];
                if (tid < 128) { const int s = tid >> 1, hf = tid & 1; const u32x4 w = *(const u32x4*)(P + (t0 + s) * NP + PC_AL + 8 * hf);
                    LAS float* d = AL + s * 16 + 8 * hf; d[0] = bf_lo(w.x); d[1] = bf_hi(w.x); d[2] = bf_lo(w.y); d[3] = bf_hi(w.y); d[4] = bf_lo(w.z); d[5] = bf_hi(w.z); d[6] = bf_lo(w.w); d[7] = bf_hi(w.w); }
#pragma unroll
                for (int i = 0; i < 2; ++i) { const int p = tid + 512 * i, row = p >> 4, c16 = p & 15; *(LAS u32x4*)(KL + row * 136 + c16 * 8) = *(const u32x4*)(P + (t0 + row) * NP + PC_K + h * 128 + c16 * 8); }
                if (tid < 256) { const int vb = tid & 31, sb = tid >> 5; u32x4 Lr[8];
#pragma unroll
                  for (int i = 0; i < 8; ++i) Lr[i] = *(const u32x4*)(P + (t0 + 8 * sb + i) * NP + PC_V + h * 256 + 8 * vb);
#pragma unroll
                  for (int j = 0; j < 8; ++j) { const unsigned sel = (j & 1) ? 0x07060302u : 0x05040100u; u32x4 w;
                      w.x = __builtin_amdgcn_perm(Lr[1][j >> 1], Lr[0][j >> 1], sel); w.y = __builtin_amdgcn_perm(Lr[3][j >> 1], Lr[2][j >> 1], sel);
                      w.z = __builtin_amdgcn_perm(Lr[5][j >> 1], Lr[4][j >> 1], sel); w.w = __builtin_amdgcn_perm(Lr[7][j >> 1], Lr[6][j >> 1], sel);
                      *(LAS u32x4*)(VT + (8 * vb + j) * 128 + ((sb ^ (vb & 7)) << 4)) = w; } }
                __syncthreads();
#pragma unroll
                for (int i = 0; i < 4; ++i) { const int q = tid + 512 * i, v = q >> 3, slot = q & 7; *(u32x4*)(VTT + ((size_t)item * 256 + v) * 64 + 8 * (slot ^ ((v >> 3) & 7))) = *(const LAS u32x4*)(VT + q * 16); }
                float cs[16]; float run = 0.f;
#pragma unroll
                for (int i = 0; i < 16; ++i) { const LAS float* al = AL + (16 * sg + i) * 16; float z = ba;
#pragma unroll
                    for (int j = 0; j < 16; ++j) z += al[j] * wa2[j];
                    const float la = -(fmaxf(-z, 0.f) + __logf(1.0f + __expf(-fabsf(z)))) * (1.0f / 16.0f); run += la; cs[i] = run; }
                CUMG[sg * 128 + dk] = run;
                __syncthreads();
                float pre = 0.f, tot = 0.f;
#pragma unroll
                for (int gq = 0; gq < 4; ++gq) { const float v = CUMG[gq * 128 + dk]; tot += v; if (gq < sg) pre += v; }
                if (sg == 0) DECB[item * 128 + dk] = __expf(tot);
                { unsigned pk[8];
#pragma unroll
                  for (int i = 0; i < 8; ++i) { const float f0 = __expf(tot - (pre + cs[2 * i])), f1 = __expf(tot - (pre + cs[2 * i + 1])); pk[i] = cvt_pk_bf16(bf2f(KL[(16 * sg + 2 * i) * 136 + dk]) * f0, bf2f(KL[(16 * sg + 2 * i + 1) * 136 + dk]) * f1); }
                  u32x4 w0, w1; w0.x = pk[0]; w0.y = pk[1]; w0.z = pk[2]; w0.w = pk[3]; w1.x = pk[4]; w1.y = pk[5]; w1.z = pk[6]; w1.w = pk[7];
                  u32x4* dst = (u32x4*)(KTT + ((size_t)item * 128 + dk) * 64 + 16 * sg); dst[0] = w0; dst[1] = w1; }
                __syncthreads();
            }
        }
        GRID_BAR();
        {
            LAS bf16* SB = (LAS bf16*)(lds + 8192);
            LAS float* OT = (LAS float*)(lds + 43008);
            LAS bf16* VTS = (LAS bf16*)(lds + 77824);
            LAS bf16* QS = (LAS bf16*)(lds + 96256);
            const int fr = lane & 15, fq = lane >> 4, mi = wave >> 1, ni = wave & 1;
            struct GlaRegs { bf16x8 af[2]; u32x4 q[2]; u32x4 vt; f32x4 dec; };
            const bool split = (G == 256);
            for (int rep = 0; rep < REP_P2; ++rep)
            if (!split || !(vcu & 1))
            for (int it = split ? (vcu >> 1) : vcu; it < 128; it += split ? 128 : G) {
                const int b = it >> 4, h = (it >> 2) & 3, vs = it & 3;
                f32x4 Sacc[4];
#pragma unroll
                for (int n = 0; n < 4; ++n) Sacc[n] = (f32x4){0.f, 0.f, 0.f, 0.f};
                GlaRegs R[3];
#define GLA_LOAD(X, cc) do { const int item_ = (b * 32 + (cc)) * 4 + h; const size_t t0_ = (size_t)b * SEQ + 64 * (cc); \
                    _Pragma("unroll") for (int ks = 0; ks < 2; ++ks) X.af[ks] = *(const bf16x8*)(KTT + ((size_t)item_ * 128 + 16 * wave + fr) * 64 + 32 * ks + 8 * fq); \
                    X.vt = *(const u32x4*)(VTT + ((size_t)item_ * 256 + vs * 64 + 8 * wave + (lane >> 3)) * 64 + 8 * (lane & 7)); \
                    _Pragma("unroll") for (int i = 0; i < 2; ++i) X.q[i] = *(const u32x4*)(P + (t0_ + 8 * wave + (lane >> 3)) * NP + PC_Q + h * 128 + 8 * (lane & 7) + 64 * i); \
                    X.dec = *(const f32x4*)(DECB + item_ * 128 + 16 * wave + 4 * fq); } while (0)
#define GLA_PUT_VT(X, cc) do { *(LAS u32x4*)(VTS + ((cc) & 1) * (64 * 72) + (8 * wave + (lane >> 3)) * 72 + 8 * (lane & 7)) = X.vt; } while (0)
                GLA_LOAD(R[0], 0); GLA_LOAD(R[1], 1); GLA_LOAD(R[2], 2);
                GLA_PUT_VT(R[0], 0);
                __syncthreads();
                for (int c0 = 0; c0 < 32; c0 += 3) {
#pragma unroll
                    for (int u = 0; u < 3; ++u) {
                        const int c = c0 + u; if (c >= 32) break;
                        const size_t t0 = (size_t)b * SEQ + 64 * c;
                        LAS bf16* SBc = SB + (c & 1) * (64 * 136); LAS bf16* QSc = QS + (c & 1) * (64 * 136); const LAS bf16* VTc = VTS + (c & 1) * (64 * 72);
#pragma unroll
                        for (int n = 0; n < 4; ++n) Sacc[n] *= R[u].dec;
#pragma unroll
                        for (int ks = 0; ks < 2; ++ks)
#pragma unroll
                            for (int n = 0; n < 4; ++n) { const bf16x8 bvf = *(const LAS bf16x8*)(VTc + (16 * n + fr) * 72 + 32 * ks + 8 * fq); Sacc[n] = __builtin_amdgcn_mfma_f32_16x16x32_bf16(R[u].af[ks], bvf, Sacc[n], 0, 0, 0); }
#pragma unroll
                        for (int n = 0; n < 4; ++n) { u32x2 w; w.x = cvt_pk_bf16(Sacc[n][0], Sacc[n][1]); w.y = cvt_pk_bf16(Sacc[n][2], Sacc[n][3]); *(LAS u32x2*)(SBc + (16 * n + fr) * 136 + 16 * wave + 4 * fq) = w; }
#pragma unroll
                        for (int i = 0; i < 2; ++i) *(LAS u32x4*)(QSc + (8 * wave + (lane >> 3)) * 136 + 8 * (lane & 7) + 64 * i) = R[u].q[i];
                        if (c + 1 < 32) GLA_PUT_VT(R[(u + 1) % 3], c + 1);
                        if (c + 3 < 32) GLA_LOAD(R[u], c + 3);
                        __syncthreads();
                        f32x4 oa[2] = {(f32x4){0.f, 0.f, 0.f, 0.f}, (f32x4){0.f, 0.f, 0.f, 0.f}};
#pragma unroll
                        for (int kk = 0; kk < 4; ++kk) { const bf16x8 qf = *(const LAS bf16x8*)(QSc + (16 * mi + fr) * 136 + 32 * kk + 8 * fq);
#pragma unroll
                            for (int n2 = 0; n2 < 2; ++n2) { const bf16x8 sf = *(const LAS bf16x8*)(SBc + (16 * (2 * ni + n2) + fr) * 136 + 32 * kk + 8 * fq); oa[n2] = __builtin_amdgcn_mfma_f32_16x16x32_bf16(qf, sf, oa[n2], 0, 0, 0); } }
                        LAS float* OTc = OT + (c & 1) * (64 * 68);
#pragma unroll
                        for (int n2 = 0; n2 < 2; ++n2)
#pragma unroll
                            for (int j = 0; j < 4; ++j) OTc[(16 * mi + 4 * fq + j) * 68 + 16 * (2 * ni + n2) + fr] = oa[n2][j] * 0.08838834764831845f;
                        if (c > 0) {
                            const LAS f32x4* op = (const LAS f32x4*)(OT + ((c - 1) & 1) * (64 * 68) + (8 * wave + (lane >> 3)) * 68 + 8 * (lane & 7)); const f32x4 ov0 = op[0], ov1 = op[1];
                            u32x4 ow; ow.x = cvt_pk_bf16(ov0[0], ov0[1]); ow.y = cvt_pk_bf16(ov0[2], ov0[3]); ow.z = cvt_pk_bf16(ov1[0], ov1[1]); ow.w = cvt_pk_bf16(ov1[2], ov1[3]);
                            *(u32x4*)(Ob + (t0 - 64 + 8 * wave + (lane >> 3)) * 1024 + h * 256 + vs * 64 + 8 * (lane & 7)) = ow; }
                    }
                }
                __syncthreads();
                { const size_t t0 = (size_t)b * SEQ + 64 * 31; const LAS f32x4* op = (const LAS f32x4*)(OT + (31 & 1) * (64 * 68) + (8 * wave + (lane >> 3)) * 68 + 8 * (lane & 7)); const f32x4 ov0 = op[0], ov1 = op[1];
                  u32x4 ow; ow.x = cvt_pk_bf16(ov0[0], ov0[1]); ow.y = cvt_pk_bf16(ov0[2], ov0[3]); ow.z = cvt_pk_bf16(ov1[0], ov1[1]); ow.w = cvt_pk_bf16(ov1[2], ov1[3]);
                  *(u32x4*)(Ob + (t0 + 8 * wave + (lane >> 3)) * 1024 + h * 256 + vs * 64 + 8 * (lane & 7)) = ow; }
                __syncthreads();
#undef GLA_LOAD
#undef GLA_PUT_VT
            }
            if (!split || (vcu & 1)) { const int hw = split ? (vcu >> 1) * NWAVES + wave : gw, nhw = split ? 128 * NWAVES : NGW;
            for (int wi = hw; wi < 2048; wi += nhw) {
                const int tb = wi >> 1, hf = wi & 1, c0 = 512 * hf + 8 * lane; const int t0 = 16 * tb;
                float w0[8], w1[8], w2[8], cb[8];
#pragma unroll
                for (int j = 0; j < 8; ++j) { w0[j] = a.conv_w[c0 + j]; w1[j] = a.conv_w[1024 + c0 + j]; w2[j] = a.conv_w[2048 + c0 + j]; cb[j] = a.conv_b[c0 + j]; }
                float y2[8], y1[8];
#pragma unroll
                for (int j = 0; j < 8; ++j) { y2[j] = 0.f; y1[j] = 0.f; }
                if ((t0 % SEQ) != 0) {
                    const bf16* pr = P + (size_t)(t0 - 2) * NP + c0; const u32x4 c2 = *(const u32x4*)(pr + PC_UC), x2 = *(const u32x4*)(pr + PC_UX), c1 = *(const u32x4*)(pr + NP + PC_UC), x1 = *(const u32x4*)(pr + NP + PC_UX);
                    y2[0] = bf_lo(c2.x) * bf_lo(x2.x); y2[1] = bf_hi(c2.x) * bf_hi(x2.x); y2[2] = bf_lo(c2.y) * bf_lo(x2.y); y2[3] = bf_hi(c2.y) * bf_hi(x2.y); y2[4] = bf_lo(c2.z) * bf_lo(x2.z); y2[5] = bf_hi(c2.z) * bf_hi(x2.z); y2[6] = bf_lo(c2.w) * bf_lo(x2.w); y2[7] = bf_hi(c2.w) * bf_hi(x2.w);
                    y1[0] = bf_lo(c1.x) * bf_lo(x1.x); y1[1] = bf_hi(c1.x) * bf_hi(x1.x); y1[2] = bf_lo(c1.y) * bf_lo(x1.y); y1[3] = bf_hi(c1.y) * bf_hi(x1.y); y1[4] = bf_lo(c1.z) * bf_lo(x1.z); y1[5] = bf_hi(c1.z) * bf_hi(x1.z); y1[6] = bf_lo(c1.w) * bf_lo(x1.w); y1[7] = bf_hi(c1.w) * bf_hi(x1.w);
                }
#pragma unroll 4
                for (int t = 0; t < 16; ++t) {
                    const bf16* pr = P + (size_t)(t0 + t) * NP + c0; const u32x4 uc = *(const u32x4*)(pr + PC_UC), ub = *(const u32x4*)(pr + PC_UB), ux = *(const u32x4*)(pr + PC_UX);
                    float y0[8], bb[8];
                    y0[0] = bf_lo(uc.x) * bf_lo(ux.x); y0[1] = bf_hi(uc.x) * bf_hi(ux.x); y0[2] = bf_lo(uc.y) * bf_lo(ux.y); y0[3] = bf_hi(uc.y) * bf_hi(ux.y); y0[4] = bf_lo(uc.z) * bf_lo(ux.z); y0[5] = bf_hi(uc.z) * bf_hi(ux.z); y0[6] = bf_lo(uc.w) * bf_lo(ux.w); y0[7] = bf_hi(uc.w) * bf_hi(ux.w);
                    bb[0] = bf_lo(ub.x); bb[1] = bf_hi(ub.x); bb[2] = bf_lo(ub.y); bb[3] = bf_hi(ub.y); bb[4] = bf_lo(ub.z); bb[5] = bf_hi(ub.z); bb[6] = bf_lo(ub.w); bb[7] = bf_hi(ub.w);
                    float z[8];
#pragma unroll
                    for (int j = 0; j < 8; ++j) { z[j] = bb[j] * (cb[j] + w0[j] * y2[j] + w1[j] * y1[j] + w2[j] * y0[j]); y2[j] = y1[j]; y1[j] = y0[j]; }
                    u32x4 w; w.x = cvt_pk_bf16(z[0], z[1]); w.y = cvt_pk_bf16(z[2], z[3]); w.z = cvt_pk_bf16(z[4], z[5]); w.w = cvt_pk_bf16(z[6], z[7]);
                    *(u32x4*)(ZA + (size_t)(t0 + t) * 1024 + c0) = w;
                }
            }
            { LAS float* scr = (LAS float*)(lds + wave * 16896);
              for (int it = hw; it < 16 * 64; it += nhw) { const int kb = it / 64, nb = it % 64; tr_item(a.w_br_a, DM, 64 * kb, 32 * nb, WA, 1024, 32 * nb, scr, lane); }
              for (int it = hw; it < 16 * 64; it += nhw) { const int kb = it / 64, nb = it % 64; tr_item(a.w_br_b, DM, 64 * kb, 32 * nb, WB, 1024, 32 * nb, scr, lane); }
              for (int it = hw; it < 32 * 64; it += nhw) { const int kb = it / 64, nb = it % 64; tr_item(a.w_out, DM, 64 * kb, 32 * nb, WO, DM, 32 * nb, scr, lane); } }
            }
#if DBG_STAGE >= 3
            moe_convert_queue(ctl + CW_Q3, NQ_MOE - NQ_TAIL - NQ_SCAN, NQ_MOE - NQ_TAIL, a.w_gate_up, a.w_down, WGU8, WD8, lane);
#endif
        }
        if (BOTH(2)) GRID_BAR();
    }

    if (IN(3)) {
        {
            f32x4 gg[4];
#pragma unroll
            for (int j = 0; j < 4; ++j) gg[j] = *((const f32x4*)(a.gla_norm_g + 16 * lane) + j);
            for (int m = gw; m < NTOK; m += NGW) {
                const u32x4* op = (const u32x4*)(Ob + (size_t)m * 1024 + 16 * lane); const u32x4 ob0 = op[0], ob1 = op[1]; f32x4 o[4]; float s = 0.f;
                o[0] = (f32x4){bf_lo(ob0.x), bf_hi(ob0.x), bf_lo(ob0.y), bf_hi(ob0.y)}; o[1] = (f32x4){bf_lo(ob0.z), bf_hi(ob0.z), bf_lo(ob0.w), bf_hi(ob0.w)};
                o[2] = (f32x4){bf_lo(ob1.x), bf_hi(ob1.x), bf_lo(ob1.y), bf_hi(ob1.y)}; o[3] = (f32x4){bf_lo(ob1.z), bf_hi(ob1.z), bf_lo(ob1.w), bf_hi(ob1.w)};
#pragma unroll
                for (int j = 0; j < 4; ++j) { s += (o[j].x * o[j].x + o[j].y * o[j].y) + (o[j].z * o[j].z + o[j].w * o[j].w); }
                s += __shfl_xor(s, 1); s += __shfl_xor(s, 2); s += __shfl_xor(s, 4); s += __shfl_xor(s, 8);
                const float rs = 1.0f / sqrtf(s * (1.0f / 256.0f) + EPS);
                const u32x4* rp = (const u32x4*)(P + (size_t)m * NP + PC_R + 16 * lane); const u32x4 r0 = rp[0], r1 = rp[1];
                float rr[16];
                rr[0] = bf_lo(r0.x); rr[1] = bf_hi(r0.x); rr[2] = bf_lo(r0.y); rr[3] = bf_hi(r0.y); rr[4] = bf_lo(r0.z); rr[5] = bf_hi(r0.z); rr[6] = bf_lo(r0.w); rr[7] = bf_hi(r0.w);
                rr[8] = bf_lo(r1.x); rr[9] = bf_hi(r1.x); rr[10] = bf_lo(r1.y); rr[11] = bf_hi(r1.y); rr[12] = bf_lo(r1.z); rr[13] = bf_hi(r1.z); rr[14] = bf_lo(r1.w); rr[15] = bf_hi(r1.w);
                float z[16];
#pragma unroll
                for (int j = 0; j < 4; ++j)
#pragma unroll
                    for (int q = 0; q < 4; ++q) { const float r = rr[4 * j + q]; z[4 * j + q] = o[j][q] * rs * gg[j][q] * (r * fast_sigmoid(r)); }
                u32x4 w0, w1; w0.x = cvt_pk_bf16(z[0], z[1]); w0.y = cvt_pk_bf16(z[2], z[3]); w0.z = cvt_pk_bf16(z[4], z[5]); w0.w = cvt_pk_bf16(z[6], z[7]);
                w1.x = cvt_pk_bf16(z[8], z[9]); w1.y = cvt_pk_bf16(z[10], z[11]); w1.z = cvt_pk_bf16(z[12], z[13]); w1.w = cvt_pk_bf16(z[14], z[15]);
                u32x4* zp = (u32x4*)(ZB + (size_t)m * 1024 + 16 * lane); zp[0] = w0; zp[1] = w1;
            }
        }
        if (BOTH(3)) GRID_BAR();
    }

    if (IN(4)) {
        { pg8::Gemm g{ZA, WA, 2048, ZB, WB, nullptr}; pg8::StaticOrder S; S.init(NTOK / 256, DM / 256, G, bx); pg8::EpiGate2 E{G8, MIX}; pg8::gemm_phase<false, 2, false>(lds, g, S, E); }
        if (BOTH(4)) GRID_BAR();
    }

    if (IN(6)) {
        pg8::Gemm g{MIX, WO, 2 * DM, nullptr, nullptr, nullptr}; pg8::StaticOrder S; S.init(NTOK / 256, DM / 256, G, bx); pg8::EpiResF32 E{a.x, X1};
        pg8::gemm_phase<false, 1, false>(lds, g, S, E);
        if (BOTH(6)) GRID_BAR();
    }
#endif

#if DBG_STAGE >= 3
    if (IN(7)) {
        for (int i = gw * 64 + lane; i < MAXSLOT; i += NGW * 64) slot_tok[i] = 0;
        LAS float* comb = (LAS float*)(lds);
        LAS float* lgb = (LAS float*)(lds + 16384);
        LAS int* hist = (LAS int*)(lds + 40960);
        const int r16 = lane & 15, kq = lane >> 4, gi = wave & 3, kh = wave >> 2;
        for (int rg0 = 0; rg0 < 1024; rg0 += 4 * G) {
            const int rg = rg0 + gi * G + vcu; const bool active = rg < 1024;
            const size_t row = (size_t)(active ? rg : 0) * 16 + r16;
            const f32x4* xp = (const f32x4*)(X1 + row * DM + 8 * kq); const f32x4* gp = (const f32x4*)(a.norm_ffn_g + 8 * kq);
            unsigned* hp = (unsigned*)(H8 + row * DM + 8 * kq);
            f32x4 acc0 = (f32x4){0.f, 0.f, 0.f, 0.f}, acc1 = (f32x4){0.f, 0.f, 0.f, 0.f}; float ssq = 0.f;
            for (int h = 0; h < 2; ++h) {
                { const u32x4* src = (const u32x4*)WRF + (size_t)h * 8192 + tid; LAS u32x4* dst = (LAS u32x4*)lds + tid;
#pragma unroll
                  for (int i = 0; i < 16; ++i) dst[512 * i] = src[512 * i]; }
                __syncthreads();
                if (active) {
                    const LAS f32x4* wl = (const LAS f32x4*)lds + (size_t)(2 * 32 * kh) * 64 + lane;
                    const int jb = 64 * h + 32 * kh;
#pragma unroll 4
                    for (int jj = 0; jj < 32; ++jj) { const int j = jb + jj;
                        const int ko = 8 * (j >> 1) + (j & 1);
                        const f32x4 av = xp[ko], gv = gp[ko], b0 = wl[(2 * jj) * 64], b1 = wl[(2 * jj + 1) * 64];
                        ssq += (av.x * av.x + av.y * av.y) + (av.z * av.z + av.w * av.w);
                        hp[ko] = pk4_fp8(av.x * gv.x * 16.0f, av.y * gv.y * 16.0f, av.z * gv.z * 16.0f, av.w * gv.w * 16.0f);
                        acc0 = __builtin_amdgcn_mfma_f32_16x16x4f32(av.x, b0.x, acc0, 0, 0, 0); acc1 = __builtin_amdgcn_mfma_f32_16x16x4f32(av.x, b1.x, acc1, 0, 0, 0);
                        acc0 = __builtin_amdgcn_mfma_f32_16x16x4f32(av.y, b0.y, acc0, 0, 0, 0); acc1 = __builtin_amdgcn_mfma_f32_16x16x4f32(av.y, b1.y, acc1, 0, 0, 0);
                        acc0 = __builtin_amdgcn_mfma_f32_16x16x4f32(av.z, b0.z, acc0, 0, 0, 0); acc1 = __builtin_amdgcn_mfma_f32_16x16x4f32(av.z, b1.z, acc1, 0, 0, 0);
                        acc0 = __builtin_amdgcn_mfma_f32_16x16x4f32(av.w, b0.w, acc0, 0, 0, 0); acc1 = __builtin_amdgcn_mfma_f32_16x16x4f32(av.w, b1.w, acc1, 0, 0, 0); }
                }
                __syncthreads();
            }
            ssq += __shfl_xor(ssq, 16); ssq += __shfl_xor(ssq, 32);
            if (kh == 1) { LAS float* c = comb + (gi * 64 + lane) * 12;
#pragma unroll
                for (int j = 0; j < 4; ++j) { c[j] = acc0[j]; c[4 + j] = acc1[j]; }
                c[8] = ssq; }
            if (tid < 64) hist[tid] = 0;
            __syncthreads();
            int te[4] = {0, 0, 0, 0}, lr[4] = {0, 0, 0, 0}; float tw[4] = {0.f, 0.f, 0.f, 0.f}; float rs = 0.f;
            if (active && kh == 0) {
                const LAS float* c = comb + (gi * 64 + lane) * 12;
#pragma unroll
                for (int j = 0; j < 4; ++j) { acc0[j] += c[j]; acc1[j] += c[4 + j]; }
                ssq += c[8];
                rs = 1.0f / sqrtf(ssq * (1.0f / DM) + EPS);
                LAS float* lg = lgb + gi * (16 * 36);
#pragma unroll
                for (int j = 0; j < 4; ++j) { lg[(4 * kq + j) * 36 + r16] = acc0[j]; lg[(4 * kq + j) * 36 + 16 + r16] = acc1[j]; }
                LDS_WAIT(); asm volatile("" ::: "memory");
                if (lane < 16) {
                    float l[32];
#pragma unroll
                    for (int n = 0; n < 32; ++n) l[n] = lg[lane * 36 + n] * rs + a.b_router[n];
                    float tv[4];
#pragma unroll
                    for (int k = 0; k < 4; ++k) { float bv = -3.0e38f; int bi = 0;
#pragma unroll
                        for (int n = 0; n < 32; ++n) if (l[n] > bv) { bv = l[n]; bi = n; }
                        tv[k] = bv; te[k] = bi;
#pragma unroll
                        for (int n = 0; n < 32; ++n) l[n] = (n == bi) ? -3.0e38f : l[n]; }
                    float den = 0.f;
#pragma unroll
                    for (int k = 0; k < 4; ++k) { tw[k] = expf(tv[k] - tv[0]); den += tw[k]; }
                    const float inv = 1.0f / den;
#pragma unroll
                    for (int k = 0; k < 4; ++k) { tw[k] *= inv; lr[k] = __hip_atomic_fetch_add(&hist[te[k]], 1, __ATOMIC_RELAXED, __HIP_MEMORY_SCOPE_WORKGROUP); }
                }
            }
            __syncthreads();
            if (tid < 32) { const int c = hist[tid]; hist[32 + tid] = c ? (int)__hip_atomic_fetch_add(ctl + CW_CNT + 64 * tid, (unsigned)c, RLX_AGENT) : 0; }
            __syncthreads();
            if (active && kh == 0 && lane < 16) { const size_t orow = (size_t)rg * 16 + lane;
#pragma unroll
                for (int k = 0; k < 4; ++k) { tk_e[orow * 4 + k] = te[k]; tk_rank[orow * 4 + k] = hist[32 + te[k]] + lr[k]; tk_w[orow * 4 + k] = tw[k]; }
                rs_tok[orow] = rs; }
            __syncthreads();
        }
        if (BOTH(7)) GRID_BAR();
    }

    if (IN(8)) {
        if (tid == 0) { int ps = 0, mt = 0;
            for (int e = 0; e < NE; ++e) { const int c = (int)__hip_atomic_load(ctl + CW_CNT + 64 * e, RLX_AGENT); pstart[e] = ps; const int nt = (c + 255) >> 8; for (int i = 0; i < nt; ++i) tile_e[mt + i] = e; mt += nt; ps += nt << 8; }
            pstart[NE] = ps; MISC[16] = (unsigned)mt; }
        __syncthreads();
        for (int p0 = gw * 64; p0 < NTOK * 4; p0 += NGW * 64) { const int p = p0 + lane;
            const int tok = p >> 2; const int e = tk_e[p], rk = tk_rank[p]; const int slot = pstart[e] + rk;
            { tk_slot[p] = slot; slot_w[slot] = tk_w[p]; slot_rs[slot] = rs_tok[tok]; slot_tok[slot] = tok; }
        }
        if (BOTH(8)) GRID_BAR();
    }

    if (IN(9)) {
        const int MT = (int)MISC[16];
        LAS int* tokt = (LAS int*)(lds + TOKT_OFF);
        const int ng9 = (G == 256) ? NG9 : G;
        if (bx < ng9) {
        pg8::GroupedOrder S; S.init(MT, 16, ng9, bx); S.tile_e = tile_e;
        { pg8::Unit u; for (int i = 0; i < TOKT_UNITS && S.next(i, u); ++i) if (tid < 256) tokt[i * 256 + tid] = slot_tok[u.pm * 256 + tid]; }
        __syncthreads();
        pg8::Gemm g{H8, WGU8, DM, nullptr, nullptr, tokt}; pg8::EpiSwiglu8 E{a.b_gate_up, slot_rs, ACT8};
        pg8::gemm_phase<true, 1, true>(lds, g, S, E);
        }
        moe_convert_queue(ctl + CW_Q2, NQ_MOE - NQ_TAIL, NQ_MOE, a.w_gate_up, a.w_down, WGU8, WD8, lane);
        if (BOTH(9)) GRID_BAR();
    }
    if (IN(10)) {
        const int MT = (int)MISC[16];
        pg8::Gemm g{ACT8, WD8, DFF, nullptr, nullptr, nullptr}; pg8::GroupedOrder S; S.init(MT, 8, G, bx); S.tile_e = tile_e; pg8::EpiDown8 E{a.b_down, slot_w, YS8};
        pg8::gemm_phase<true, 1, false>(lds, g, S, E);
        if (BOTH(10)) GRID_BAR();
    }
#endif

    if (IN(11)) {
        f32x4 gv[8];
#pragma unroll
        for (int j = 0; j < 8; ++j) gv[j] = *((const f32x4*)a.norm_final_g + lane + 64 * j);
        for (int m = gw; m < NTOK; m += NGW) {
#if DBG_STAGE >= 1
            const f32x4* xr = (const f32x4*)(X1 + (size_t)m * DM) + lane;
#else
            const f32x4* xr = (const f32x4*)(a.x + (size_t)m * DM) + lane;
#endif
            f32x4 v[8];
#pragma unroll
            for (int j = 0; j < 8; ++j) v[j] = xr[64 * j];
#if DBG_STAGE >= 3
#pragma unroll
            for (int k = 0; k < 4; ++k) { const int slot = tk_slot[m * 4 + k]; const unsigned* yp = (const unsigned*)(YS8 + (size_t)slot * DM) + lane;
#pragma unroll
                for (int j = 0; j < 8; ++j) { const int w = (int)yp[64 * j]; const f32x2 lo = __builtin_amdgcn_cvt_pk_f32_fp8(w, false), hi = __builtin_amdgcn_cvt_pk_f32_fp8(w, true);
                    v[j].x += lo.x * (1.0f / 64.0f); v[j].y += lo.y * (1.0f / 64.0f); v[j].z += hi.x * (1.0f / 64.0f); v[j].w += hi.y * (1.0f / 64.0f); } }
#endif
            float s = 0.f;
#pragma unroll
            for (int j = 0; j < 8; ++j) s += (v[j].x * v[j].x + v[j].y * v[j].y) + (v[j].z * v[j].z + v[j].w * v[j].w);
            const float rs = 1.0f / sqrtf(wave_sum(s) * (1.0f / DM) + EPS);
            f32x4* o = (f32x4*)(a.out + (size_t)m * DM) + lane;
#pragma unroll
            for (int j = 0; j < 8; ++j) o[64 * j] = v[j] * rs * gv[j];
        }
    }
#undef IN
#undef BOTH
#undef GRID_BAR
}

extern "C" void kernel_launch(void* const* d_in, const int* in_sizes, int n_in, void* d_out, int out_size, void* d_ws, size_t ws_size, hipStream_t stream) {
    static int grid = 0;
    if (grid == 0) {
        if (n_in != 19 || in_sizes[0] != NTOK * DM || out_size != NTOK * DM || ws_size < WS_END) { fprintf(stderr, "kernel_launch: unexpected shapes (n_in %d, in0 %d, out %d, ws %zu); nothing launched\n", n_in, n_in > 0 ? in_sizes[0] : -1, out_size, ws_size); grid = -1; return; }
        int dev = 0, cus = 0, per_cu = 0;
        if (hipGetDevice(&dev) != hipSuccess || hipDeviceGetAttribute(&cus, hipDeviceAttributeMultiprocessorCount, dev) != hipSuccess) { grid = -1; return; }
        if (hipFuncSetAttribute((const void*)mega_fwd, hipFuncAttributeMaxDynamicSharedMemorySize, LDS_BYTES) != hipSuccess) { fprintf(stderr, "kernel_launch: hipFuncSetAttribute failed\n"); grid = -1; return; }
        if (hipOccupancyMaxActiveBlocksPerMultiprocessor(&per_cu, (const void*)mega_fwd, NWAVES * 64, LDS_BYTES) != hipSuccess || per_cu < 1) { fprintf(stderr, "kernel_launch: occupancy query reports %d blocks per CU\n", per_cu); per_cu = 1; }
        (void)hipGetLastError();
        grid = cus;
    }
    if (grid < 0) return;
    if (hipMemsetAsync((char*)d_ws + WS_CTL, 0, CTL_ZERO_BYTES, stream) != hipSuccess) { fprintf(stderr, "kernel_launch: memset failed\n"); return; }
    Args a{};
    a.x = (const float*)d_in[0]; a.norm_mix_g = (const float*)d_in[1]; a.w_in = (const float*)d_in[2]; a.conv_w = (const float*)d_in[3]; a.conv_b = (const float*)d_in[4]; a.w_a2 = (const float*)d_in[5];
    a.b_a = (const float*)d_in[6]; a.gla_norm_g = (const float*)d_in[7]; a.w_br_a = (const float*)d_in[8]; a.w_br_b = (const float*)d_in[9]; a.w_out = (const float*)d_in[10]; a.norm_ffn_g = (const float*)d_in[11];
    a.w_router = (const float*)d_in[12]; a.b_router = (const float*)d_in[13]; a.w_gate_up = (const float*)d_in[14]; a.b_gate_up = (const float*)d_in[15]; a.w_down = (const float*)d_in[16]; a.b_down = (const float*)d_in[17];
    a.norm_final_g = (const float*)d_in[18]; a.out = (float*)d_out; a.ws = (unsigned char*)d_ws; a.ph_lo = 0; a.ph_hi = 12;
    hipLaunchKernelGGL(mega_fwd, dim3(grid), dim3(NWAVES * 64), LDS_BYTES, stream, a);
    const hipError_t le = hipPeekAtLastError();
    if (le != hipSuccess) fprintf(stderr, "kernel_launch: launch failed: %s\n", hipGetErrorName(le));
}
```

```cpp
#include <hip/hip_runtime.h>
#include <cstdio>
#include <cstdint>

#ifndef DBG_STAGE
#define DBG_STAGE 3
#endif

#ifndef REP_P0
#define REP_P0 1
#endif
#ifndef REP_P2
#define REP_P2 1
#endif
#define LAS __attribute__((address_space(3)))
#define GAS __attribute__((address_space(1)))
typedef unsigned short bf16;
typedef short bf16x8 __attribute__((ext_vector_type(8)));
typedef float f32x4 __attribute__((ext_vector_type(4)));
typedef float f32x2 __attribute__((ext_vector_type(2)));
typedef unsigned u32x4 __attribute__((ext_vector_type(4)));
typedef unsigned u32x2 __attribute__((ext_vector_type(2)));

constexpr int NTOK = 16384, DM = 2048, SEQ = 2048, NBATCH = 8;
constexpr int NP = 10496;
constexpr int PC_UC = 0, PC_UB = 1024, PC_UX = 2048, PC_Q = 3072, PC_K = 3584, PC_V = 4096, PC_R = 5120, PC_AL = 6144, PC_GA = 6400, PC_GB = 8448;
constexpr int SRC_AL = 6144;
constexpr int DIN = 10256;
constexpr int NE = 32, TOPK = 4, DFF = 2048;
constexpr int MAXSLOT = NTOK * TOPK + NE * 256;
constexpr int MAXMT = MAXSLOT / 256;
constexpr float EPS = 1e-6f;

constexpr size_t MiB = 1u << 20;
constexpr size_t WS_CTL = 0, CTL_ZERO_BYTES = 1 * MiB;
constexpr size_t WS_WRF = 1 * MiB;
constexpr size_t WS_TK = 2 * MiB;
constexpr size_t WS_SLOT = 4 * MiB;
constexpr size_t WS_WIN = 8 * MiB;
constexpr size_t WS_WA = 50 * MiB;
constexpr size_t WS_WB = 54 * MiB;
constexpr size_t WS_WO = 58 * MiB;
constexpr size_t WS_WGU = 66 * MiB;
constexpr size_t WS_WD = 578 * MiB;
constexpr size_t WS_H = 834 * MiB;
constexpr size_t WS_P = 898 * MiB;
constexpr size_t WS_ZA = 1226 * MiB;
constexpr size_t WS_ZB = 1258 * MiB;
constexpr size_t WS_O = 1290 * MiB;
constexpr size_t WS_YA = 1354 * MiB;
constexpr size_t WS_MIX = 1418 * MiB;
constexpr size_t WS_X1 = 1482 * MiB;
constexpr size_t WS_XB = 1610 * MiB;
constexpr size_t WS_ACT = 1898 * MiB;
constexpr size_t WS_YS = 2186 * MiB;
constexpr size_t WS_KTT = 2474 * MiB;
constexpr size_t WS_DEC = 2490 * MiB;
constexpr size_t WS_VTT = 2492 * MiB;
constexpr size_t WS_WIN8 = 2524 * MiB;
constexpr size_t WS_HQ8 = 2532 * MiB;
constexpr size_t WS_END = 2564 * MiB;
constexpr int CW_BAR = 4096;
constexpr int CW_Q3 = 8320;
constexpr int CW_Q2 = 8256;
constexpr int CW_Q = 8192;
constexpr int NGEMM = 208, QBATCH = 8;
constexpr int CW_CNT = 16384;

constexpr int RING_BYTES = 131072;
constexpr int TOKT_OFF = 131072, TOKT_UNITS = 30;
constexpr int LDSCTL_OFF = 161792;
constexpr int MISC_OFF = LDSCTL_OFF;
constexpr int TILEE_OFF = LDSCTL_OFF + 128;
constexpr int PSTART_OFF = TILEE_OFF + 4 * 320;
constexpr int LDS_BYTES = 163840;
constexpr int NWAVES = 8;

#define LDS_WAIT() asm volatile("s_waitcnt lgkmcnt(0)" ::: "memory")
#define VM_WAIT() asm volatile("s_waitcnt vmcnt(0)" ::: "memory")
#define RLX_AGENT __ATOMIC_RELAXED, __HIP_MEMORY_SCOPE_AGENT

typedef __bf16 bf16x2_t __attribute__((ext_vector_type(2)));
__device__ __forceinline__ unsigned cvt_pk_bf16(float lo, float hi) { f32x2 v = {lo, hi}; bf16x2_t b = __builtin_convertvector(v, bf16x2_t); return __builtin_bit_cast(unsigned, b); }
__device__ __forceinline__ float clamp448(float x) { return __builtin_amdgcn_fmed3f(x, -448.0f, 448.0f); }
__device__ __forceinline__ unsigned pk4_fp8(float a, float b, float c, float d) {
    int w = 0; w = __builtin_amdgcn_cvt_pk_fp8_f32(clamp448(a), clamp448(b), w, false); w = __builtin_amdgcn_cvt_pk_fp8_f32(clamp448(c), clamp448(d), w, true); return (unsigned)w; }
__device__ __forceinline__ float bf_lo(unsigned w) { return __uint_as_float(w << 16); }
__device__ __forceinline__ float bf_hi(unsigned w) { return __uint_as_float(w & 0xffff0000u); }
__device__ __forceinline__ float bf2f(bf16 b) { return __uint_as_float(((unsigned)b) << 16); }
__device__ __forceinline__ float fast_sigmoid(float x) { return __builtin_amdgcn_rcpf(1.0f + __builtin_amdgcn_exp2f(-1.44269504089f * x)); }
__device__ __forceinline__ float wave_sum(float v) {
#pragma unroll
    for (int o = 1; o < 64; o <<= 1) v += __shfl_xor(v, o);
    return v;
}

namespace pg8 {
constexpr int BM = 256, BK = 64, HALF = 128, HTB = HALF * BK * 2, STAGE_BYTES = 8 * HTB, NXCD = 8, WGM = 8;
__host__ __device__ __forceinline__ int lds_byte(int r, int c) { const int st = (r >> 4) * 2 + (c >> 5), rr = r & 15, cc = c & 31, ob = rr * 64 + cc * 2; return st * 1024 + (ob ^ (((ob >> 9) & 1) << 5)); }
__host__ __device__ __forceinline__ void stage_rc(int b, int& R, int& C) { const int st = b / 1024, sb = b % 1024, swz = sb ^ (((sb >> 9) & 1) << 5); R = (st >> 1) * 16 + swz / 64; C = (st & 1) * 32 + (swz % 64) / 2; }
__host__ __device__ __forceinline__ int perm32(int rho) { const int n = rho >> 4, i = rho & 15; return 8 * (i >> 2) + 4 * n + (i & 3); }

struct Unit { int pm, pn, pb, e; };
struct Gemm { const void* A; const void* Bt; int ldb; const void* A2; const void* Bt2; const LAS int* tokt; };

struct StaticOrder {
    int nM, nN, nwg, G, c, wgm;
    __device__ void init(int nM_, int nN_, int G_, int c_, int wgm_ = WGM) { nM = nM_; nN = nN_; nwg = nM * nN; G = G_; c = c_; wgm = wgm_; }
    __device__ __forceinline__ bool tile(int i, int& pm, int& pn) const {
        const long L = (long)i * G + c; if (L >= nwg) return false;
        int wgid = (int)L; { const int q = nwg / NXCD, r = nwg % NXCD, xcd = wgid % NXCD, off = wgid / NXCD; wgid = (xcd < r ? xcd * (q + 1) : r * (q + 1) + (xcd - r) * q) + off; }
        const int nig = wgm * nN, gid = wgid / nig, fm = gid * wgm, gsz = (nM - fm) < wgm ? (nM - fm) : wgm;
        pm = fm + ((wgid % nig) % gsz); pn = (wgid % nig) / gsz; return true;
    }
    __device__ __forceinline__ bool next(int i, Unit& u) const { if (!tile(i, u.pm, u.pn)) return false; u.pb = u.pn; u.e = 0; return true; }
};
struct GroupedOrder : StaticOrder {
    const LAS int* tile_e;
    __device__ __forceinline__ bool next(int i, Unit& u) const { if (!tile(i, u.pm, u.pn)) return false; u.e = tile_e[u.pm]; u.pb = u.e * nN + u.pn; return true; }
};

struct EpiPlainBf16 {
    static constexpr bool HASPRE = false; struct Pre {};
    static constexpr bool PERM = true;
    bf16* O; int ldc; int colbase; float scale;
    __device__ __forceinline__ void operator()(const f32x4 (&acc)[2][2][4][2], const Unit& u, int wr, int wc, int fr, int fq) const {
        const int row0 = u.pm * BM + wr * 64 + fr, col0 = colbase + u.pn * BM + wc * 32 + 8 * fq;
#pragma unroll
        for (int ai = 0; ai < 2; ++ai)
#pragma unroll
            for (int m = 0; m < 4; ++m) { bf16* rowp = O + (size_t)(row0 + ai * HALF + m * 16) * ldc + col0;
#pragma unroll
                for (int bj = 0; bj < 2; ++bj) { const f32x4 v0 = acc[ai][bj][m][0] * scale, v1 = acc[ai][bj][m][1] * scale;
                    u32x4 w; w.x = cvt_pk_bf16(v0[0], v0[1]); w.y = cvt_pk_bf16(v0[2], v0[3]); w.z = cvt_pk_bf16(v1[0], v1[1]); w.w = cvt_pk_bf16(v1[2], v1[3]);
                    *(u32x4*)(rowp + bj * HALF) = w; } }
    }
};
struct EpiPlainFp8 {
    static constexpr bool HASPRE = false; struct Pre {};
    static constexpr bool PERM = true;
    unsigned char* O8; int ldc; float scale;
    __device__ __forceinline__ void operator()(const f32x4 (&acc)[2][2][4][2], const Unit& u, int wr, int wc, int fr, int fq) const {
        const int row0 = u.pm * BM + wr * 64 + fr, col0 = u.pn * BM + wc * 32 + 8 * fq;
#pragma unroll
        for (int ai = 0; ai < 2; ++ai)
#pragma unroll
            for (int m = 0; m < 4; ++m) { unsigned char* rowp = O8 + (size_t)(row0 + ai * HALF + m * 16) * ldc + col0;
#pragma unroll
                for (int bj = 0; bj < 2; ++bj) { const f32x4 v0 = acc[ai][bj][m][0] * scale, v1 = acc[ai][bj][m][1] * scale;
                    u32x2 w; w.x = pk4_fp8(v0[0], v0[1], v0[2], v0[3]); w.y = pk4_fp8(v1[0], v1[1], v1[2], v1[3]);
                    *(u32x2*)(rowp + bj * HALF) = w; } }
    }
};
struct EpiGate2 {
    static constexpr bool HASPRE = false; struct Pre {};
    static constexpr bool PERM = true;
    const unsigned char* G8; bf16* O;
    __device__ __forceinline__ void mid(f32x4 (&acc)[2][2][4][2], const Unit& u, int wr, int wc, int fr, int fq) const {
        int opq = 0; asm volatile("" : "+v"(opq));
        const int row0 = u.pm * BM + wr * 64 + fr + opq, col0 = u.pn * BM + wc * 32 + 8 * fq;
        u32x2 ga[2][2], gb[2][2];
#define EG2_LOAD(buf, g_) do { const size_t row_ = (size_t)(row0 + ((g_) >> 2) * HALF + ((g_) & 3) * 16); _Pragma("unroll") for (int bj = 0; bj < 2; ++bj) { const int col_ = col0 + bj * HALF; \
            ga[buf][bj] = *(const u32x2*)(G8 + row_ * 4096 + col_); gb[buf][bj] = *(const u32x2*)(G8 + row_ * 4096 + 2048 + col_); } } while (0)
        EG2_LOAD(0, 0);
#pragma unroll
        for (int g = 0; g < 8; ++g) { const int ai = g >> 2, m = g & 3, cb = g & 1;
            if (g + 1 < 8) { if (cb) EG2_LOAD(0, g + 1); else EG2_LOAD(1, g + 1); }
            asm volatile("" ::: "memory");
#pragma unroll
            for (int bj = 0; bj < 2; ++bj) {
#pragma unroll
                for (int q = 0; q < 4; ++q) {
                    const int gaw_ = (int)(q < 2 ? ga[cb][bj].x : ga[cb][bj].y), gbw_ = (int)(q < 2 ? gb[cb][bj].x : gb[cb][bj].y);
                    const f32x2 a2 = (q & 1) ? __builtin_amdgcn_cvt_pk_f32_fp8(gaw_, true) : __builtin_amdgcn_cvt_pk_f32_fp8(gaw_, false), b2 = (q & 1) ? __builtin_amdgcn_cvt_pk_f32_fp8(gbw_, true) : __builtin_amdgcn_cvt_pk_f32_fp8(gbw_, false);
                    const float r0 = (1.0f + __builtin_amdgcn_exp2f(-0.0901684400556f * b2.x)) * __builtin_amdgcn_rcpf(1.0f + __builtin_amdgcn_exp2f(-0.0901684400556f * a2.x));
                    const float r1 = (1.0f + __builtin_amdgcn_exp2f(-0.0901684400556f * b2.y)) * __builtin_amdgcn_rcpf(1.0f + __builtin_amdgcn_exp2f(-0.0901684400556f * a2.y));
                    acc[ai][bj][m][q >> 1][2 * (q & 1)] *= r0; acc[ai][bj][m][q >> 1][2 * (q & 1) + 1] *= r1; } } }
#undef EG2_LOAD
    }
    __device__ __forceinline__ void operator()(const f32x4 (&acc)[2][2][4][2], const Unit& u, int wr, int wc, int fr, int fq) const {
        const int row0 = u.pm * BM + wr * 64 + fr, col0 = u.pn * BM + wc * 32 + 8 * fq;
#pragma unroll
        for (int ai = 0; ai < 2; ++ai)
#pragma unroll
            for (int m = 0; m < 4; ++m) { const size_t row = (size_t)(row0 + ai * HALF + m * 16);
#pragma unroll
                for (int bj = 0; bj < 2; ++bj) { const int col = col0 + bj * HALF;
                    const u32x2 g = *(const u32x2*)(G8 + row * 4096 + 2048 + col);
                    f32x4 v0 = acc[ai][bj][m][0], v1 = acc[ai][bj][m][1];
                    { const f32x2 g0 = __builtin_amdgcn_cvt_pk_f32_fp8((int)g.x, false), g1 = __builtin_amdgcn_cvt_pk_f32_fp8((int)g.x, true), g2 = __builtin_amdgcn_cvt_pk_f32_fp8((int)g.y, false), g3 = __builtin_amdgcn_cvt_pk_f32_fp8((int)g.y, true);
                      v0[0] *= fast_sigmoid(0.0625f * g0.x); v0[1] *= fast_sigmoid(0.0625f * g0.y); v0[2] *= fast_sigmoid(0.0625f * g1.x); v0[3] *= fast_sigmoid(0.0625f * g1.y);
                      v1[0] *= fast_sigmoid(0.0625f * g2.x); v1[1] *= fast_sigmoid(0.0625f * g2.y); v1[2] *= fast_sigmoid(0.0625f * g3.x); v1[3] *= fast_sigmoid(0.0625f * g3.y); }
                    u32x4 w; w.x = cvt_pk_bf16(v0[0], v0[1]); w.y = cvt_pk_bf16(v0[2], v0[3]); w.z = cvt_pk_bf16(v1[0], v1[1]); w.w = cvt_pk_bf16(v1[2], v1[3]);
                    *(u32x4*)(O + row * DM + col) = w; } }
    }
};
struct EpiResF32 {
    static constexpr bool HASPRE = false; struct Pre {};
    static constexpr bool PERM = false;
    const float* base; float* C;
    __device__ __forceinline__ void operator()(const f32x4 (&acc)[2][2][4][2], const Unit& u, int wr, int wc, int fr, int fq) const {
        const int row0 = u.pm * BM + wr * 64 + fr, col0 = u.pn * BM + wc * 32 + 4 * fq;
#pragma unroll
        for (int ai = 0; ai < 2; ++ai)
#pragma unroll
            for (int m = 0; m < 4; ++m) { const size_t off = (size_t)(row0 + ai * HALF + m * 16) * DM + col0;
#pragma unroll
                for (int bj = 0; bj < 2; ++bj)
#pragma unroll
                    for (int n = 0; n < 2; ++n) { const f32x4 b = *(const f32x4*)(base + off + bj * HALF + n * 16); *(f32x4*)(C + off + bj * HALF + n * 16) = acc[ai][bj][m][n] + b; } }
    }
};
struct EpiSwiglu8 {
    static constexpr bool PERM = true;
    static constexpr bool HASPRE = true;
    struct Pre { f32x4 bg0, bg1, bu0, bu1; float rs[4]; };
    const float* bgu; const float* slot_rs; unsigned char* ACT8;
    __device__ __forceinline__ void prefetch(Pre& p, const Unit& u, int wr, int wc, int fr, int fq) const {
        const int row0 = u.pm * BM + wr * 64 + fr, cl = u.pn * HALF + wc * 32 + 8 * fq;
        const float* bg = bgu + (size_t)u.e * (2 * DFF) + cl;
        p.bg0 = *(const f32x4*)(bg); p.bg1 = *(const f32x4*)(bg + 4); p.bu0 = *(const f32x4*)(bg + DFF); p.bu1 = *(const f32x4*)(bg + DFF + 4);
#pragma unroll
        for (int m = 0; m < 4; ++m) p.rs[m] = slot_rs[(size_t)(row0 + m * 16)];
    }
    __device__ __forceinline__ void operator()(const f32x4 (&acc)[2][2][4][2], const Unit& u, int wr, int wc, int fr, int fq, const Pre& p) const {
        const int row0 = u.pm * BM + wr * 64 + fr, cl = u.pn * HALF + wc * 32 + 8 * fq;
        const f32x4 bg0 = p.bg0, bg1 = p.bg1, bu0 = p.bu0, bu1 = p.bu1;
        float rs1[4];
#pragma unroll
        for (int m = 0; m < 4; ++m) rs1[m] = slot_rs[(size_t)(row0 + HALF + m * 16)];
#pragma unroll
        for (int ai = 0; ai < 2; ++ai)
#pragma unroll
            for (int m = 0; m < 4; ++m) { const size_t row = (size_t)(row0 + ai * HALF + m * 16); const float rs = (ai ? rs1[m] : p.rs[m]) * (1.0f / 16384.0f);
                const f32x4 g0 = acc[ai][0][m][0] * rs + bg0, g1 = acc[ai][0][m][1] * rs + bg1, u0 = acc[ai][1][m][0] * rs + bu0, u1 = acc[ai][1][m][1] * rs + bu1;
                float o[8];
#pragma unroll
                for (int j = 0; j < 4; ++j) {
                    float g = fminf(g0[j], 7.0f), up = __builtin_amdgcn_fmed3f(u0[j], -7.0f, 7.0f);
                    o[j] = (up * 4.0f + 4.0f) * (g * __builtin_amdgcn_rcpf(1.0f + __builtin_amdgcn_exp2f(-2.45546696f * g)));
                    g = fminf(g1[j], 7.0f); up = __builtin_amdgcn_fmed3f(u1[j], -7.0f, 7.0f);
                    o[4 + j] = (up * 4.0f + 4.0f) * (g * __builtin_amdgcn_rcpf(1.0f + __builtin_amdgcn_exp2f(-2.45546696f * g))); }
                u32x2 w; { int t_ = 0; t_ = __builtin_amdgcn_cvt_pk_fp8_f32(o[0], o[1], t_, false); t_ = __builtin_amdgcn_cvt_pk_fp8_f32(o[2], o[3], t_, true); w.x = (unsigned)t_;
                           t_ = 0; t_ = __builtin_amdgcn_cvt_pk_fp8_f32(o[4], o[5], t_, false); t_ = __builtin_amdgcn_cvt_pk_fp8_f32(o[6], o[7], t_, true); w.y = (unsigned)t_; }
                *(u32x2*)(ACT8 + row * DFF + cl) = w; }
    }
};
struct EpiDown8 {
    static constexpr bool PERM = true;
    static constexpr bool HASPRE = true;
    struct Pre { f32x4 bv[2][2]; float sw[8]; };
    const float* bd; const float* slot_w; unsigned char* YS8;
    __device__ __forceinline__ void prefetch(Pre& p, const Unit& u, int wr, int wc, int fr, int fq) const {
        const int row0 = u.pm * BM + wr * 64 + fr, col0 = u.pn * BM + wc * 32 + 8 * fq;
        const float* bp = bd + (size_t)u.e * DM + col0;
#pragma unroll
        for (int bj = 0; bj < 2; ++bj)
#pragma unroll
            for (int n = 0; n < 2; ++n) p.bv[bj][n] = *(const f32x4*)(bp + bj * HALF + 4 * n);
#pragma unroll
        for (int ai = 0; ai < 2; ++ai)
#pragma unroll
            for (int m = 0; m < 4; ++m) p.sw[ai * 4 + m] = slot_w[(size_t)(row0 + ai * HALF + m * 16)];
    }
    __device__ __forceinline__ void operator()(const f32x4 (&acc)[2][2][4][2], const Unit& u, int wr, int wc, int fr, int fq, const Pre& p) const {
        const int row0 = u.pm * BM + wr * 64 + fr, col0 = u.pn * BM + wc * 32 + 8 * fq;
#pragma unroll
        for (int ai = 0; ai < 2; ++ai)
#pragma unroll
            for (int m = 0; m < 4; ++m) { const size_t row = (size_t)(row0 + ai * HALF + m * 16); const float sw = p.sw[ai * 4 + m] * 64.0f;
#pragma unroll
                for (int bj = 0; bj < 2; ++bj) { const f32x4 v0 = (acc[ai][bj][m][0] * (1.0f / 4096.0f) + p.bv[bj][0]) * sw, v1 = (acc[ai][bj][m][1] * (1.0f / 4096.0f) + p.bv[bj][1]) * sw;
                    u32x2 w; w.x = pk4_fp8(v0[0], v0[1], v0[2], v0[3]); w.y = pk4_fp8(v1[0], v1[1], v1[2], v1[3]);
                    *(u32x2*)(YS8 + row * DM + col0 + bj * HALF) = w; } }
    }
};

typedef int v4i_t __attribute__((ext_vector_type(4)));
typedef int v8i_t __attribute__((ext_vector_type(8)));
template <bool F8, int NSEG, bool GATHER, class Epi, class Sched>
__device__ __forceinline__ void gemm_phase(LAS unsigned char* lds, const Gemm g, const Sched& S, const Epi& E) {
    const int tid = threadIdx.x, wid = __builtin_amdgcn_readfirstlane(tid >> 6), lane = tid & 63, wr = wid >> 2, wc = wid & 3, fr = lane & 15, fq = lane >> 4;
    const int ldb = g.ldb, nt = ldb / 128;
    unsigned voffA[2], voffB[2];
#pragma unroll
    for (int i = 0; i < 2; ++i) { int R, C; stage_rc(tid * 16 + i * 8192, R, C); const int Rb = Epi::PERM ? ((R & ~31) + perm32(R & 31)) : R;
        voffA[i] = (unsigned)(R * ldb + C * 2); voffB[i] = (unsigned)(Rb * ldb + C * 2); }
    const size_t kstep = (size_t)128;
    const size_t hstep = (size_t)HALF * ldb;
    const size_t tstep = 2 * hstep;
    const unsigned ldsw = (unsigned)wid * 1024u;
    const int aoff = lds_byte(wr * 64 + fr, fq * 8), boff = lds_byte(wc * 32 + fr, fq * 8);
#define PG8_SA(b, h) (((b) * 2 + (h)) * HTB)
#define PG8_SB(b, h) ((4 + (b) * 2 + (h)) * HTB)
#define PG8_STAGE(bufoff, gbase, voff) do { _Pragma("unroll") for (int _i = 0; _i < 2; ++_i) \
        __builtin_amdgcn_global_load_lds((const unsigned*)((const char*)(gbase) + (voff)[_i]), (LAS unsigned*)(lds + (bufoff) + ldsw + _i * 8192), 16, 0, 0); } while (0)
#define PG8_STAGE_A(bufoff, gbase, h, nx) do { if constexpr (GATHER) { unsigned vv_[2]; vv_[0] = (nx) ? offAn[h][0] : offA[h][0]; vv_[1] = (nx) ? offAn[h][1] : offA[h][1]; PG8_STAGE(bufoff, gbase, vv_); } \
        else { PG8_STAGE(bufoff, (gbase) + ((h) ? hstep : (size_t)0), voffA); } } while (0)
#define PG8_LDA(dst, b, h) do { _Pragma("unroll") for (int m = 0; m < 4; ++m) _Pragma("unroll") for (int k = 0; k < 2; ++k) dst[m][k] = *(const LAS bf16x8*)(lds + PG8_SA(b, h) + aoff + m * 2048 + k * 1024); } while (0)
#define PG8_LDB(dst, b, h) do { _Pragma("unroll") for (int n = 0; n < 2; ++n) _Pragma("unroll") for (int k = 0; k < 2; ++k) dst[n][k] = *(const LAS bf16x8*)(lds + PG8_SB(b, h) + boff + n * 2048 + k * 1024); } while (0)
#define PG8_MMA(ai, bj, At, Bt) do { __builtin_amdgcn_s_setprio(1); if constexpr (F8) { asm volatile("s_nop 1"); _Pragma("unroll") for (int m = 0; m < 4; ++m) _Pragma("unroll") for (int n = 0; n < 2; ++n) \
        { const v8i_t b8_ = __builtin_shufflevector(__builtin_bit_cast(v4i_t, Bt[n][0]), __builtin_bit_cast(v4i_t, Bt[n][1]), 0, 1, 2, 3, 4, 5, 6, 7); \
          const v8i_t a8_ = __builtin_shufflevector(__builtin_bit_cast(v4i_t, At[m][0]), __builtin_bit_cast(v4i_t, At[m][1]), 0, 1, 2, 3, 4, 5, 6, 7); \
          asm volatile("v_mfma_scale_f32_16x16x128_f8f6f4 %0, %1, %2, %0, %3, %3 op_sel_hi:[0,0,0]" : "+v"(acc[ai][bj][m][n]) : "v"(b8_), "v"(a8_), "v"(sc8)); } } \
      else { _Pragma("unroll") for (int m = 0; m < 4; ++m) _Pragma("unroll") for (int n = 0; n < 2; ++n) _Pragma("unroll") for (int k = 0; k < 2; ++k) \
        acc[ai][bj][m][n] = __builtin_amdgcn_mfma_f32_16x16x32_bf16(Bt[n][k], At[m][k], acc[ai][bj][m][n], 0, 0, 0); } __builtin_amdgcn_s_setprio(0); } while (0)
#define PG8_WAIT_V(n) asm volatile("s_waitcnt vmcnt(" #n ")" ::: "memory")
#define PG8_WAIT_L(n) asm volatile("s_waitcnt lgkmcnt(" #n ")" ::: "memory")
#define PG8_BAR __builtin_amdgcn_s_barrier()
#define PG8_SCHED __builtin_amdgcn_sched_barrier(0)
    Unit cur, nxt; int ui = 0;
    if (!S.next(0, cur)) return;
    typename Epi::Pre pre; if constexpr (Epi::HASPRE) E.prefetch(pre, cur, wr, wc, fr, fq);
    int sc8 = 0; if constexpr (F8) { asm volatile("v_mov_b32 %0, 0x7f7f7f7f\n\ts_nop 1" : "=v"(sc8)); }
    f32x4 acc[2][2][4][2];
#pragma unroll
    for (int a = 0; a < 2; ++a)
#pragma unroll
        for (int b = 0; b < 2; ++b)
#pragma unroll
            for (int m = 0; m < 4; ++m)
#pragma unroll
                for (int n = 0; n < 2; ++n) acc[a][b][m][n] = (f32x4){0.f, 0.f, 0.f, 0.f};
    bf16x8 At[4][2], B0[2][2], B1[2][2];
    const char* cA = (const char*)g.A + (GATHER ? (size_t)0 : (size_t)cur.pm * tstep); const char* cB = (const char*)g.Bt + (size_t)cur.pb * tstep;
    constexpr bool DUAL = (NSEG == 2);
    unsigned offA[2][2] = {{0u, 0u}, {0u, 0u}}, offAn[2][2] = {{0u, 0u}, {0u, 0u}};
    int gR0 = 0, gC2 = 0; if constexpr (GATHER) { int R, C; stage_rc(tid * 16, R, C); gR0 = R; gC2 = C * 2;
#pragma unroll
        for (int h = 0; h < 2; ++h)
#pragma unroll
            for (int i = 0; i < 2; ++i) offA[h][i] = (unsigned)(g.tokt[128 * h + gR0 + 64 * i] * ldb + gC2);
        asm volatile("s_waitcnt lgkmcnt(0)" ::: "memory"); }
    PG8_STAGE(PG8_SB(0, 0), cB, voffB); PG8_STAGE_A(PG8_SA(0, 0), cA, 0, false); PG8_STAGE(PG8_SB(0, 1), cB + hstep, voffB); PG8_STAGE_A(PG8_SA(0, 1), cA, 1, false);
    if (wr == 1) PG8_BAR;
    PG8_WAIT_V(4); PG8_BAR;
    PG8_STAGE(PG8_SB(1, 0), cB + kstep, voffB); PG8_STAGE_A(PG8_SA(1, 0), cA + kstep, 0, false); PG8_STAGE(PG8_SB(1, 1), cB + hstep + kstep, voffB);
    PG8_WAIT_V(6); PG8_BAR;
    for (;;) {
        const bool has_next = S.next(ui + 1, nxt);
        if constexpr (GATHER) { if (has_next) {
#pragma unroll
            for (int h = 0; h < 2; ++h)
#pragma unroll
                for (int i = 0; i < 2; ++i) offAn[h][i] = (unsigned)(g.tokt[(ui + 1) * 256 + 128 * h + gR0 + 64 * i] * ldb + gC2); }
            asm volatile("s_waitcnt lgkmcnt(0)" ::: "memory"); }
        const char* nA = (has_next && !GATHER) ? (const char*)g.A + (size_t)nxt.pm * tstep : cA; const char* nB = has_next ? (const char*)g.Bt + (size_t)nxt.pb * tstep : cB;
        for (int t = 0; t < NSEG * nt; t += 2) {
            const bool last = (t == NSEG * nt - 2); const bool nx = last && has_next;
            const bool seg2 = DUAL && (t >= nt), cross = DUAL && (t == nt - 2);
            const char* sA_ = seg2 ? (const char*)g.A2 + (size_t)cur.pm * tstep - (size_t)nt * kstep : cA; const char* sB_ = seg2 ? (const char*)g.Bt2 + (size_t)cur.pb * tstep - (size_t)nt * kstep : cB;
            if constexpr (DUAL) { if (t == nt) E.mid(acc, cur, wr, wc, fr, fq); }
            const char* a1 = sA_ + (size_t)(t + 1) * kstep;
            const char* a2 = last ? nA : cross ? (const char*)g.A2 + (size_t)cur.pm * tstep : sA_ + (size_t)(t + 2) * kstep; const char* b2 = last ? nB : cross ? (const char*)g.Bt2 + (size_t)cur.pb * tstep : sB_ + (size_t)(t + 2) * kstep;
            const char* a3 = a2 + kstep; const char* b3 = b2 + kstep;
            PG8_LDB(B0, 0, 0); PG8_SCHED; PG8_LDA(At, 0, 0); PG8_STAGE_A(PG8_SA(1, 1), a1, 1, false);
            PG8_WAIT_L(8); PG8_BAR; PG8_WAIT_L(0); PG8_MMA(0, 0, At, B0); PG8_BAR; PG8_SCHED;
            PG8_LDB(B1, 0, 1); PG8_STAGE(PG8_SB(0, 0), b2, voffB);
            PG8_BAR; PG8_WAIT_L(0); PG8_MMA(0, 1, At, B1); PG8_BAR;
            PG8_LDA(At, 0, 1); PG8_STAGE_A(PG8_SA(0, 0), a2, 0, nx);
            PG8_BAR; PG8_WAIT_L(0); PG8_MMA(1, 0, At, B0); PG8_BAR; PG8_SCHED;
            PG8_STAGE(PG8_SB(0, 1), b2 + hstep, voffB);
            PG8_WAIT_V(6); PG8_BAR; PG8_MMA(1, 1, At, B1); PG8_BAR;
            PG8_LDB(B0, 1, 0); PG8_SCHED; PG8_LDA(At, 1, 0); PG8_STAGE_A(PG8_SA(0, 1), a2, 1, nx);
            PG8_WAIT_L(8); PG8_BAR; PG8_WAIT_L(0); PG8_MMA(0, 0, At, B0); PG8_BAR; PG8_SCHED;
            PG8_LDB(B1, 1, 1); PG8_STAGE(PG8_SB(1, 0), b3, voffB);
            PG8_BAR; PG8_WAIT_L(0); PG8_MMA(0, 1, At, B1); PG8_BAR;
            PG8_LDA(At, 1, 1); PG8_STAGE_A(PG8_SA(1, 0), a3, 0, nx);
            PG8_BAR; PG8_WAIT_L(0); PG8_MMA(1, 0, At, B0); PG8_BAR; PG8_SCHED;
            PG8_STAGE(PG8_SB(1, 1), b3 + hstep, voffB);
            PG8_WAIT_V(6); PG8_BAR; PG8_MMA(1, 1, At, B1); PG8_BAR;
        }
        if constexpr (F8) { asm volatile("s_nop 15\n\ts_nop 15" : "+v"(acc[1][1][0][0]), "+v"(acc[1][1][0][1]), "+v"(acc[1][1][1][0]), "+v"(acc[1][1][1][1]), "+v"(acc[1][1][2][0]), "+v"(acc[1][1][2][1]), "+v"(acc[1][1][3][0]), "+v"(acc[1][1][3][1])); }
        if constexpr (Epi::HASPRE) E(acc, cur, wr, wc, fr, fq, pre); else E(acc, cur, wr, wc, fr, fq);
        if (!has_next) break;
#pragma unroll
        for (int a = 0; a < 2; ++a)
#pragma unroll
            for (int b = 0; b < 2; ++b)
#pragma unroll
                for (int m = 0; m < 4; ++m)
#pragma unroll
                    for (int n = 0; n < 2; ++n) acc[a][b][m][n] = (f32x4){0.f, 0.f, 0.f, 0.f};
        cur = nxt; cA = nA; cB = nB; ++ui;
        if constexpr (Epi::HASPRE) E.prefetch(pre, cur, wr, wc, fr, fq);
        if constexpr (GATHER) {
#pragma unroll
            for (int h = 0; h < 2; ++h)
#pragma unroll
                for (int i = 0; i < 2; ++i) offA[h][i] = offAn[h][i]; }
    }
    PG8_WAIT_V(0);
    if (wr == 0) PG8_BAR;
    PG8_BAR;
#undef PG8_SA
#undef PG8_SB
#undef PG8_STAGE
#undef PG8_STAGE_A
#undef PG8_LDA
#undef PG8_LDB
#undef PG8_MMA
#undef PG8_WAIT_V
#undef PG8_WAIT_L
#undef PG8_BAR
#undef PG8_SCHED
}
}

#define XB_TMO      128
#define XB_XCNT(j)  (256  + 64 * (j))
#define XB_XSUB(j)  (1280 + 64 * (j))
#define XB_XGEN(j)  (2304 + 64 * (j))
#define XB_TOP      3328
#define XB_TOPGEN   3392
#define XCD_BAR_WORDS 3456
#define XB_SPIN_CAP (1u << 18)

__device__ __forceinline__ unsigned xb_ld(unsigned* p)              { return __hip_atomic_load(p, __ATOMIC_RELAXED, __HIP_MEMORY_SCOPE_AGENT); }
__device__ __forceinline__ unsigned xb_add(unsigned* p, unsigned v) { return __hip_atomic_fetch_add(p, v, __ATOMIC_RELAXED, __HIP_MEMORY_SCOPE_AGENT); }
__device__ __forceinline__ unsigned xb_xcc_id() { return (unsigned)__builtin_amdgcn_s_getreg((3 << 11) | 20) & 0xFu; }
#define XB_SPIN(cond, bar) do { unsigned _sp = 0; while (cond) { __builtin_amdgcn_s_sleep(1); \
    if ((++_sp & 255u) == 0u) { if (xb_ld(&(bar)[XB_TMO])) break; if (_sp > XB_SPIN_CAP) { atomicAdd(&(bar)[XB_TMO], 1u); break; } } } } while (0)

struct XcdBarrier { unsigned* bar; unsigned x; volatile LAS unsigned* st; };

__device__ __forceinline__ XcdBarrier xcd_barrier_post(unsigned* bar, volatile LAS unsigned* st) {
    XcdBarrier b; b.bar = bar; b.x = xb_xcc_id(); b.st = st;
    if (threadIdx.x == 0) (void)xb_add(&bar[XB_XCNT(b.x)], 1u);
    return b;
}
__device__ __forceinline__ void xcd_barrier_complete(unsigned* bar, unsigned x, unsigned& nloc, unsigned& nx) {
    const unsigned G = gridDim.x * gridDim.y * gridDim.z;
    unsigned sum, cnt, mine, sp = 0u;
    for (;;) {
        sum = 0u; cnt = 0u; mine = 0u;
#pragma unroll
        for (unsigned j = 0; j < 16; ++j) { const unsigned c = xb_ld(&bar[XB_XCNT(j)]); sum += c; cnt += (c > 0u) ? 1u : 0u; mine = (j == x) ? c : mine; }
        if (sum == G) break;
        __builtin_amdgcn_s_sleep(1);
        if ((++sp & 255u) == 0u) { if (xb_ld(&bar[XB_TMO])) break; if (sp > XB_SPIN_CAP) { atomicAdd(&bar[XB_TMO], 1u); break; } }
    }
    nloc = mine > 0u ? mine : 1u; nx = cnt > 0u ? cnt : 1u;
}
__device__ __forceinline__ void xcd_barrier(const XcdBarrier& b) {
    asm volatile("s_waitcnt vmcnt(0)" ::: "memory");
    __syncthreads();
    if (threadIdx.x == 0) {
        unsigned* bar = b.bar;
        __builtin_amdgcn_s_waitcnt(0);
        unsigned nloc = b.st[0], nx = b.st[1];
        if (nloc == 0u) { xcd_barrier_complete(bar, b.x, nloc, nx); b.st[0] = nloc; b.st[1] = nx; }
        const unsigned old = xb_add(&bar[XB_XSUB(b.x)], 1u);
        const unsigned gen = old / nloc;
        if (old + 1u == (gen + 1u) * nloc) {
            __builtin_amdgcn_fence(__ATOMIC_RELEASE, "agent");
            asm volatile("s_waitcnt vmcnt(0)" ::: "memory");
            const unsigned og = xb_add(&bar[XB_TOP], 1u);
            const unsigned tg = og / nx;
            if (og + 1u == (tg + 1u) * nx) xb_add(&bar[XB_TOPGEN], 1u);
            else XB_SPIN(xb_ld(&bar[XB_TOPGEN]) == tg, bar);
            __builtin_amdgcn_fence(__ATOMIC_ACQUIRE, "agent");
            xb_add(&bar[XB_XGEN(b.x)], 1u);
            asm volatile("s_waitcnt vmcnt(0)" ::: "memory");
        } else {
            XB_SPIN(xb_ld(&bar[XB_XGEN(b.x)]) == gen, bar);
            __builtin_amdgcn_fence(__ATOMIC_ACQUIRE, "agent");
            asm volatile("s_waitcnt vmcnt(0)" ::: "memory");
        }
    }
    __syncthreads();
}

struct Args {
    const float* x; const float* norm_mix_g; const float* w_in; const float* conv_w; const float* conv_b; const float* w_a2; const float* b_a; const float* gla_norm_g;
    const float* w_br_a; const float* w_br_b; const float* w_out; const float* norm_ffn_g; const float* w_router; const float* b_router; const float* w_gate_up; const float* b_gate_up;
    const float* w_down; const float* b_down; const float* norm_final_g; float* out; unsigned char* ws; int ph_lo, ph_hi;
};

__device__ __forceinline__ void tr_item(const float* W, size_t ldw, int k0, int sn0, bf16* WT, int K, size_t drow0, LAS float* scr, int lane) {
#pragma unroll 8
    for (int i = 0; i < 32; ++i) { const int kk = 2 * i + (lane >> 5); scr[kk * 33 + (lane & 31)] = W[(size_t)(k0 + kk) * ldw + sn0 + (lane & 31)]; }
    LDS_WAIT(); asm volatile("" ::: "memory");
    const int c = lane & 7;
#pragma unroll
    for (int j = 0; j < 4; ++j) { const int n = (lane >> 3) + 8 * j; const LAS float* s = scr + (8 * c) * 33 + n;
        u32x4 o; o.x = cvt_pk_bf16(s[0 * 33], s[1 * 33]); o.y = cvt_pk_bf16(s[2 * 33], s[3 * 33]); o.z = cvt_pk_bf16(s[4 * 33], s[5 * 33]); o.w = cvt_pk_bf16(s[6 * 33], s[7 * 33]);
        *(u32x4*)(WT + (drow0 + n) * K + k0 + 8 * c) = o; }
    LDS_WAIT(); asm volatile("" ::: "memory");
}

struct TrItem { const float* W; size_t ldw; unsigned char* dst; int Kb; };
__device__ __forceinline__ void tr8_load(const TrItem& t, f32x4 (&r)[16]) {
#pragma unroll
    for (int i = 0; i < 16; ++i) r[i] = __builtin_nontemporal_load((const f32x4*)(t.W + (size_t)i * t.ldw));
}
__device__ __forceinline__ void tr8_store(const TrItem& t, const f32x4 (&r)[16], float scale) {
#pragma unroll
    for (int q = 0; q < 4; ++q) { u32x4 o;
        o.x = pk4_fp8(r[0][q] * scale, r[1][q] * scale, r[2][q] * scale, r[3][q] * scale); o.y = pk4_fp8(r[4][q] * scale, r[5][q] * scale, r[6][q] * scale, r[7][q] * scale);
        o.z = pk4_fp8(r[8][q] * scale, r[9][q] * scale, r[10][q] * scale, r[11][q] * scale); o.w = pk4_fp8(r[12][q] * scale, r[13][q] * scale, r[14][q] * scale, r[15][q] * scale);
        __builtin_nontemporal_store(o, (u32x4*)(t.dst + (size_t)q * t.Kb)); }
}
__device__ __forceinline__ TrItem moe_item(int it, const float* w_gate_up, const float* w_down, unsigned char* WGU8, unsigned char* WD8, int lane) {
    constexpr int NQ_GU = NE * 16 * 128; const int kr = lane >> 3, c4 = lane & 7; TrItem t;
    if (it < NQ_GU) { const int e = it / (16 * 128), r = it % (16 * 128), kb = r / 128, nb = r % 128; const int n0 = 32 * nb, isup = n0 / DFF, j = n0 % DFF;
        t.ldw = 2 * DFF; t.Kb = DM; t.W = w_gate_up + (size_t)e * DM * 2 * DFF + (size_t)(128 * kb + 16 * kr) * (2 * DFF) + n0 + 4 * c4;
        t.dst = WGU8 + ((size_t)e * 4096 + 256 * (j / 128) + 128 * isup + (j % 128) + 4 * c4) * DM + 128 * kb + 16 * kr; }
    else { const int i2 = it - NQ_GU; const int e = i2 / (16 * 64), r = i2 % (16 * 64), kb = r / 64, nb = r % 64;
        t.ldw = DM; t.Kb = DFF; t.W = w_down + (size_t)e * DFF * DM + (size_t)(128 * kb + 16 * kr) * DM + 32 * nb + 4 * c4;
        t.dst = WD8 + ((size_t)e * DM + 32 * nb + 4 * c4) * DFF + 128 * kb + 16 * kr; }
    return t;
}

constexpr int NQ_MOE = NE * 16 * 128 + NE * 16 * 64;
constexpr int NG9 = 232;
constexpr int NQ_SCAN = 0;
constexpr int NQ_TAIL = 32768;
static_assert(QBATCH % 2 == 0 && NQ_MOE % QBATCH == 0 && NQ_TAIL % QBATCH == 0, "queue batches");
__device__ __forceinline__ void moe_convert_queue(unsigned* head, int first, int last, const float* w_gate_up, const float* w_down, unsigned char* WGU8, unsigned char* WD8, int lane) {
    int nbase = 0; if (lane == 0) nbase = (int)__hip_atomic_fetch_add(head, (unsigned)QBATCH, RLX_AGENT);
    for (;;) {
        const int base = first + __builtin_amdgcn_readfirstlane(nbase);
        if (base >= last) break;
        if (lane == 0) nbase = (int)__hip_atomic_fetch_add(head, (unsigned)QBATCH, RLX_AGENT);
        f32x4 ra[16], rb[16];
        TrItem ta = moe_item(base, w_gate_up, w_down, WGU8, WD8, lane), tb;
        tr8_load(ta, ra);
#pragma unroll
        for (int j = 0; j < QBATCH; j += 2) {
            tb = moe_item(base + j + 1, w_gate_up, w_down, WGU8, WD8, lane); tr8_load(tb, rb);
            tr8_store(ta, ra, 1024.0f);
            if (j + 2 < QBATCH) { ta = moe_item(base + j + 2, w_gate_up, w_down, WGU8, WD8, lane); tr8_load(ta, ra); }
            tr8_store(tb, rb, 1024.0f);
        }
    }
}

__global__ void __launch_bounds__(NWAVES * 64, 2) mega_fwd(Args a) {
    extern __shared__ __attribute__((aligned(16))) unsigned char lds_raw[];
    LAS unsigned char* lds = (LAS unsigned char*)lds_raw;
    volatile LAS unsigned* MISC = (volatile LAS unsigned*)(lds + MISC_OFF);
    LAS int* tile_e = (LAS int*)(lds + TILEE_OFF);
    LAS int* pstart = (LAS int*)(lds + PSTART_OFF);
    const int tid = threadIdx.x, lane = tid & 63, wave = __builtin_amdgcn_readfirstlane(tid >> 6);
    const int G = gridDim.x; const int bx = blockIdx.x; const int vcu = (G % 8 == 0) ? (bx % 8) * (G / 8) + bx / 8 : bx;
    const int gw = vcu * NWAVES + wave, NGW = G * NWAVES;
    unsigned char* ws = a.ws;
    unsigned* ctl = (unsigned*)(ws + WS_CTL);
    float* WRF = (float*)(ws + WS_WRF);
    int* tk_e = (int*)(ws + WS_TK); int* tk_rank = tk_e + NTOK * 4; float* tk_w = (float*)(tk_rank + NTOK * 4); int* tk_slot = (int*)(tk_w + NTOK * 4); float* rs_tok = (float*)(tk_slot + NTOK * 4);
    float* slot_w = (float*)(ws + WS_SLOT); float* slot_rs = slot_w + MAXSLOT; int* slot_tok = (int*)(slot_rs + MAXSLOT);
    bf16* WIN = (bf16*)(ws + WS_WIN); bf16* WA = (bf16*)(ws + WS_WA); bf16* WB = (bf16*)(ws + WS_WB); bf16* WO = (bf16*)(ws + WS_WO); unsigned char* WGU8 = ws + WS_WGU; unsigned char* WD8 = ws + WS_WD;
    bf16* Hb = (bf16*)(ws + WS_H); bf16* P = (bf16*)(ws + WS_P); bf16* ZA = (bf16*)(ws + WS_ZA); bf16* ZB = (bf16*)(ws + WS_ZB); bf16* Ob = (bf16*)(ws + WS_O);
    bf16* YA = (bf16*)(ws + WS_YA); bf16* MIX = (bf16*)(ws + WS_MIX); float* X1 = (float*)(ws + WS_X1); unsigned char* G8 = ws + WS_XB; unsigned char* ACT8 = ws + WS_ACT; unsigned char* YS8 = ws + WS_YS; unsigned char* H8 = ws + WS_H; unsigned char* WIN8 = ws + WS_WIN8; unsigned char* HQ8 = ws + WS_HQ8;

    for (int u = tid; u < (LDS_BYTES - LDSCTL_OFF) / 4; u += NWAVES * 64) ((LAS unsigned*)(lds + LDSCTL_OFF))[u] = 0u;
    __syncthreads();
    XcdBarrier bar = xcd_barrier_post(ctl + CW_BAR, MISC + 8);
    const int lo = a.ph_lo, hi = a.ph_hi;
#define IN(k) (lo <= (k) && (k) < hi)
#define BOTH(k) (IN(k) && IN((k) + 1))
#define GRID_BAR() xcd_barrier(bar)

    if (IN(0)) {
      for (int rep = 0; rep < REP_P0; ++rep) {
        {
            f32x4 gv[8];
#pragma unroll
            for (int j = 0; j < 8; ++j) gv[j] = *((const f32x4*)a.norm_mix_g + lane + 64 * j);
            for (int m = gw; m < NTOK; m += NGW) {
                const f32x4* xr = (const f32x4*)(a.x + (size_t)m * DM) + lane; f32x4 v[8]; float s = 0.f;
#pragma unroll
                for (int j = 0; j < 8; ++j) { v[j] = xr[64 * j]; s += (v[j].x * v[j].x + v[j].y * v[j].y) + (v[j].z * v[j].z + v[j].w * v[j].w); }
                const float rs = 1.0f / sqrtf(wave_sum(s) * (1.0f / DM) + EPS);
                u32x2* o8 = (u32x2*)(Hb + (size_t)m * DM) + lane;
                unsigned* q8 = (unsigned*)(HQ8 + (size_t)m * DM) + lane;
#pragma unroll
                for (int j = 0; j < 8; ++j) { const float h0 = v[j].x * rs * gv[j].x, h1 = v[j].y * rs * gv[j].y, h2 = v[j].z * rs * gv[j].z, h3 = v[j].w * rs * gv[j].w;
                    u32x2 w; w.x = cvt_pk_bf16(h0, h1); w.y = cvt_pk_bf16(h2, h3); o8[64 * j] = w; q8[64 * j] = pk4_fp8(8.0f * h0, 8.0f * h1, 8.0f * h2, 8.0f * h3); }
            }
        }
#if DBG_STAGE >= 1
        {
            LAS float* scr = (LAS float*)(lds + wave * 16896);
            for (int it = gw; it < 192 * 32; it += NGW) { const int kb = it / 192, db = it % 192; const int d0 = 32 * db; tr_item(a.w_in, DIN, 64 * kb, d0, WIN, DM, d0, scr, lane); }
            for (int it = gw; it < 16 * 128; it += NGW) { const int kb = it / 128, nb = it % 128; const int kr = lane >> 3, c4 = lane & 7; TrItem t; t.ldw = DIN; t.Kb = DM;
                t.W = a.w_in + (size_t)(128 * kb + 16 * kr) * DIN + 6160 + 32 * nb + 4 * c4; t.dst = WIN8 + ((size_t)32 * nb + 4 * c4) * DM + 128 * kb + 16 * kr;
                f32x4 r8[16]; tr8_load(t, r8); tr8_store(t, r8, 512.0f); }
            for (int i = gw * 64 + lane; i < 256 * DM; i += NGW * 64) { const int r = i / DM, k = i % DM; WIN[(size_t)(PC_AL + r) * DM + k] = r < 16 ? (bf16)(cvt_pk_bf16(a.w_in[(size_t)k * DIN + SRC_AL + r], 0.f) & 0xffffu) : (bf16)0; }
#if DBG_STAGE >= 3
            for (int i = gw * 64 + lane; i < 128 * 2 * 64 * 4; i += NGW * 64) { const int ii = i & 3, l = (i >> 2) & 63, t = (i >> 8) & 1, j = i >> 9; const int k = 32 * (j >> 1) + 8 * (l >> 4) + 4 * (j & 1) + ii;
                WRF[i] = a.norm_ffn_g[k] * a.w_router[(size_t)k * NE + 16 * t + (l & 15)]; }
#endif
        }
#endif
      }
        if (BOTH(0)) GRID_BAR();
    }

#if DBG_STAGE >= 1
    if (IN(1)) {
        const int ngemm = (G == 256) ? NGEMM : G;
        if (bx < ngemm) {
            { pg8::Gemm g{Hb, WIN, 2 * DM, nullptr, nullptr, nullptr}; pg8::StaticOrder S; S.init(NTOK / 256, 25, ngemm, bx, 4); pg8::EpiPlainBf16 E{P, NP, 0, 1.0f}; pg8::gemm_phase<false, 1, false>(lds, g, S, E); }
            { pg8::Gemm g{HQ8, WIN8, DM, nullptr, nullptr, nullptr}; pg8::StaticOrder S; S.init(NTOK / 256, 16, ngemm, bx, 4); pg8::EpiPlainFp8 E{G8, 4096, 16.0f / 4096.0f}; pg8::gemm_phase<true, 1, false>(lds, g, S, E); }
        }
#if DBG_STAGE >= 3
        moe_convert_queue(ctl + CW_Q, 0, NQ_MOE - NQ_TAIL - NQ_SCAN, a.w_gate_up, a.w_down, WGU8, WD8, lane);
#endif
        if (BOTH(1)) GRID_BAR();
    }

    if (IN(2)) {
        bf16* KTT = (bf16*)(ws + WS_KTT);
        float* DECB = (float*)(ws + WS_DEC);
        bf16* VTT = (bf16*)(ws + WS_VTT);
        {
            LAS float* AL = (LAS float*)(lds);
            LAS float* CUMG = (LAS float*)(lds + 4096);
            LAS bf16* KL = (LAS bf16*)(lds + 8192);
            LAS unsigned char* VT = lds + 32768;
            for (int item = vcu; item < 1024; item += G) {
                const int b = item >> 7, c = (item >> 2) & 31, h = item & 3;
                const size_t t0 = (size_t)b * SEQ + 64 * c;
                const int dk = tid & 127, sg = tid >> 7;
                float wa2[16];
#pragma unroll
                for (int j = 0; j < 16; ++j) wa2[j] = a.w_a2[j * 512 + h * 128 + dk];
                const float ba = a.b_a[h * 128 + dk];
                if (tid < 128) { const int s = tid >> 1, hf = tid & 1; const u32x4 w = *(const u32x4*)(P + (t0 + s) * NP + PC_AL + 8 * hf);
                    LAS float* d = AL + s * 16 + 8 * hf; d[0] = bf_lo(w.x); d[1] = bf_hi(w.x); d[2] = bf_lo(w.y); d[3] = bf_hi(w.y); d[4] = bf_lo(w.z); d[5] = bf_hi(w.z); d[6] = bf_lo(w.w); d[7] = bf_hi(w.w); }
#pragma unroll
                for (int i = 0; i < 2; ++i) { const int p = tid + 512 * i, row = p >> 4, c16 = p & 15; *(LAS u32x4*)(KL + row * 136 + c16 * 8) = *(const u32x4*)(P + (t0 + row) * NP + PC_K + h * 128 + c16 * 8); }
                if (tid < 256) { const int vb = tid & 31, sb = tid >> 5; u32x4 Lr[8];
#pragma unroll
                  for (int i = 0; i < 8; ++i) Lr[i] = *(const u32x4*)(P + (t0 + 8 * sb + i) * NP + PC_V + h * 256 + 8 * vb);
#pragma unroll
                  for (int j = 0; j < 8; ++j) { const unsigned sel = (j & 1) ? 0x07060302u : 0x05040100u; u32x4 w;
                      w.x = __builtin_amdgcn_perm(Lr[1][j >> 1], Lr[0][j >> 1], sel); w.y = __builtin_amdgcn_perm(Lr[3][j >> 1], Lr[2][j >> 1], sel);
                      w.z = __builtin_amdgcn_perm(Lr[5][j >> 1], Lr[4][j >> 1], sel); w.w = __builtin_amdgcn_perm(Lr[7][j >> 1], Lr[6][j >> 1], sel);
                      *(LAS u32x4*)(VT + (8 * vb + j) * 128 + ((sb ^ (vb & 7)) << 4)) = w; } }
                __syncthreads();
#pragma unroll
                for (int i = 0; i < 4; ++i) { const int q = tid + 512 * i, v = q >> 3, slot = q & 7; *(u32x4*)(VTT + ((size_t)item * 256 + v) * 64 + 8 * (slot ^ ((v >> 3) & 7))) = *(const LAS u32x4*)(VT + q * 16); }
                float cs[16]; float run = 0.f;
#pragma unroll
                for (int i = 0; i < 16; ++i) { const LAS float* al = AL + (16 * sg + i) * 16; float z = ba;
#pragma unroll
                    for (int j = 0; j < 16; ++j) z += al[j] * wa2[j];
                    const float la = -(fmaxf(-z, 0.f) + __logf(1.0f + __expf(-fabsf(z)))) * (1.0f / 16.0f); run += la; cs[i] = run; }
                CUMG[sg * 128 + dk] = run;
                __syncthreads();
                float pre = 0.f, tot = 0.f;
#pragma unroll
                for (int gq = 0; gq < 4; ++gq) { const float v = CUMG[gq * 128 + dk]; tot += v; if (gq < sg) pre += v; }
                if (sg == 0) DECB[item * 128 + dk] = __expf(tot);
                { unsigned pk[8];
#pragma unroll
                  for (int i = 0; i < 8; ++i) { const float f0 = __expf(tot - (pre + cs[2 * i])), f1 = __expf(tot - (pre + cs[2 * i + 1])); pk[i] = cvt_pk_bf16(bf2f(KL[(16 * sg + 2 * i) * 136 + dk]) * f0, bf2f(KL[(16 * sg + 2 * i + 1) * 136 + dk]) * f1); }
                  u32x4 w0, w1; w0.x = pk[0]; w0.y = pk[1]; w0.z = pk[2]; w0.w = pk[3]; w1.x = pk[4]; w1.y = pk[5]; w1.z = pk[6]; w1.w = pk[7];
                  u32x4* dst = (u32x4*)(KTT + ((size_t)item * 128 + dk) * 64 + 16 * sg); dst[0] = w0; dst[1] = w1; }
                __syncthreads();
            }
        }
        GRID_BAR();
        {
            LAS bf16* SB = (LAS bf16*)(lds + 8192);
            LAS float* OT = (LAS float*)(lds + 43008);
            LAS bf16* VTS = (LAS bf16*)(lds + 77824);
            LAS bf16* QS = (LAS bf16*)(lds + 96256);
            const int fr = lane & 15, fq = lane >> 4, mi = wave >> 1, ni = wave & 1;
            struct GlaRegs { bf16x8 af[2]; u32x4 q[2]; u32x4 vt; f32x4 dec; };
            const bool split = (G == 256);
            for (int rep = 0; rep < REP_P2; ++rep)
            if (!split || !(vcu & 1))
            for (int it = split ? (vcu >> 1) : vcu; it < 128; it += split ? 128 : G) {
                const int b = it >> 4, h = (it >> 2) & 3, vs = it & 3;
                f32x4 Sacc[4];
#pragma unroll
                for (int n = 0; n < 4; ++n) Sacc[n] = (f32x4){0.f, 0.f, 0.f, 0.f};
                GlaRegs R[3];
#define GLA_LOAD(X, cc) do { const int item_ = (b * 32 + (cc)) * 4 + h; const size_t t0_ = (size_t)b * SEQ + 64 * (cc); \
                    _Pragma("unroll") for (int ks = 0; ks < 2; ++ks) X.af[ks] = *(const bf16x8*)(KTT + ((size_t)item_ * 128 + 16 * wave + fr) * 64 + 32 * ks + 8 * fq); \
                    X.vt = *(const u32x4*)(VTT + ((size_t)item_ * 256 + vs * 64 + 8 * wave + (lane >> 3)) * 64 + 8 * (lane & 7)); \
                    _Pragma("unroll") for (int i = 0; i < 2; ++i) X.q[i] = *(const u32x4*)(P + (t0_ + 8 * wave + (lane >> 3)) * NP + PC_Q + h * 128 + 8 * (lane & 7) + 64 * i); \
                    X.dec = *(const f32x4*)(DECB + item_ * 128 + 16 * wave + 4 * fq); } while (0)
#define GLA_PUT_VT(X, cc) do { *(LAS u32x4*)(VTS + ((cc) & 1) * (64 * 72) + (8 * wave + (lane >> 3)) * 72 + 8 * (lane & 7)) = X.vt; } while (0)
                GLA_LOAD(R[0], 0); GLA_LOAD(R[1], 1); GLA_LOAD(R[2], 2);
                GLA_PUT_VT(R[0], 0);
                __syncthreads();
                for (int c0 = 0; c0 < 32; c0 += 3) {
#pragma unroll
                    for (int u = 0; u < 3; ++u) {
                        const int c = c0 + u; if (c >= 32) break;
                        const size_t t0 = (size_t)b * SEQ + 64 * c;
                        LAS bf16* SBc = SB + (c & 1) * (64 * 136); LAS bf16* QSc = QS + (c & 1) * (64 * 136); const LAS bf16* VTc = VTS + (c & 1) * (64 * 72);
#pragma unroll
                        for (int n = 0; n < 4; ++n) Sacc[n] *= R[u].dec;
#pragma unroll
                        for (int ks = 0; ks < 2; ++ks)
#pragma unroll
                            for (int n = 0; n < 4; ++n) { const bf16x8 bvf = *(const LAS bf16x8*)(VTc + (16 * n + fr) * 72 + 32 * ks + 8 * fq); Sacc[n] = __builtin_amdgcn_mfma_f32_16x16x32_bf16(R[u].af[ks], bvf, Sacc[n], 0, 0, 0); }
#pragma unroll
                        for (int n = 0; n < 4; ++n) { u32x2 w; w.x = cvt_pk_bf16(Sacc[n][0], Sacc[n][1]); w.y = cvt_pk_bf16(Sacc[n][2], Sacc[n][3]); *(LAS u32x2*)(SBc + (16 * n + fr) * 136 + 16 * wave + 4 * fq) = w; }
#pragma unroll
                        for (int i = 0; i < 2; ++i) *(LAS u32x4*)(QSc + (8 * wave + (lane >> 3)) * 136 + 8 * (lane & 7) + 64 * i) = R[u].q[i];
                        if (c + 1 < 32) GLA_PUT_VT(R[(u + 1) % 3], c + 1);
                        if (c + 3 < 32) GLA_LOAD(R[u], c + 3);
                        __syncthreads();
                        f32x4 oa[2] = {(f32x4){0.f, 0.f, 0.f, 0.f}, (f32x4){0.f, 0.f, 0.f, 0.f}};
#pragma unroll
                        for (int kk = 0; kk < 4; ++kk) { const bf16x8 qf = *(const LAS bf16x8*)(QSc + (16 * mi + fr) * 136 + 32 * kk + 8 * fq);
#pragma unroll
                            for (int n2 = 0; n2 < 2; ++n2) { const bf16x8 sf = *(const LAS bf16x8*)(SBc + (16 * (2 * ni + n2) + fr) * 136 + 32 * kk + 8 * fq); oa[n2] = __builtin_amdgcn_mfma_f32_16x16x32_bf16(qf, sf, oa[n2], 0, 0, 0); } }
                        LAS float* OTc = OT + (c & 1) * (64 * 68);
#pragma unroll
                        for (int n2 = 0; n2 < 2; ++n2)
#pragma unroll
                            for (int j = 0; j < 4; ++j) OTc[(16 * mi + 4 * fq + j) * 68 + 16 * (2 * ni + n2) + fr] = oa[n2][j] * 0.08838834764831845f;
                        if (c > 0) {
                            const LAS f32x4* op = (const LAS f32x4*)(OT + ((c - 1) & 1) * (64 * 68) + (8 * wave + (lane >> 3)) * 68 + 8 * (lane & 7)); const f32x4 ov0 = op[0], ov1 = op[1];
                            u32x4 ow; ow.x = cvt_pk_bf16(ov0[0], ov0[1]); ow.y = cvt_pk_bf16(ov0[2], ov0[3]); ow.z = cvt_pk_bf16(ov1[0], ov1[1]); ow.w = cvt_pk_bf16(ov1[2], ov1[3]);
                            *(u32x4*)(Ob + (t0 - 64 + 8 * wave + (lane >> 3)) * 1024 + h * 256 + vs * 64 + 8 * (lane & 7)) = ow; }
                    }
                }
                __syncthreads();
                { const size_t t0 = (size_t)b * SEQ + 64 * 31; const LAS f32x4* op = (const LAS f32x4*)(OT + (31 & 1) * (64 * 68) + (8 * wave + (lane >> 3)) * 68 + 8 * (lane & 7)); const f32x4 ov0 = op[0], ov1 = op[1];
                  u32x4 ow; ow.x = cvt_pk_bf16(ov0[0], ov0[1]); ow.y = cvt_pk_bf16(ov0[2], ov0[3]); ow.z = cvt_pk_bf16(ov1[0], ov1[1]); ow.w = cvt_pk_bf16(ov1[2], ov1[3]);
                  *(u32x4*)(Ob + (t0 + 8 * wave + (lane >> 3)) * 1024 + h * 256 + vs * 64 + 8 * (lane & 7)) = ow; }
                __syncthreads();
#undef GLA_LOAD
#undef GLA_PUT_VT
            }
            if (!split || (vcu & 1)) { const int hw = split ? (vcu >> 1) * NWAVES + wave : gw, nhw = split ? 128 * NWAVES : NGW;
            for (int wi = hw; wi < 2048; wi += nhw) {
                const int tb = wi >> 1, hf = wi & 1, c0 = 512 * hf + 8 * lane; const int t0 = 16 * tb;
                float w0[8], w1[8], w2[8], cb[8];
#pragma unroll
                for (int j = 0; j < 8; ++j) { w0[j] = a.conv_w[c0 + j]; w1[j] = a.conv_w[1024 + c0 + j]; w2[j] = a.conv_w[2048 + c0 + j]; cb[j] = a.conv_b[c0 + j]; }
                float y2[8], y1[8];
#pragma unroll
                for (int j = 0; j < 8; ++j) { y2[j] = 0.f; y1[j] = 0.f; }
                if ((t0 % SEQ) != 0) {
                    const bf16* pr = P + (size_t)(t0 - 2) * NP + c0; const u32x4 c2 = *(const u32x4*)(pr + PC_UC), x2 = *(const u32x4*)(pr + PC_UX), c1 = *(const u32x4*)(pr + NP + PC_UC), x1 = *(const u32x4*)(pr + NP + PC_UX);
                    y2[0] = bf_lo(c2.x) * bf_lo(x2.x); y2[1] = bf_hi(c2.x) * bf_hi(x2.x); y2[2] = bf_lo(c2.y) * bf_lo(x2.y); y2[3] = bf_hi(c2.y) * bf_hi(x2.y); y2[4] = bf_lo(c2.z) * bf_lo(x2.z); y2[5] = bf_hi(c2.z) * bf_hi(x2.z); y2[6] = bf_lo(c2.w) * bf_lo(x2.w); y2[7] = bf_hi(c2.w) * bf_hi(x2.w);
                    y1[0] = bf_lo(c1.x) * bf_lo(x1.x); y1[1] = bf_hi(c1.x) * bf_hi(x1.x); y1[2] = bf_lo(c1.y) * bf_lo(x1.y); y1[3] = bf_hi(c1.y) * bf_hi(x1.y); y1[4] = bf_lo(c1.z) * bf_lo(x1.z); y1[5] = bf_hi(c1.z) * bf_hi(x1.z); y1[6] = bf_lo(c1.w) * bf_lo(x1.w); y1[7] = bf_hi(c1.w) * bf_hi(x1.w);
                }
#pragma unroll 4
                for (int t = 0; t < 16; ++t) {
                    const bf16* pr = P + (size_t)(t0 + t) * NP + c0; const u32x4 uc = *(const u32x4*)(pr + PC_UC), ub = *(const u32x4*)(pr + PC_UB), ux = *(const u32x4*)(pr + PC_UX);
                    float y0[8], bb[8];
                    y0[0] = bf_lo(uc.x) * bf_lo(ux.x); y0[1] = bf_hi(uc.x) * bf_hi(ux.x); y0[2] = bf_lo(uc.y) * bf_lo(ux.y); y0[3] = bf_hi(uc.y) * bf_hi(ux.y); y0[4] = bf_lo(uc.z) * bf_lo(ux.z); y0[5] = bf_hi(uc.z) * bf_hi(ux.z); y0[6] = bf_lo(uc.w) * bf_lo(ux.w); y0[7] = bf_hi(uc.w) * bf_hi(ux.w);
                    bb[0] = bf_lo(ub.x); bb[1] = bf_hi(ub.x); bb[2] = bf_lo(ub.y); bb[3] = bf_hi(ub.y); bb[4] = bf_lo(ub.z); bb[5] = bf_hi(ub.z); bb[6] = bf_lo(ub.w); bb[7] = bf_hi(ub.w);
                    float z[8];
#pragma unroll
                    for (int j = 0; j < 8; ++j) { z[j] = bb[j] * (cb[j] + w0[j] * y2[j] + w1[j] * y1[j] + w2[j] * y0[j]); y2[j] = y1[j]; y1[j] = y0[j]; }
                    u32x4 w; w.x = cvt_pk_bf16(z[0], z[1]); w.y = cvt_pk_bf16(z[2], z[3]); w.z = cvt_pk_bf16(z[4], z[5]); w.w = cvt_pk_bf16(z[6], z[7]);
                    *(u32x4*)(ZA + (size_t)(t0 + t) * 1024 + c0) = w;
                }
            }
            { LAS float* scr = (LAS float*)(lds + wave * 16896);
              for (int it = hw; it < 16 * 64; it += nhw) { const int kb = it / 64, nb = it % 64; tr_item(a.w_br_a, DM, 64 * kb, 32 * nb, WA, 1024, 32 * nb, scr, lane); }
              for (int it = hw; it < 16 * 64; it += nhw) { const int kb = it / 64, nb = it % 64; tr_item(a.w_br_b, DM, 64 * kb, 32 * nb, WB, 1024, 32 * nb, scr, lane); }
              for (int it = hw; it < 32 * 64; it += nhw) { const int kb = it / 64, nb = it % 64; tr_item(a.w_out, DM, 64 * kb, 32 * nb, WO, DM, 32 * nb, scr, lane); } }
            }
#if DBG_STAGE >= 3
            moe_convert_queue(ctl + CW_Q3, NQ_MOE - NQ_TAIL - NQ_SCAN, NQ_MOE - NQ_TAIL, a.w_gate_up, a.w_down, WGU8, WD8, lane);
#endif
        }
        if (BOTH(2)) GRID_BAR();
    }

    if (IN(3)) {
        {
            f32x4 gg[4];
#pragma unroll
            for (int j = 0; j < 4; ++j) gg[j] = *((const f32x4*)(a.gla_norm_g + 16 * lane) + j);
            for (int m = gw; m < NTOK; m += NGW) {
                const u32x4* op = (const u32x4*)(Ob + (size_t)m * 1024 + 16 * lane); const u32x4 ob0 = op[0], ob1 = op[1]; f32x4 o[4]; float s = 0.f;
                o[0] = (f32x4){bf_lo(ob0.x), bf_hi(ob0.x), bf_lo(ob0.y), bf_hi(ob0.y)}; o[1] = (f32x4){bf_lo(ob0.z), bf_hi(ob0.z), bf_lo(ob0.w), bf_hi(ob0.w)};
                o[2] = (f32x4){bf_lo(ob1.x), bf_hi(ob1.x), bf_lo(ob1.y), bf_hi(ob1.y)}; o[3] = (f32x4){bf_lo(ob1.z), bf_hi(ob1.z), bf_lo(ob1.w), bf_hi(ob1.w)};
#pragma unroll
                for (int j = 0; j < 4; ++j) { s += (o[j].x * o[j].x + o[j].y * o[j].y) + (o[j].z * o[j].z + o[j].w * o[j].w); }
                s += __shfl_xor(s, 1); s += __shfl_xor(s, 2); s += __shfl_xor(s, 4); s += __shfl_xor(s, 8);
                const float rs = 1.0f / sqrtf(s * (1.0f / 256.0f) + EPS);
                const u32x4* rp = (const u32x4*)(P + (size_t)m * NP + PC_R + 16 * lane); const u32x4 r0 = rp[0], r1 = rp[1];
                float rr[16];
                rr[0] = bf_lo(r0.x); rr[1] = bf_hi(r0.x); rr[2] = bf_lo(r0.y); rr[3] = bf_hi(r0.y); rr[4] = bf_lo(r0.z); rr[5] = bf_hi(r0.z); rr[6] = bf_lo(r0.w); rr[7] = bf_hi(r0.w);
                rr[8] = bf_lo(r1.x); rr[9] = bf_hi(r1.x); rr[10] = bf_lo(r1.y); rr[11] = bf_hi(r1.y); rr[12] = bf_lo(r1.z); rr[13] = bf_hi(r1.z); rr[14] = bf_lo(r1.w); rr[15] = bf_hi(r1.w);
                float z[16];
#pragma unroll
                for (int j = 0; j < 4; ++j)
#pragma unroll
                    for (int q = 0; q < 4; ++q) { const float r = rr[4 * j + q]; z[4 * j + q] = o[j][q] * rs * gg[j][q] * (r * fast_sigmoid(r)); }
                u32x4 w0, w1; w0.x = cvt_pk_bf16(z[0], z[1]); w0.y = cvt_pk_bf16(z[2], z[3]); w0.z = cvt_pk_bf16(z[4], z[5]); w0.w = cvt_pk_bf16(z[6], z[7]);
                w1.x = cvt_pk_bf16(z[8], z[9]); w1.y = cvt_pk_bf16(z[10], z[11]); w1.z = cvt_pk_bf16(z[12], z[13]); w1.w = cvt_pk_bf16(z[14], z[15]);
                u32x4* zp = (u32x4*)(ZB + (size_t)m * 1024 + 16 * lane); zp[0] = w0; zp[1] = w1;
            }
        }
        if (BOTH(3)) GRID_BAR();
    }

    if (IN(4)) {
        { pg8::Gemm g{ZA, WA, 2048, ZB, WB, nullptr}; pg8::StaticOrder S; S.init(NTOK / 256, DM / 256, G, bx); pg8::EpiGate2 E{G8, MIX}; pg8::gemm_phase<false, 2, false>(lds, g, S, E); }
        if (BOTH(4)) GRID_BAR();
    }

    if (IN(6)) {
        pg8::Gemm g{MIX, WO, 2 * DM, nullptr, nullptr, nullptr}; pg8::StaticOrder S; S.init(NTOK / 256, DM / 256, G, bx); pg8::EpiResF32 E{a.x, X1};
        pg8::gemm_phase<false, 1, false>(lds, g, S, E);
        if (BOTH(6)) GRID_BAR();
    }
#endif

#if DBG_STAGE >= 3
    if (IN(7)) {
        for (int i = gw * 64 + lane; i < MAXSLOT; i += NGW * 64) slot_tok[i] = 0;
        LAS float* comb = (LAS float*)(lds);
        LAS float* lgb = (LAS float*)(lds + 16384);
        LAS int* hist = (LAS int*)(lds + 40960);
        const int r16 = lane & 15, kq = lane >> 4, gi = wave & 3, kh = wave >> 2;
        for (int rg0 = 0; rg0 < 1024; rg0 += 4 * G) {
            const int rg = rg0 + gi * G + vcu; const bool active = rg < 1024;
            const size_t row = (size_t)(active ? rg : 0) * 16 + r16;
            const f32x4* xp = (const f32x4*)(X1 + row * DM + 8 * kq); const f32x4* gp = (const f32x4*)(a.norm_ffn_g + 8 * kq);
            unsigned* hp = (unsigned*)(H8 + row * DM + 8 * kq);
            f32x4 acc0 = (f32x4){0.f, 0.f, 0.f, 0.f}, acc1 = (f32x4){0.f, 0.f, 0.f, 0.f}; float ssq = 0.f;
            for (int h = 0; h < 2; ++h) {
                { const u32x4* src = (const u32x4*)WRF + (size_t)h * 8192 + tid; LAS u32x4* dst = (LAS u32x4*)lds + tid;
#pragma unroll
                  for (int i = 0; i < 16; ++i) dst[512 * i] = src[512 * i]; }
                __syncthreads();
                if (active) {
                    const LAS f32x4* wl = (const LAS f32x4*)lds + (size_t)(2 * 32 * kh) * 64 + lane;
                    const int jb = 64 * h + 32 * kh;
#pragma unroll 4
                    for (int jj = 0; jj < 32; ++jj) { const int j = jb + jj;
                        const int ko = 8 * (j >> 1) + (j & 1);
                        const f32x4 av = xp[ko], gv = gp[ko], b0 = wl[(2 * jj) * 64], b1 = wl[(2 * jj + 1) * 64];
                        ssq += (av.x * av.x + av.y * av.y) + (av.z * av.z + av.w * av.w);
                        hp[ko] = pk4_fp8(av.x * gv.x * 16.0f, av.y * gv.y * 16.0f, av.z * gv.z * 16.0f, av.w * gv.w * 16.0f);
                        acc0 = __builtin_amdgcn_mfma_f32_16x16x4f32(av.x, b0.x, acc0, 0, 0, 0); acc1 = __builtin_amdgcn_mfma_f32_16x16x4f32(av.x, b1.x, acc1, 0, 0, 0);
                        acc0 = __builtin_amdgcn_mfma_f32_16x16x4f32(av.y, b0.y, acc0, 0, 0, 0); acc1 = __builtin_amdgcn_mfma_f32_16x16x4f32(av.y, b1.y, acc1, 0, 0, 0);
                        acc0 = __builtin_amdgcn_mfma_f32_16x16x4f32(av.z, b0.z, acc0, 0, 0, 0); acc1 = __builtin_amdgcn_mfma_f32_16x16x4f32(av.z, b1.z, acc1, 0, 0, 0);
                        acc0 = __builtin_amdgcn_mfma_f32_16x16x4f32(av.w, b0.w, acc0, 0, 0, 0); acc1 = __builtin_amdgcn_mfma_f32_16x16x4f32(av.w, b1.w, acc1, 0, 0, 0); }
                }
                __syncthreads();
            }
            ssq += __shfl_xor(ssq, 16); ssq += __shfl_xor(ssq, 32);
            if (kh == 1) { LAS float* c = comb + (gi * 64 + lane) * 12;
#pragma unroll
                for (int j = 0; j < 4; ++j) { c[j] = acc0[j]; c[4 + j] = acc1[j]; }
                c[8] = ssq; }
            if (tid < 64) hist[tid] = 0;
            __syncthreads();
            int te[4] = {0, 0, 0, 0}, lr[4] = {0, 0, 0, 0}; float tw[4] = {0.f, 0.f, 0.f, 0.f}; float rs = 0.f;
            if (active && kh == 0) {
                const LAS float* c = comb + (gi * 64 + lane) * 12;
#pragma unroll
                for (int j = 0; j < 4; ++j) { acc0[j] += c[j]; acc1[j] += c[4 + j]; }
                ssq += c[8];
                rs = 1.0f / sqrtf(ssq * (1.0f / DM) + EPS);
                LAS float* lg = lgb + gi * (16 * 36);
#pragma unroll
                for (int j = 0; j < 4; ++j) { lg[(4 * kq + j) * 36 + r16] = acc0[j]; lg[(4 * kq + j) * 36 + 16 + r16] = acc1[j]; }
                LDS_WAIT(); asm volatile("" ::: "memory");
                if (lane < 16) {
                    float l[32];
#pragma unroll
                    for (int n = 0; n < 32; ++n) l[n] = lg[lane * 36 + n] * rs + a.b_router[n];
                    float tv[4];
#pragma unroll
                    for (int k = 0; k < 4; ++k) { float bv = -3.0e38f; int bi = 0;
#pragma unroll
                        for (int n = 0; n < 32; ++n) if (l[n] > bv) { bv = l[n]; bi = n; }
                        tv[k] = bv; te[k] = bi;
#pragma unroll
                        for (int n = 0; n < 32; ++n) l[n] = (n == bi) ? -3.0e38f : l[n]; }
                    float den = 0.f;
#pragma unroll
                    for (int k = 0; k < 4; ++k) { tw[k] = expf(tv[k] - tv[0]); den += tw[k]; }
                    const float inv = 1.0f / den;
#pragma unroll
                    for (int k = 0; k < 4; ++k) { tw[k] *= inv; lr[k] = __hip_atomic_fetch_add(&hist[te[k]], 1, __ATOMIC_RELAXED, __HIP_MEMORY_SCOPE_WORKGROUP); }
                }
            }
            __syncthreads();
            if (tid < 32) { const int c = hist[tid]; hist[32 + tid] = c ? (int)__hip_atomic_fetch_add(ctl + CW_CNT + 64 * tid, (unsigned)c, RLX_AGENT) : 0; }
            __syncthreads();
            if (active && kh == 0 && lane < 16) { const size_t orow = (size_t)rg * 16 + lane;
#pragma unroll
                for (int k = 0; k < 4; ++k) { tk_e[orow * 4 + k] = te[k]; tk_rank[orow * 4 + k] = hist[32 + te[k]] + lr[k]; tk_w[orow * 4 + k] = tw[k]; }
                rs_tok[orow] = rs; }
            __syncthreads();
        }
        if (BOTH(7)) GRID_BAR();
    }

    if (IN(8)) {
        if (tid == 0) { int ps = 0, mt = 0;
            for (int e = 0; e < NE; ++e) { const int c = (int)__hip_atomic_load(ctl + CW_CNT + 64 * e, RLX_AGENT); pstart[e] = ps; const int nt = (c + 255) >> 8; for (int i = 0; i < nt; ++i) tile_e[mt + i] = e; mt += nt; ps += nt << 8; }
            pstart[NE] = ps; MISC[16] = (unsigned)mt; }
        __syncthreads();
        for (int p0 = gw * 64; p0 < NTOK * 4; p0 += NGW * 64) { const int p = p0 + lane;
            const int tok = p >> 2; const int e = tk_e[p], rk = tk_rank[p]; const int slot = pstart[e] + rk;
            { tk_slot[p] = slot; slot_w[slot] = tk_w[p]; slot_rs[slot] = rs_tok[tok]; slot_tok[slot] = tok; }
        }
        if (BOTH(8)) GRID_BAR();
    }

    if (IN(9)) {
        const int MT = (int)MISC[16];
        LAS int* tokt = (LAS int*)(lds + TOKT_OFF);
        const int ng9 = (G == 256) ? NG9 : G;
        if (bx < ng9) {
        pg8::GroupedOrder S; S.init(MT, 16, ng9, bx); S.tile_e = tile_e;
        { pg8::Unit u; for (int i = 0; i < TOKT_UNITS && S.next(i, u); ++i) if (tid < 256) tokt[i * 256 + tid] = slot_tok[u.pm * 256 + tid]; }
        __syncthreads();
        pg8::Gemm g{H8, WGU8, DM, nullptr, nullptr, tokt}; pg8::EpiSwiglu8 E{a.b_gate_up, slot_rs, ACT8};
        pg8::gemm_phase<true, 1, true>(lds, g, S, E);
        }
        moe_convert_queue(ctl + CW_Q2, NQ_MOE - NQ_TAIL, NQ_MOE, a.w_gate_up, a.w_down, WGU8, WD8, lane);
        if (BOTH(9)) GRID_BAR();
    }
    if (IN(10)) {
        const int MT = (int)MISC[16];
        pg8::Gemm g{ACT8, WD8, DFF, nullptr, nullptr, nullptr}; pg8::GroupedOrder S; S.init(MT, 8, G, bx); S.tile_e = tile_e; pg8::EpiDown8 E{a.b_down, slot_w, YS8};
        pg8::gemm_phase<true, 1, false>(lds, g, S, E);
        if (BOTH(10)) GRID_BAR();
    }
#endif

    if (IN(11)) {
        f32x4 gv[8];
#pragma unroll
        for (int j = 0; j < 8; ++j) gv[j] = *((const f32x4*)a.norm_final_g + lane + 64 * j);
        for (int m = gw; m < NTOK; m += NGW) {
#if DBG_STAGE >= 1
            const f32x4* xr = (const f32x4*)(X1 + (size_t)m * DM) + lane;
#else
            const f32x4* xr = (const f32x4*)(a.x + (size_t)m * DM) + lane;
#endif
            f32x4 v[8];
#pragma unroll
            for (int j = 0; j < 8; ++j) v[j] = xr[64 * j];
#if DBG_STAGE >= 3
#pragma unroll
            for (int k = 0; k < 4; ++k) { const int slot = tk_slot[m * 4 + k]; const unsigned* yp = (const unsigned*)(YS8 + (size_t)slot * DM) + lane;
#pragma unroll
                for (int j = 0; j < 8; ++j) { const int w = (int)yp[64 * j]; const f32x2 lo = __builtin_amdgcn_cvt_pk_f32_fp8(w, false), hi = __builtin_amdgcn_cvt_pk_f32_fp8(w, true);
                    v[j].x += lo.x * (1.0f / 64.0f); v[j].y += lo.y * (1.0f / 64.0f); v[j].z += hi.x * (1.0f / 64.0f); v[j].w += hi.y * (1.0f / 64.0f); } }
#endif
            float s = 0.f;
#pragma unroll
            for (int j = 0; j < 8; ++j) s += (v[j].x * v[j].x + v[j].y * v[j].y) + (v[j].z * v[j].z + v[j].w * v[j].w);
            const float rs = 1.0f / sqrtf(wave_sum(s) * (1.0f / DM) + EPS);
            f32x4* o = (f32x4*)(a.out + (size_t)m * DM) + lane;
#pragma unroll
            for (int j = 0; j < 8; ++j) o[64 * j] = v[j] * rs * gv[j];
        }
    }
#undef IN
#undef BOTH
#undef GRID_BAR
}

extern "C" void kernel_launch(void* const* d_in, const int* in_sizes, int n_in, void* d_out, int out_size, void* d_ws, size_t ws_size, hipStream_t stream) {
    static int grid = 0;
    if (grid == 0) {
        if (n_in != 19 || in_sizes[0] != NTOK * DM || out_size != NTOK * DM || ws_size < WS_END) { fprintf(stderr, "kernel_launch: unexpected shapes (n_in %d, in0 %d, out %d, ws %zu); nothing launched\n", n_in, n_in > 0 ? in_sizes[0] : -1, out_size, ws_size); grid = -1; return; }
        int dev = 0, cus = 0, per_cu = 0;
        if (hipGetDevice(&dev) != hipSuccess || hipDeviceGetAttribute(&cus, hipDeviceAttributeMultiprocessorCount, dev) != hipSuccess) { grid = -1; return; }
        if (hipFuncSetAttribute((const void*)mega_fwd, hipFuncAttributeMaxDynamicSharedMemorySize, LDS_BYTES) != hipSuccess) { fprintf(stderr, "kernel_launch: hipFuncSetAttribute failed\n"); grid = -1; return; }
        if (hipOccupancyMaxActiveBlocksPerMultiprocessor(&per_cu, (const void*)mega_fwd, NWAVES * 64, LDS_BYTES) != hipSuccess || per_cu < 1) { fprintf(stderr, "kernel_launch: occupancy query reports %d blocks per CU\n", per_cu); per_cu = 1; }
        (void)hipGetLastError();
        grid = cus;
    }
    if (grid < 0) return;
    if (hipMemsetAsync((char*)d_ws + WS_CTL, 0, CTL_ZERO_BYTES, stream) != hipSuccess) { fprintf(stderr, "kernel_launch: memset failed\n"); return; }
    Args a{};
    a.x = (const float*)d_in[0]; a.norm_mix_g = (const float*)d_in[1]; a.w_in = (const float*)d_in[2]; a.conv_w = (const float*)d_in[3]; a.conv_b = (const float*)d_in[4]; a.w_a2 = (const float*)d_in[5];
    a.b_a = (const float*)d_in[6]; a.gla_norm_g = (const float*)d_in[7]; a.w_br_a = (const float*)d_in[8]; a.w_br_b = (const float*)d_in[9]; a.w_out = (const float*)d_in[10]; a.norm_ffn_g = (const float*)d_in[11];
    a.w_router = (const float*)d_in[12]; a.b_router = (const float*)d_in[13]; a.w_gate_up = (const float*)d_in[14]; a.b_gate_up = (const float*)d_in[15]; a.w_down = (const float*)d_in[16]; a.b_down = (const float*)d_in[17];
    a.norm_final_g = (const float*)d_in[18]; a.out = (float*)d_out; a.ws = (unsigned char*)d_ws; a.ph_lo = 0; a.ph_hi = 12;
    hipLaunchKernelGGL(mega_fwd, dim3(grid), dim3(NWAVES * 64), LDS_BYTES, stream, a);
    const hipError_t le = hipPeekAtLastError();
    if (le != hipSuccess) fprintf(stderr, "kernel_launch: launch failed: %s\n", hipGetErrorName(le));
}
```

```cpp
#include <hip/hip_runtime.h>
#include <cstdio>
#include <cstdint>

#ifndef DBG_STAGE
#define DBG_STAGE 3
#endif

#ifndef REP_P0
#define REP_P0 1
#endif
#ifndef REP_P2
#define REP_P2 1
#endif
#define LAS __attribute__((address_space(3)))
#define GAS __attribute__((address_space(1)))
typedef unsigned short bf16;
typedef short bf16x8 __attribute__((ext_vector_type(8)));
typedef float f32x4 __attribute__((ext_vector_type(4)));
typedef float f32x2 __attribute__((ext_vector_type(2)));
typedef unsigned u32x4 __attribute__((ext_vector_type(4)));
typedef unsigned u32x2 __attribute__((ext_vector_type(2)));

constexpr int NTOK = 16384, DM = 2048, SEQ = 2048, NBATCH = 8;
constexpr int NP = 10496;
constexpr int PC_UC = 0, PC_UB = 1024, PC_UX = 2048, PC_Q = 3072, PC_K = 3584, PC_V = 4096, PC_R = 5120, PC_AL = 6144, PC_GA = 6400, PC_GB = 8448;
constexpr int SRC_AL = 6144;
constexpr int DIN = 10256;
constexpr int NE = 32, TOPK = 4, DFF = 2048;
constexpr int MAXSLOT = NTOK * TOPK + NE * 256;
constexpr int MAXMT = MAXSLOT / 256;
constexpr float EPS = 1e-6f;

constexpr size_t MiB = 1u << 20;
constexpr size_t WS_CTL = 0, CTL_ZERO_BYTES = 1 * MiB;
constexpr size_t WS_WRF = 1 * MiB;
constexpr size_t WS_TK = 2 * MiB;
constexpr size_t WS_SLOT = 4 * MiB;
constexpr size_t WS_WIN = 8 * MiB;
constexpr size_t WS_WA = 50 * MiB;
constexpr size_t WS_WB = 54 * MiB;
constexpr size_t WS_WO = 58 * MiB;
constexpr size_t WS_WGU = 66 * MiB;
constexpr size_t WS_WD = 578 * MiB;
constexpr size_t WS_H = 834 * MiB;
constexpr size_t WS_P = 898 * MiB;
constexpr size_t WS_ZA = 1226 * MiB;
constexpr size_t WS_ZB = 1258 * MiB;
constexpr size_t WS_O = 1290 * MiB;
constexpr size_t WS_YA = 1354 * MiB;
constexpr size_t WS_MIX = 1418 * MiB;
constexpr size_t WS_X1 = 1482 * MiB;
constexpr size_t WS_XB = 1610 * MiB;
constexpr size_t WS_ACT = 1898 * MiB;
constexpr size_t WS_YS = 2186 * MiB;
constexpr size_t WS_KTT = 2474 * MiB;
constexpr size_t WS_DEC = 2490 * MiB;
constexpr size_t WS_VTT = 2492 * MiB;
constexpr size_t WS_WIN8 = 2524 * MiB;
constexpr size_t WS_HQ8 = 2532 * MiB;
constexpr size_t WS_END = 2564 * MiB;
constexpr int CW_BAR = 4096;
constexpr int CW_Q3 = 8320;
constexpr int CW_Q2 = 8256;
constexpr int CW_Q = 8192;
constexpr int NGEMM = 208, QBATCH = 8;
constexpr int CW_CNT = 16384;

constexpr int RING_BYTES = 131072;
constexpr int TOKT_OFF = 131072, TOKT_UNITS = 30;
constexpr int LDSCTL_OFF = 161792;
constexpr int MISC_OFF = LDSCTL_OFF;
constexpr int TILEE_OFF = LDSCTL_OFF + 128;
constexpr int PSTART_OFF = TILEE_OFF + 4 * 320;
constexpr int LDS_BYTES = 163840;
constexpr int NWAVES = 8;

#define LDS_WAIT() asm volatile("s_waitcnt lgkmcnt(0)" ::: "memory")
#define VM_WAIT() asm volatile("s_waitcnt vmcnt(0)" ::: "memory")
#define RLX_AGENT __ATOMIC_RELAXED, __HIP_MEMORY_SCOPE_AGENT

typedef __bf16 bf16x2_t __attribute__((ext_vector_type(2)));
__device__ __forceinline__ unsigned cvt_pk_bf16(float lo, float hi) { f32x2 v = {lo, hi}; bf16x2_t b = __builtin_convertvector(v, bf16x2_t); return __builtin_bit_cast(unsigned, b); }
__device__ __forceinline__ float clamp448(float x) { return __builtin_amdgcn_fmed3f(x, -448.0f, 448.0f); }
__device__ __forceinline__ unsigned pk4_fp8(float a, float b, float c, float d) {
    int w = 0; w = __builtin_amdgcn_cvt_pk_fp8_f32(clamp448(a), clamp448(b), w, false); w = __builtin_amdgcn_cvt_pk_fp8_f32(clamp448(c), clamp448(d), w, true); return (unsigned)w; }
__device__ __forceinline__ float bf_lo(unsigned w) { return __uint_as_float(w << 16); }
__device__ __forceinline__ float bf_hi(unsigned w) { return __uint_as_float(w & 0xffff0000u); }
__device__ __forceinline__ float bf2f(bf16 b) { return __uint_as_float(((unsigned)b) << 16); }
__device__ __forceinline__ float fast_sigmoid(float x) { return __builtin_amdgcn_rcpf(1.0f + __builtin_amdgcn_exp2f(-1.44269504089f * x)); }
__device__ __forceinline__ float wave_sum(float v) {
#pragma unroll
    for (int o = 1; o < 64; o <<= 1) v += __shfl_xor(v, o);
    return v;
}

namespace pg8 {
constexpr int BM = 256, BK = 64, HALF = 128, HTB = HALF * BK * 2, STAGE_BYTES = 8 * HTB, NXCD = 8, WGM = 8;
__host__ __device__ __forceinline__ int lds_byte(int r, int c) { const int st = (r >> 4) * 2 + (c >> 5), rr = r & 15, cc = c & 31, ob = rr * 64 + cc * 2; return st * 1024 + (ob ^ (((ob >> 9) & 1) << 5)); }
__host__ __device__ __forceinline__ void stage_rc(int b, int& R, int& C) { const int st = b / 1024, sb = b % 1024, swz = sb ^ (((sb >> 9) & 1) << 5); R = (st >> 1) * 16 + swz / 64; C = (st & 1) * 32 + (swz % 64) / 2; }
__host__ __device__ __forceinline__ int perm32(int rho) { const int n = rho >> 4, i = rho & 15; return 8 * (i >> 2) + 4 * n + (i & 3); }

struct Unit { int pm, pn, pb, e; };
struct Gemm { const void* A; const void* Bt; int ldb; const void* A2; const void* Bt2; const LAS int* tokt; };

struct StaticOrder {
    int nM, nN, nwg, G, c, wgm;
    __device__ void init(int nM_, int nN_, int G_, int c_, int wgm_ = WGM) { nM = nM_; nN = nN_; nwg = nM * nN; G = G_; c = c_; wgm = wgm_; }
    __device__ __forceinline__ bool tile(int i, int& pm, int& pn) const {
        const long L = (long)i * G + c; if (L >= nwg) return false;
        int wgid = (int)L; { const int q = nwg / NXCD, r = nwg % NXCD, xcd = wgid % NXCD, off = wgid / NXCD; wgid = (xcd < r ? xcd * (q + 1) : r * (q + 1) + (xcd - r) * q) + off; }
        const int nig = wgm * nN, gid = wgid / nig, fm = gid * wgm, gsz = (nM - fm) < wgm ? (nM - fm) : wgm;
        pm = fm + ((wgid % nig) % gsz); pn = (wgid % nig) / gsz; return true;
    }
    __device__ __forceinline__ bool next(int i, Unit& u) const { if (!tile(i, u.pm, u.pn)) return false; u.pb = u.pn; u.e = 0; return true; }
};
struct GroupedOrder : StaticOrder {
    const LAS int* tile_e;
    __device__ __forceinline__ bool next(int i, Unit& u) const { if (!tile(i, u.pm, u.pn)) return false; u.e = tile_e[u.pm]; u.pb = u.e * nN + u.pn; return true; }
};

struct EpiPlainBf16 {
    static constexpr bool HASPRE = false; struct Pre {};
    static constexpr bool PERM = true;
    bf16* O; int ldc; int colbase; float scale;
    __device__ __forceinline__ void operator()(const f32x4 (&acc)[2][2][4][2], const Unit& u, int wr, int wc, int fr, int fq) const {
        const int row0 = u.pm * BM + wr * 64 + fr, col0 = colbase + u.pn * BM + wc * 32 + 8 * fq;
#pragma unroll
        for (int ai = 0; ai < 2; ++ai)
#pragma unroll
            for (int m = 0; m < 4; ++m) { bf16* rowp = O + (size_t)(row0 + ai * HALF + m * 16) * ldc + col0;
#pragma unroll
                for (int bj = 0; bj < 2; ++bj) { const f32x4 v0 = acc[ai][bj][m][0] * scale, v1 = acc[ai][bj][m][1] * scale;
                    u32x4 w; w.x = cvt_pk_bf16(v0[0], v0[1]); w.y = cvt_pk_bf16(v0[2], v0[3]); w.z = cvt_pk_bf16(v1[0], v1[1]); w.w = cvt_pk_bf16(v1[2], v1[3]);
                    *(u32x4*)(rowp + bj * HALF) = w; } }
    }
};
struct EpiPlainFp8 {
    static constexpr bool HASPRE = false; struct Pre {};
    static constexpr bool PERM = true;
    unsigned char* O8; int ldc; float scale;
    __device__ __forceinline__ void operator()(const f32x4 (&acc)[2][2][4][2], const Unit& u, int wr, int wc, int fr, int fq) const {
        const int row0 = u.pm * BM + wr * 64 + fr, col0 = u.pn * BM + wc * 32 + 8 * fq;
#pragma unroll
        for (int ai = 0; ai < 2; ++ai)
#pragma unroll
            for (int m = 0; m < 4; ++m) { unsigned char* rowp = O8 + (size_t)(row0 + ai * HALF + m * 16) * ldc + col0;
#pragma unroll
                for (int bj = 0; bj < 2; ++bj) { const f32x4 v0 = acc[ai][bj][m][0] * scale, v1 = acc[ai][bj][m][1] * scale;
                    u32x2 w; w.x = pk4_fp8(v0[0], v0[1], v0[2], v0[3]); w.y = pk4_fp8(v1[0], v1[1], v1[2], v1[3]);
                    *(u32x2*)(rowp + bj * HALF) = w; } }
    }
};
struct EpiGate2 {
    static constexpr bool HASPRE = false; struct Pre {};
    static constexpr bool PERM = true;
    const unsigned char* G8; bf16* O;
    __device__ __forceinline__ void mid(f32x4 (&acc)[2][2][4][2], const Unit& u, int wr, int wc, int fr, int fq) const {
        int opq = 0; asm volatile("" : "+v"(opq));
        const int row0 = u.pm * BM + wr * 64 + fr + opq, col0 = u.pn * BM + wc * 32 + 8 * fq;
        u32x2 ga[2][2], gb[2][2];
#define EG2_LOAD(buf, g_) do { const size_t row_ = (size_t)(row0 + ((g_) >> 2) * HALF + ((g_) & 3) * 16); _Pragma("unroll") for (int bj = 0; bj < 2; ++bj) { const int col_ = col0 + bj * HALF; \
            ga[buf][bj] = *(const u32x2*)(G8 + row_ * 4096 + col_); gb[buf][bj] = *(const u32x2*)(G8 + row_ * 4096 + 2048 + col_); } } while (0)
        EG2_LOAD(0, 0);
#pragma unroll
        for (int g = 0; g < 8; ++g) { const int ai = g >> 2, m = g & 3, cb = g & 1;
            if (g + 1 < 8) { if (cb) EG2_LOAD(0, g + 1); else EG2_LOAD(1, g + 1); }
            asm volatile("" ::: "memory");
#pragma unroll
            for (int bj = 0; bj < 2; ++bj) {
#pragma unroll
                for (int q = 0; q < 4; ++q) {
                    const int gaw_ = (int)(q < 2 ? ga[cb][bj].x : ga[cb][bj].y), gbw_ = (int)(q < 2 ? gb[cb][bj].x : gb[cb][bj].y);
                    const f32x2 a2 = (q & 1) ? __builtin_amdgcn_cvt_pk_f32_fp8(gaw_, true) : __builtin_amdgcn_cvt_pk_f32_fp8(gaw_, false), b2 = (q & 1) ? __builtin_amdgcn_cvt_pk_f32_fp8(gbw_, true) : __builtin_amdgcn_cvt_pk_f32_fp8(gbw_, false);
                    const float r0 = (1.0f + __builtin_amdgcn_exp2f(-0.0901684400556f * b2.x)) * __builtin_amdgcn_rcpf(1.0f + __builtin_amdgcn_exp2f(-0.0901684400556f * a2.x));
                    const float r1 = (1.0f + __builtin_amdgcn_exp2f(-0.0901684400556f * b2.y)) * __builtin_amdgcn_rcpf(1.0f + __builtin_amdgcn_exp2f(-0.0901684400556f * a2.y));
                    acc[ai][bj][m][q >> 1][2 * (q & 1)] *= r0; acc[ai][bj][m][q >> 1][2 * (q & 1) + 1] *= r1; } } }
#undef EG2_LOAD
    }
    __device__ __forceinline__ void operator()(const f32x4 (&acc)[2][2][4][2], const Unit& u, int wr, int wc, int fr, int fq) const {
        const int row0 = u.pm * BM + wr * 64 + fr, col0 = u.pn * BM + wc * 32 + 8 * fq;
#pragma unroll
        for (int ai = 0; ai < 2; ++ai)
#pragma unroll
            for (int m = 0; m < 4; ++m) { const size_t row = (size_t)(row0 + ai * HALF + m * 16);
#pragma unroll
                for (int bj = 0; bj < 2; ++bj) { const int col = col0 + bj * HALF;
                    const u32x2 g = *(const u32x2*)(G8 + row * 4096 + 2048 + col);
                    f32x4 v0 = acc[ai][bj][m][0], v1 = acc[ai][bj][m][1];
                    { const f32x2 g0 = __builtin_amdgcn_cvt_pk_f32_fp8((int)g.x, false), g1 = __builtin_amdgcn_cvt_pk_f32_fp8((int)g.x, true), g2 = __builtin_amdgcn_cvt_pk_f32_fp8((int)g.y, false), g3 = __builtin_amdgcn_cvt_pk_f32_fp8((int)g.y, true);
                      v0[0] *= fast_sigmoid(0.0625f * g0.x); v0[1] *= fast_sigmoid(0.0625f * g0.y); v0[2] *= fast_sigmoid(0.0625f * g1.x); v0[3] *= fast_sigmoid(0.0625f * g1.y);
                      v1[0] *= fast_sigmoid(0.0625f * g2.x); v1[1] *= fast_sigmoid(0.0625f * g2.y); v1[2] *= fast_sigmoid(0.0625f * g3.x); v1[3] *= fast_sigmoid(0.0625f * g3.y); }
                    u32x4 w; w.x = cvt_pk_bf16(v0[0], v0[1]); w.y = cvt_pk_bf16(v0[2], v0[3]); w.z = cvt_pk_bf16(v1[0], v1[1]); w.w = cvt_pk_bf16(v1[2], v1[3]);
                    *(u32x4*)(O + row * DM + col) = w; } }
    }
};
struct EpiResF32 {
    static constexpr bool HASPRE = false; struct Pre {};
    static constexpr bool PERM = false;
    const float* base; float* C;
    __device__ __forceinline__ void operator()(const f32x4 (&acc)[2][2][4][2], const Unit& u, int wr, int wc, int fr, int fq) const {
        const int row0 = u.pm * BM + wr * 64 + fr, col0 = u.pn * BM + wc * 32 + 4 * fq;
#pragma unroll
        for (int ai = 0; ai < 2; ++ai)
#pragma unroll
            for (int m = 0; m < 4; ++m) { const size_t off = (size_t)(row0 + ai * HALF + m * 16) * DM + col0;
#pragma unroll
                for (int bj = 0; bj < 2; ++bj)
#pragma unroll
                    for (int n = 0; n < 2; ++n) { const f32x4 b = *(const f32x4*)(base + off + bj * HALF + n * 16); *(f32x4*)(C + off + bj * HALF + n * 16) = acc[ai][bj][m][n] + b; } }
    }
};
struct EpiSwiglu8 {
    static constexpr bool PERM = true;
    static constexpr bool HASPRE = true;
    struct Pre { f32x4 bg0, bg1, bu0, bu1; float rs[4]; };
    const float* bgu; const float* slot_rs; unsigned char* ACT8;
    __device__ __forceinline__ void prefetch(Pre& p, const Unit& u, int wr, int wc, int fr, int fq) const {
        const int row0 = u.pm * BM + wr * 64 + fr, cl = u.pn * HALF + wc * 32 + 8 * fq;
        const float* bg = bgu + (size_t)u.e * (2 * DFF) + cl;
        p.bg0 = *(const f32x4*)(bg); p.bg1 = *(const f32x4*)(bg + 4); p.bu0 = *(const f32x4*)(bg + DFF) * 4.0f + 4.0f; p.bu1 = *(const f32x4*)(bg + DFF + 4) * 4.0f + 4.0f;
#pragma unroll
        for (int m = 0; m < 4; ++m) p.rs[m] = slot_rs[(size_t)(row0 + m * 16)];
    }
    __device__ __forceinline__ void operator()(const f32x4 (&acc)[2][2][4][2], const Unit& u, int wr, int wc, int fr, int fq, const Pre& p) const {
        const int row0 = u.pm * BM + wr * 64 + fr, cl = u.pn * HALF + wc * 32 + 8 * fq;
        const f32x4 bg0 = p.bg0, bg1 = p.bg1, bu0 = p.bu0, bu1 = p.bu1;
        float rs1[4];
#pragma unroll
        for (int m = 0; m < 4; ++m) rs1[m] = slot_rs[(size_t)(row0 + HALF + m * 16)];
#pragma unroll
        for (int ai = 0; ai < 2; ++ai)
#pragma unroll
            for (int m = 0; m < 4; ++m) { const size_t row = (size_t)(row0 + ai * HALF + m * 16); const float rs = (ai ? rs1[m] : p.rs[m]) * (1.0f / 16384.0f);
                const float rs4 = 4.0f * rs;
                const f32x4 g0 = acc[ai][0][m][0] * rs + bg0, g1 = acc[ai][0][m][1] * rs + bg1, u0 = acc[ai][1][m][0] * rs4 + bu0, u1 = acc[ai][1][m][1] * rs4 + bu1;
                float o[8];
#pragma unroll
                for (int j = 0; j < 4; ++j) {
                    float g = fminf(g0[j], 7.0f), up = __builtin_amdgcn_fmed3f(u0[j], -24.0f, 32.0f);
                    o[j] = up * (g * __builtin_amdgcn_rcpf(1.0f + __builtin_amdgcn_exp2f(-2.45546696f * g)));
                    g = fminf(g1[j], 7.0f); up = __builtin_amdgcn_fmed3f(u1[j], -24.0f, 32.0f);
                    o[4 + j] = up * (g * __builtin_amdgcn_rcpf(1.0f + __builtin_amdgcn_exp2f(-2.45546696f * g))); }
                u32x2 w; { int t_ = 0; t_ = __builtin_amdgcn_cvt_pk_fp8_f32(o[0], o[1], t_, false); t_ = __builtin_amdgcn_cvt_pk_fp8_f32(o[2], o[3], t_, true); w.x = (unsigned)t_;
                           t_ = 0; t_ = __builtin_amdgcn_cvt_pk_fp8_f32(o[4], o[5], t_, false); t_ = __builtin_amdgcn_cvt_pk_fp8_f32(o[6], o[7], t_, true); w.y = (unsigned)t_; }
                *(u32x2*)(ACT8 + row * DFF + cl) = w; }
    }
};
struct EpiDown8 {
    static constexpr bool PERM = true;
    static constexpr bool HASPRE = true;
    struct Pre { f32x4 bv[2][2]; float sw[8]; };
    const float* bd; const float* slot_w; unsigned char* YS8;
    __device__ __forceinline__ void prefetch(Pre& p, const Unit& u, int wr, int wc, int fr, int fq) const {
        const int row0 = u.pm * BM + wr * 64 + fr, col0 = u.pn * BM + wc * 32 + 8 * fq;
        const float* bp = bd + (size_t)u.e * DM + col0;
#pragma unroll
        for (int bj = 0; bj < 2; ++bj)
#pragma unroll
            for (int n = 0; n < 2; ++n) p.bv[bj][n] = *(const f32x4*)(bp + bj * HALF + 4 * n);
#pragma unroll
        for (int ai = 0; ai < 2; ++ai)
#pragma unroll
            for (int m = 0; m < 4; ++m) p.sw[ai * 4 + m] = slot_w[(size_t)(row0 + ai * HALF + m * 16)];
    }
    __device__ __forceinline__ void operator()(const f32x4 (&acc)[2][2][4][2], const Unit& u, int wr, int wc, int fr, int fq, const Pre& p) const {
        const int row0 = u.pm * BM + wr * 64 + fr, col0 = u.pn * BM + wc * 32 + 8 * fq;
#pragma unroll
        for (int ai = 0; ai < 2; ++ai)
#pragma unroll
            for (int m = 0; m < 4; ++m) { const size_t row = (size_t)(row0 + ai * HALF + m * 16); const float sw = p.sw[ai * 4 + m] * 64.0f;
#pragma unroll
                for (int bj = 0; bj < 2; ++bj) { const f32x4 v0 = (acc[ai][bj][m][0] * (1.0f / 4096.0f) + p.bv[bj][0]) * sw, v1 = (acc[ai][bj][m][1] * (1.0f / 4096.0f) + p.bv[bj][1]) * sw;
                    u32x2 w; w.x = pk4_fp8(v0[0], v0[1], v0[2], v0[3]); w.y = pk4_fp8(v1[0], v1[1], v1[2], v1[3]);
                    *(u32x2*)(YS8 + row * DM + col0 + bj * HALF) = w; } }
    }
};

typedef int v4i_t __attribute__((ext_vector_type(4)));
typedef int v8i_t __attribute__((ext_vector_type(8)));
template <bool F8, int NSEG, bool GATHER, class Epi, class Sched>
__device__ __forceinline__ void gemm_phase(LAS unsigned char* lds, const Gemm g, const Sched& S, const Epi& E) {
    const int tid = threadIdx.x, wid = __builtin_amdgcn_readfirstlane(tid >> 6), lane = tid & 63, wr = wid >> 2, wc = wid & 3, fr = lane & 15, fq = lane >> 4;
    const int ldb = g.ldb, nt = ldb / 128;
    unsigned voffA[2], voffB[2];
#pragma unroll
    for (int i = 0; i < 2; ++i) { int R, C; stage_rc(tid * 16 + i * 8192, R, C); const int Rb = Epi::PERM ? ((R & ~31) + perm32(R & 31)) : R;
        voffA[i] = (unsigned)(R * ldb + C * 2); voffB[i] = (unsigned)(Rb * ldb + C * 2); }
    const size_t kstep = (size_t)128;
    const size_t hstep = (size_t)HALF * ldb;
    const size_t tstep = 2 * hstep;
    const unsigned ldsw = (unsigned)wid * 1024u;
    const int aoff = lds_byte(wr * 64 + fr, fq * 8), boff = lds_byte(wc * 32 + fr, fq * 8);
#define PG8_SA(b, h) (((b) * 2 + (h)) * HTB)
#define PG8_SB(b, h) ((4 + (b) * 2 + (h)) * HTB)
#define PG8_STAGE(bufoff, gbase, voff) do { _Pragma("unroll") for (int _i = 0; _i < 2; ++_i) \
        __builtin_amdgcn_global_load_lds((const unsigned*)((const char*)(gbase) + (voff)[_i]), (LAS unsigned*)(lds + (bufoff) + ldsw + _i * 8192), 16, 0, 0); } while (0)
#define PG8_STAGE_A(bufoff, gbase, h, nx) do { if constexpr (GATHER) { unsigned vv_[2]; vv_[0] = (nx) ? offAn[h][0] : offA[h][0]; vv_[1] = (nx) ? offAn[h][1] : offA[h][1]; PG8_STAGE(bufoff, gbase, vv_); } \
        else { PG8_STAGE(bufoff, (gbase) + ((h) ? hstep : (size_t)0), voffA); } } while (0)
#define PG8_LDA(dst, b, h) do { _Pragma("unroll") for (int m = 0; m < 4; ++m) _Pragma("unroll") for (int k = 0; k < 2; ++k) dst[m][k] = *(const LAS bf16x8*)(lds + PG8_SA(b, h) + aoff + m * 2048 + k * 1024); } while (0)
#define PG8_LDB(dst, b, h) do { _Pragma("unroll") for (int n = 0; n < 2; ++n) _Pragma("unroll") for (int k = 0; k < 2; ++k) dst[n][k] = *(const LAS bf16x8*)(lds + PG8_SB(b, h) + boff + n * 2048 + k * 1024); } while (0)
#define PG8_MMA(ai, bj, At, Bt) do { __builtin_amdgcn_s_setprio(1); if constexpr (F8) { asm volatile("s_nop 1"); _Pragma("unroll") for (int m = 0; m < 4; ++m) _Pragma("unroll") for (int n = 0; n < 2; ++n) \
        { const v8i_t b8_ = __builtin_shufflevector(__builtin_bit_cast(v4i_t, Bt[n][0]), __builtin_bit_cast(v4i_t, Bt[n][1]), 0, 1, 2, 3, 4, 5, 6, 7); \
          const v8i_t a8_ = __builtin_shufflevector(__builtin_bit_cast(v4i_t, At[m][0]), __builtin_bit_cast(v4i_t, At[m][1]), 0, 1, 2, 3, 4, 5, 6, 7); \
          asm volatile("v_mfma_scale_f32_16x16x128_f8f6f4 %0, %1, %2, %0, %3, %3 op_sel_hi:[0,0,0]" : "+v"(acc[ai][bj][m][n]) : "v"(b8_), "v"(a8_), "v"(sc8)); } } \
      else { _Pragma("unroll") for (int m = 0; m < 4; ++m) _Pragma("unroll") for (int n = 0; n < 2; ++n) _Pragma("unroll") for (int k = 0; k < 2; ++k) \
        acc[ai][bj][m][n] = __builtin_amdgcn_mfma_f32_16x16x32_bf16(Bt[n][k], At[m][k], acc[ai][bj][m][n], 0, 0, 0); } __builtin_amdgcn_s_setprio(0); } while (0)
#define PG8_WAIT_V(n) asm volatile("s_waitcnt vmcnt(" #n ")" ::: "memory")
#define PG8_WAIT_L(n) asm volatile("s_waitcnt lgkmcnt(" #n ")" ::: "memory")
#define PG8_BAR __builtin_amdgcn_s_barrier()
#define PG8_SCHED __builtin_amdgcn_sched_barrier(0)
    Unit cur, nxt; int ui = 0;
    if (!S.next(0, cur)) return;
    typename Epi::Pre pre; if constexpr (Epi::HASPRE) E.prefetch(pre, cur, wr, wc, fr, fq);
    int sc8 = 0; if constexpr (F8) { asm volatile("v_mov_b32 %0, 0x7f7f7f7f\n\ts_nop 1" : "=v"(sc8)); }
    f32x4 acc[2][2][4][2];
#pragma unroll
    for (int a = 0; a < 2; ++a)
#pragma unroll
        for (int b = 0; b < 2; ++b)
#pragma unroll
            for (int m = 0; m < 4; ++m)
#pragma unroll
                for (int n = 0; n < 2; ++n) acc[a][b][m][n] = (f32x4){0.f, 0.f, 0.f, 0.f};
    bf16x8 At[4][2], B0[2][2], B1[2][2];
    const char* cA = (const char*)g.A + (GATHER ? (size_t)0 : (size_t)cur.pm * tstep); const char* cB = (const char*)g.Bt + (size_t)cur.pb * tstep;
    constexpr bool DUAL = (NSEG == 2);
    unsigned offA[2][2] = {{0u, 0u}, {0u, 0u}}, offAn[2][2] = {{0u, 0u}, {0u, 0u}};
    int gR0 = 0, gC2 = 0; if constexpr (GATHER) { int R, C; stage_rc(tid * 16, R, C); gR0 = R; gC2 = C * 2;
#pragma unroll
        for (int h = 0; h < 2; ++h)
#pragma unroll
            for (int i = 0; i < 2; ++i) offA[h][i] = (unsigned)(g.tokt[128 * h + gR0 + 64 * i] * ldb + gC2);
        asm volatile("s_waitcnt lgkmcnt(0)" ::: "memory"); }
    PG8_STAGE(PG8_SB(0, 0), cB, voffB); PG8_STAGE_A(PG8_SA(0, 0), cA, 0, false); PG8_STAGE(PG8_SB(0, 1), cB + hstep, voffB); PG8_STAGE_A(PG8_SA(0, 1), cA, 1, false);
    if (wr == 1) PG8_BAR;
    PG8_WAIT_V(4); PG8_BAR;
    PG8_STAGE(PG8_SB(1, 0), cB + kstep, voffB); PG8_STAGE_A(PG8_SA(1, 0), cA + kstep, 0, false); PG8_STAGE(PG8_SB(1, 1), cB + hstep + kstep, voffB);
    PG8_WAIT_V(6); PG8_BAR;
    for (;;) {
        const bool has_next = S.next(ui + 1, nxt);
        if constexpr (GATHER) { if (has_next) {
#pragma unroll
            for (int h = 0; h < 2; ++h)
#pragma unroll
                for (int i = 0; i < 2; ++i) offAn[h][i] = (unsigned)(g.tokt[(ui + 1) * 256 + 128 * h + gR0 + 64 * i] * ldb + gC2); }
            asm volatile("s_waitcnt lgkmcnt(0)" ::: "memory"); }
        const char* nA = (has_next && !GATHER) ? (const char*)g.A + (size_t)nxt.pm * tstep : cA; const char* nB = has_next ? (const char*)g.Bt + (size_t)nxt.pb * tstep : cB;
        for (int t = 0; t < NSEG * nt; t += 2) {
            const bool last = (t == NSEG * nt - 2); const bool nx = last && has_next;
            const bool seg2 = DUAL && (t >= nt), cross = DUAL && (t == nt - 2);
            const char* sA_ = seg2 ? (const char*)g.A2 + (size_t)cur.pm * tstep - (size_t)nt * kstep : cA; const char* sB_ = seg2 ? (const char*)g.Bt2 + (size_t)cur.pb * tstep - (size_t)nt * kstep : cB;
            if constexpr (DUAL) { if (t == nt) E.mid(acc, cur, wr, wc, fr, fq); }
            const char* a1 = sA_ + (size_t)(t + 1) * kstep;
            const char* a2 = last ? nA : cross ? (const char*)g.A2 + (size_t)cur.pm * tstep : sA_ + (size_t)(t + 2) * kstep; const char* b2 = last ? nB : cross ? (const char*)g.Bt2 + (size_t)cur.pb * tstep : sB_ + (size_t)(t + 2) * kstep;
            const char* a3 = a2 + kstep; const char* b3 = b2 + kstep;
            PG8_LDB(B0, 0, 0); PG8_SCHED; PG8_LDA(At, 0, 0); PG8_STAGE_A(PG8_SA(1, 1), a1, 1, false);
            PG8_WAIT_L(8); PG8_BAR; PG8_WAIT_L(0); PG8_MMA(0, 0, At, B0); PG8_BAR; PG8_SCHED;
            PG8_LDB(B1, 0, 1); PG8_STAGE(PG8_SB(0, 0), b2, voffB);
            PG8_BAR; PG8_WAIT_L(0); PG8_MMA(0, 1, At, B1); PG8_BAR;
            PG8_LDA(At, 0, 1); PG8_STAGE_A(PG8_SA(0, 0), a2, 0, nx);
            PG8_BAR; PG8_WAIT_L(0); PG8_MMA(1, 0, At, B0); PG8_BAR; PG8_SCHED;
            PG8_STAGE(PG8_SB(0, 1), b2 + hstep, voffB);
            PG8_WAIT_V(6); PG8_BAR; PG8_MMA(1, 1, At, B1); PG8_BAR;
            PG8_LDB(B0, 1, 0); PG8_SCHED; PG8_LDA(At, 1, 0); PG8_STAGE_A(PG8_SA(0, 1), a2, 1, nx);
            PG8_WAIT_L(8); PG8_BAR; PG8_WAIT_L(0); PG8_MMA(0, 0, At, B0); PG8_BAR; PG8_SCHED;
            PG8_LDB(B1, 1, 1); PG8_STAGE(PG8_SB(1, 0), b3, voffB);
            PG8_BAR; PG8_WAIT_L(0); PG8_MMA(0, 1, At, B1); PG8_BAR;
            PG8_LDA(At, 1, 1); PG8_STAGE_A(PG8_SA(1, 0), a3, 0, nx);
            PG8_BAR; PG8_WAIT_L(0); PG8_MMA(1, 0, At, B0); PG8_BAR; PG8_SCHED;
            PG8_STAGE(PG8_SB(1, 1), b3 + hstep, voffB);
            PG8_WAIT_V(6); PG8_BAR; PG8_MMA(1, 1, At, B1); PG8_BAR;
        }
        if constexpr (F8) { asm volatile("s_nop 15\n\ts_nop 15" : "+v"(acc[1][1][0][0]), "+v"(acc[1][1][0][1]), "+v"(acc[1][1][1][0]), "+v"(acc[1][1][1][1]), "+v"(acc[1][1][2][0]), "+v"(acc[1][1][2][1]), "+v"(acc[1][1][3][0]), "+v"(acc[1][1][3][1])); }
        if constexpr (Epi::HASPRE) E(acc, cur, wr, wc, fr, fq, pre); else E(acc, cur, wr, wc, fr, fq);
        if (!has_next) break;
#pragma unroll
        for (int a = 0; a < 2; ++a)
#pragma unroll
            for (int b = 0; b < 2; ++b)
#pragma unroll
                for (int m = 0; m < 4; ++m)
#pragma unroll
                    for (int n = 0; n < 2; ++n) acc[a][b][m][n] = (f32x4){0.f, 0.f, 0.f, 0.f};
        cur = nxt; cA = nA; cB = nB; ++ui;
        if constexpr (Epi::HASPRE) E.prefetch(pre, cur, wr, wc, fr, fq);
        if constexpr (GATHER) {
#pragma unroll
            for (int h = 0; h < 2; ++h)
#pragma unroll
                for (int i = 0; i < 2; ++i) offA[h][i] = offAn[h][i]; }
    }
    PG8_WAIT_V(0);
    if (wr == 0) PG8_BAR;
    PG8_BAR;
#undef PG8_SA
#undef PG8_SB
#undef PG8_STAGE
#undef PG8_STAGE_A
#undef PG8_LDA
#undef PG8_LDB
#undef PG8_MMA
#undef PG8_WAIT_V
#undef PG8_WAIT_L
#undef PG8_BAR
#undef PG8_SCHED
}
}

#define XB_TMO      128
#define XB_XCNT(j)  (256  + 64 * (j))
#define XB_XSUB(j)  (1280 + 64 * (j))
#define XB_XGEN(j)  (2304 + 64 * (j))
#define XB_TOP      3328
#define XB_TOPGEN   3392
#define XCD_BAR_WORDS 3456
#define XB_SPIN_CAP (1u << 18)

__device__ __forceinline__ unsigned xb_ld(unsigned* p)              { return __hip_atomic_load(p, __ATOMIC_RELAXED, __HIP_MEMORY_SCOPE_AGENT); }
__device__ __forceinline__ unsigned xb_add(unsigned* p, unsigned v) { return __hip_atomic_fetch_add(p, v, __ATOMIC_RELAXED, __HIP_MEMORY_SCOPE_AGENT); }
__device__ __forceinline__ unsigned xb_xcc_id() { return (unsigned)__builtin_amdgcn_s_getreg((3 << 11) | 20) & 0xFu; }
#define XB_SPIN(cond, bar) do { unsigned _sp = 0; while (cond) { __builtin_amdgcn_s_sleep(1); \
    if ((++_sp & 255u) == 0u) { if (xb_ld(&(bar)[XB_TMO])) break; if (_sp > XB_SPIN_CAP) { atomicAdd(&(bar)[XB_TMO], 1u); break; } } } } while (0)

struct XcdBarrier { unsigned* bar; unsigned x; volatile LAS unsigned* st; };

__device__ __forceinline__ XcdBarrier xcd_barrier_post(unsigned* bar, volatile LAS unsigned* st) {
    XcdBarrier b; b.bar = bar; b.x = xb_xcc_id(); b.st = st;
    if (threadIdx.x == 0) (void)xb_add(&bar[XB_XCNT(b.x)], 1u);
    return b;
}
__device__ __forceinline__ void xcd_barrier_complete(unsigned* bar, unsigned x, unsigned& nloc, unsigned& nx) {
    const unsigned G = gridDim.x * gridDim.y * gridDim.z;
    unsigned sum, cnt, mine, sp = 0u;
    for (;;) {
        sum = 0u; cnt = 0u; mine = 0u;
#pragma unroll
        for (unsigned j = 0; j < 16; ++j) { const unsigned c = xb_ld(&bar[XB_XCNT(j)]); sum += c; cnt += (c > 0u) ? 1u : 0u; mine = (j == x) ? c : mine; }
        if (sum == G) break;
        __builtin_amdgcn_s_sleep(1);
        if ((++sp & 255u) == 0u) { if (xb_ld(&bar[XB_TMO])) break; if (sp > XB_SPIN_CAP) { atomicAdd(&bar[XB_TMO], 1u); break; } }
    }
    nloc = mine > 0u ? mine : 1u; nx = cnt > 0u ? cnt : 1u;
}
__device__ __forceinline__ void xcd_barrier(const XcdBarrier& b) {
    asm volatile("s_waitcnt vmcnt(0)" ::: "memory");
    __syncthreads();
    if (threadIdx.x == 0) {
        unsigned* bar = b.bar;
        __builtin_amdgcn_s_waitcnt(0);
        unsigned nloc = b.st[0], nx = b.st[1];
        if (nloc == 0u) { xcd_barrier_complete(bar, b.x, nloc, nx); b.st[0] = nloc; b.st[1] = nx; }
        const unsigned old = xb_add(&bar[XB_XSUB(b.x)], 1u);
        const unsigned gen = old / nloc;
        if (old + 1u == (gen + 1u) * nloc) {
            __builtin_amdgcn_fence(__ATOMIC_RELEASE, "agent");
            asm volatile("s_waitcnt vmcnt(0)" ::: "memory");
            const unsigned og = xb_add(&bar[XB_TOP], 1u);
            const unsigned tg = og / nx;
            if (og + 1u == (tg + 1u) * nx) xb_add(&bar[XB_TOPGEN], 1u);
            else XB_SPIN(xb_ld(&bar[XB_TOPGEN]) == tg, bar);
            __builtin_amdgcn_fence(__ATOMIC_ACQUIRE, "agent");
            xb_add(&bar[XB_XGEN(b.x)], 1u);
            asm volatile("s_waitcnt vmcnt(0)" ::: "memory");
        } else {
            XB_SPIN(xb_ld(&bar[XB_XGEN(b.x)]) == gen, bar);
            __builtin_amdgcn_fence(__ATOMIC_ACQUIRE, "agent");
            asm volatile("s_waitcnt vmcnt(0)" ::: "memory");
        }
    }
    __syncthreads();
}

struct Args {
    const float* x; const float* norm_mix_g; const float* w_in; const float* conv_w; const float* conv_b; const float* w_a2; const float* b_a; const float* gla_norm_g;
    const float* w_br_a; const float* w_br_b; const float* w_out; const float* norm_ffn_g; const float* w_router; const float* b_router; const float* w_gate_up; const float* b_gate_up;
    const float* w_down; const float* b_down; const float* norm_final_g; float* out; unsigned char* ws; int ph_lo, ph_hi;
};

__device__ __forceinline__ void tr_item(const float* W, size_t ldw, int k0, int sn0, bf16* WT, int K, size_t drow0, LAS float* scr, int lane) {
#pragma unroll 8
    for (int i = 0; i < 32; ++i) { const int kk = 2 * i + (lane >> 5); scr[kk * 33 + (lane & 31)] = W[(size_t)(k0 + kk) * ldw + sn0 + (lane & 31)]; }
    LDS_WAIT(); asm volatile("" ::: "memory");
    const int c = lane & 7;
#pragma unroll
    for (int j = 0; j < 4; ++j) { const int n = (lane >> 3) + 8 * j; const LAS float* s = scr + (8 * c) * 33 + n;
        u32x4 o; o.x = cvt_pk_bf16(s[0 * 33], s[1 * 33]); o.y = cvt_pk_bf16(s[2 * 33], s[3 * 33]); o.z = cvt_pk_bf16(s[4 * 33], s[5 * 33]); o.w = cvt_pk_bf16(s[6 * 33], s[7 * 33]);
        *(u32x4*)(WT + (drow0 + n) * K + k0 + 8 * c) = o; }
    LDS_WAIT(); asm volatile("" ::: "memory");
}

struct TrItem { const float* W; size_t ldw; unsigned char* dst; int Kb; };
__device__ __forceinline__ void tr8_load(const TrItem& t, f32x4 (&r)[16]) {
#pragma unroll
    for (int i = 0; i < 16; ++i) r[i] = __builtin_nontemporal_load((const f32x4*)(t.W + (size_t)i * t.ldw));
}
__device__ __forceinline__ void tr8_store(const TrItem& t, const f32x4 (&r)[16], float scale) {
#pragma unroll
    for (int q = 0; q < 4; ++q) { u32x4 o;
        o.x = pk4_fp8(r[0][q] * scale, r[1][q] * scale, r[2][q] * scale, r[3][q] * scale); o.y = pk4_fp8(r[4][q] * scale, r[5][q] * scale, r[6][q] * scale, r[7][q] * scale);
        o.z = pk4_fp8(r[8][q] * scale, r[9][q] * scale, r[10][q] * scale, r[11][q] * scale); o.w = pk4_fp8(r[12][q] * scale, r[13][q] * scale, r[14][q] * scale, r[15][q] * scale);
        __builtin_nontemporal_store(o, (u32x4*)(t.dst + (size_t)q * t.Kb)); }
}
__device__ __forceinline__ TrItem moe_item(int it, const float* w_gate_up, const float* w_down, unsigned char* WGU8, unsigned char* WD8, int lane) {
    constexpr int NQ_GU = NE * 16 * 128; const int kr = lane >> 3, c4 = lane & 7; TrItem t;
    if (it < NQ_GU) { const int e = it / (16 * 128), r = it % (16 * 128), kb = r / 128, nb = r % 128; const int n0 = 32 * nb, isup = n0 / DFF, j = n0 % DFF;
        t.ldw = 2 * DFF; t.Kb = DM; t.W = w_gate_up + (size_t)e * DM * 2 * DFF + (size_t)(128 * kb + 16 * kr) * (2 * DFF) + n0 + 4 * c4;
        t.dst = WGU8 + ((size_t)e * 4096 + 256 * (j / 128) + 128 * isup + (j % 128) + 4 * c4) * DM + 128 * kb + 16 * kr; }
    else { const int i2 = it - NQ_GU; const int e = i2 / (16 * 64), r = i2 % (16 * 64), kb = r / 64, nb = r % 64;
        t.ldw = DM; t.Kb = DFF; t.W = w_down + (size_t)e * DFF * DM + (size_t)(128 * kb + 16 * kr) * DM + 32 * nb + 4 * c4;
        t.dst = WD8 + ((size_t)e * DM + 32 * nb + 4 * c4) * DFF + 128 * kb + 16 * kr; }
    return t;
}

constexpr int NQ_MOE = NE * 16 * 128 + NE * 16 * 64;
constexpr int NG9 = 232;
constexpr int NQ_SCAN = 0;
constexpr int NQ_TAIL = 32768;
static_assert(QBATCH % 2 == 0 && NQ_MOE % QBATCH == 0 && NQ_TAIL % QBATCH == 0, "queue batches");
__device__ __forceinline__ void moe_convert_queue(unsigned* head, int first, int last, const float* w_gate_up, const float* w_down, unsigned char* WGU8, unsigned char* WD8, int lane) {
    int nbase = 0; if (lane == 0) nbase = (int)__hip_atomic_fetch_add(head, (unsigned)QBATCH, RLX_AGENT);
    for (;;) {
        const int base = first + __builtin_amdgcn_readfirstlane(nbase);
        if (base >= last) break;
        if (lane == 0) nbase = (int)__hip_atomic_fetch_add(head, (unsigned)QBATCH, RLX_AGENT);
        f32x4 ra[16], rb[16];
        TrItem ta = moe_item(base, w_gate_up, w_down, WGU8, WD8, lane), tb;
        tr8_load(ta, ra);
#pragma unroll
        for (int j = 0; j < QBATCH; j += 2) {
            tb = moe_item(base + j + 1, w_gate_up, w_down, WGU8, WD8, lane); tr8_load(tb, rb);
            tr8_store(ta, ra, 1024.0f);
            if (j + 2 < QBATCH) { ta = moe_item(base + j + 2, w_gate_up, w_down, WGU8, WD8, lane); tr8_load(ta, ra); }
            tr8_store(tb, rb, 1024.0f);
        }
    }
}

__global__ void __launch_bounds__(NWAVES * 64, 2) mega_fwd(Args a) {
    extern __shared__ __attribute__((aligned(16))) unsigned char lds_raw[];
    LAS unsigned char* lds = (LAS unsigned char*)lds_raw;
    volatile LAS unsigned* MISC = (volatile LAS unsigned*)(lds + MISC_OFF);
    LAS int* tile_e = (LAS int*)(lds + TILEE_OFF);
    LAS int* pstart = (LAS int*)(lds + PSTART_OFF);
    const int tid = threadIdx.x, lane = tid & 63, wave = __builtin_amdgcn_readfirstlane(tid >> 6);
    const int G = gridDim.x; const int bx = blockIdx.x; const int vcu = (G % 8 == 0) ? (bx % 8) * (G / 8) + bx / 8 : bx;
    const int gw = vcu * NWAVES + wave, NGW = G * NWAVES;
    unsigned char* ws = a.ws;
    unsigned* ctl = (unsigned*)(ws + WS_CTL);
    float* WRF = (float*)(ws + WS_WRF);
    int* tk_e = (int*)(ws + WS_TK); int* tk_rank = tk_e + NTOK * 4; float* tk_w = (float*)(tk_rank + NTOK * 4); int* tk_slot = (int*)(tk_w + NTOK * 4); float* rs_tok = (float*)(tk_slot + NTOK * 4);
    float* slot_w = (float*)(ws + WS_SLOT); float* slot_rs = slot_w + MAXSLOT; int* slot_tok = (int*)(slot_rs + MAXSLOT);
    bf16* WIN = (bf16*)(ws + WS_WIN); bf16* WA = (bf16*)(ws + WS_WA); bf16* WB = (bf16*)(ws + WS_WB); bf16* WO = (bf16*)(ws + WS_WO); unsigned char* WGU8 = ws + WS_WGU; unsigned char* WD8 = ws + WS_WD;
    bf16* Hb = (bf16*)(ws + WS_H); bf16* P = (bf16*)(ws + WS_P); bf16* ZA = (bf16*)(ws + WS_ZA); bf16* ZB = (bf16*)(ws + WS_ZB); bf16* Ob = (bf16*)(ws + WS_O);
    bf16* YA = (bf16*)(ws + WS_YA); bf16* MIX = (bf16*)(ws + WS_MIX); float* X1 = (float*)(ws + WS_X1); unsigned char* G8 = ws + WS_XB; unsigned char* ACT8 = ws + WS_ACT; unsigned char* YS8 = ws + WS_YS; unsigned char* H8 = ws + WS_H; unsigned char* WIN8 = ws + WS_WIN8; unsigned char* HQ8 = ws + WS_HQ8;

    for (int u = tid; u < (LDS_BYTES - LDSCTL_OFF) / 4; u += NWAVES * 64) ((LAS unsigned*)(lds + LDSCTL_OFF))[u] = 0u;
    __syncthreads();
    XcdBarrier bar = xcd_barrier_post(ctl + CW_BAR, MISC + 8);
    const int lo = a.ph_lo, hi = a.ph_hi;
#define IN(k) (lo <= (k) && (k) < hi)
#define BOTH(k) (IN(k) && IN((k) + 1))
#define GRID_BAR() xcd_barrier(bar)

    if (IN(0)) {
      for (int rep = 0; rep < REP_P0; ++rep) {
        {
            f32x4 gv[8];
#pragma unroll
            for (int j = 0; j < 8; ++j) gv[j] = *((const f32x4*)a.norm_mix_g + lane + 64 * j);
            for (int m = gw; m < NTOK; m += NGW) {
                const f32x4* xr = (const f32x4*)(a.x + (size_t)m * DM) + lane; f32x4 v[8]; float s = 0.f;
#pragma unroll
                for (int j = 0; j < 8; ++j) { v[j] = xr[64 * j]; s += (v[j].x * v[j].x + v[j].y * v[j].y) + (v[j].z * v[j].z + v[j].w * v[j].w); }
                const float rs = 1.0f / sqrtf(wave_sum(s) * (1.0f / DM) + EPS);
                u32x2* o8 = (u32x2*)(Hb + (size_t)m * DM) + lane;
                unsigned* q8 = (unsigned*)(HQ8 + (size_t)m * DM) + lane;
#pragma unroll
                for (int j = 0; j < 8; ++j) { const float h0 = v[j].x * rs * gv[j].x, h1 = v[j].y * rs * gv[j].y, h2 = v[j].z * rs * gv[j].z, h3 = v[j].w * rs * gv[j].w;
                    u32x2 w; w.x = cvt_pk_bf16(h0, h1); w.y = cvt_pk_bf16(h2, h3); o8[64 * j] = w; q8[64 * j] = pk4_fp8(8.0f * h0, 8.0f * h1, 8.0f * h2, 8.0f * h3); }
            }
        }
#if DBG_STAGE >= 1
        {
            LAS float* scr = (LAS float*)(lds + wave * 16896);
            for (int it = gw; it < 192 * 32; it += NGW) { const int kb = it / 192, db = it % 192; const int d0 = 32 * db; tr_item(a.w_in, DIN, 64 * kb, d0, WIN, DM, d0, scr, lane); }
            for (int it = gw; it < 16 * 128; it += NGW) { const int kb = it / 128, nb = it % 128; const int kr = lane >> 3, c4 = lane & 7; TrItem t; t.ldw = DIN; t.Kb = DM;
                t.W = a.w_in + (size_t)(128 * kb + 16 * kr) * DIN + 6160 + 32 * nb + 4 * c4; t.dst = WIN8 + ((size_t)32 * nb + 4 * c4) * DM + 128 * kb + 16 * kr;
                f32x4 r8[16]; tr8_load(t, r8); tr8_store(t, r8, 512.0f); }
            for (int i = gw * 64 + lane; i < 256 * DM; i += NGW * 64) { const int r = i / DM, k = i % DM; WIN[(size_t)(PC_AL + r) * DM + k] = r < 16 ? (bf16)(cvt_pk_bf16(a.w_in[(size_t)k * DIN + SRC_AL + r], 0.f) & 0xffffu) : (bf16)0; }
#if DBG_STAGE >= 3
            for (int i = gw * 64 + lane; i < 128 * 2 * 64 * 4; i += NGW * 64) { const int ii = i & 3, l = (i >> 2) & 63, t = (i >> 8) & 1, j = i >> 9; const int k = 32 * (j >> 1) + 8 * (l >> 4) + 4 * (j & 1) + ii;
                WRF[i] = a.norm_ffn_g[k] * a.w_router[(size_t)k * NE + 16 * t + (l & 15)]; }
#endif
        }
#endif
      }
        if (BOTH(0)) GRID_BAR();
    }

#if DBG_STAGE >= 1
    if (IN(1)) {
        const int ngemm = (G == 256) ? NGEMM : G;
        if (bx < ngemm) {
            { pg8::Gemm g{Hb, WIN, 2 * DM, nullptr, nullptr, nullptr}; pg8::StaticOrder S; S.init(NTOK / 256, 25, ngemm, bx, 4); pg8::EpiPlainBf16 E{P, NP, 0, 1.0f}; pg8::gemm_phase<false, 1, false>(lds, g, S, E); }
            { pg8::Gemm g{HQ8, WIN8, DM, nullptr, nullptr, nullptr}; pg8::StaticOrder S; S.init(NTOK / 256, 16, ngemm, bx, 4); pg8::EpiPlainFp8 E{G8, 4096, 16.0f / 4096.0f}; pg8::gemm_phase<true, 1, false>(lds, g, S, E); }
        }
#if DBG_STAGE >= 3
        moe_convert_queue(ctl + CW_Q, 0, NQ_MOE - NQ_TAIL - NQ_SCAN, a.w_gate_up, a.w_down, WGU8, WD8, lane);
#endif
        if (BOTH(1)) GRID_BAR();
    }

    if (IN(2)) {
        bf16* KTT = (bf16*)(ws + WS_KTT);
        float* DECB = (float*)(ws + WS_DEC);
        bf16* VTT = (bf16*)(ws + WS_VTT);
        {
            LAS float* AL = (LAS float*)(lds);
            LAS float* CUMG = (LAS float*)(lds + 4096);
            LAS bf16* KL = (LAS bf16*)(lds + 8192);
            LAS unsigned char* VT = lds + 32768;
            for (int item = vcu; item < 1024; item += G) {
                const int b = item >> 7, c = (item >> 2) & 31, h = item & 3;
                const size_t t0 = (size_t)b * SEQ + 64 * c;
                const int dk = tid & 127, sg = tid >> 7;
                float wa2[16];
#pragma unroll
                for (int j = 0; j < 16; ++j) wa2[j] = a.w_a2[j * 512 + h * 128 + dk];
                const float ba = a.b_a[h * 128 + dk];
                if (tid < 128) { const int s = tid >> 1, hf = tid & 1; const u32x4 w = *(const u32x4*)(P + (t0 + s) * NP + PC_AL + 8 * hf);
                    LAS float* d = AL + s * 16 + 8 * hf; d[0] = bf_lo(w.x); d[1] = bf_hi(w.x); d[2] = bf_lo(w.y); d[3] = bf_hi(w.y); d[4] = bf_lo(w.z); d[5] = bf_hi(w.z); d[6] = bf_lo(w.w); d[7] = bf_hi(w.w); }
#pragma unroll
                for (int i = 0; i < 2; ++i) { const int p = tid + 512 * i, row = p >> 4, c16 = p & 15; *(LAS u32x4*)(KL + row * 136 + c16 * 8) = *(const u32x4*)(P + (t0 + row) * NP + PC_K + h * 128 + c16 * 8); }
                if (tid < 256) { const int vb = tid & 31, sb = tid >> 5; u32x4 Lr[8];
#pragma unroll
                  for (int i = 0; i < 8; ++i) Lr[i] = *(const u32x4*)(P + (t0 + 8 * sb + i) * NP + PC_V + h * 256 + 8 * vb);
#pragma unroll
                  for (int j = 0; j < 8; ++j) { const unsigned sel = (j & 1) ? 0x07060302u : 0x05040100u; u32x4 w;
                      w.x = __builtin_amdgcn_perm(Lr[1][j >> 1], Lr[0][j >> 1], sel); w.y = __builtin_amdgcn_perm(Lr[3][j >> 1], Lr[2][j >> 1], sel);
                      w.z = __builtin_amdgcn_perm(Lr[5][j >> 1], Lr[4][j >> 1], sel); w.w = __builtin_amdgcn_perm(Lr[7][j >> 1], Lr[6][j >> 1], sel);
                      *(LAS u32x4*)(VT + (8 * vb + j) * 128 + ((sb ^ (vb & 7)) << 4)) = w; } }
                __syncthreads();
#pragma unroll
                for (int i = 0; i < 4; ++i) { const int q = tid + 512 * i, v = q >> 3, slot = q & 7; *(u32x4*)(VTT + ((size_t)item * 256 + v) * 64 + 8 * (slot ^ ((v >> 3) & 7))) = *(const LAS u32x4*)(VT + q * 16); }
                float cs[16]; float run = 0.f;
#pragma unroll
                for (int i = 0; i < 16; ++i) { const LAS float* al = AL + (16 * sg + i) * 16; float z = ba;
#pragma unroll
                    for (int j = 0; j < 16; ++j) z += al[j] * wa2[j];
                    const float la = -(fmaxf(-z, 0.f) + __logf(1.0f + __expf(-fabsf(z)))) * (1.0f / 16.0f); run += la; cs[i] = run; }
                CUMG[sg * 128 + dk] = run;
                __syncthreads();
                float pre = 0.f, tot = 0.f;
#pragma unroll
                for (int gq = 0; gq < 4; ++gq) { const float v = CUMG[gq * 128 + dk]; tot += v; if (gq < sg) pre += v; }
                if (sg == 0) DECB[item * 128 + dk] = __expf(tot);
                { unsigned pk[8];
#pragma unroll
                  for (int i = 0; i < 8; ++i) { const float f0 = __expf(tot - (pre + cs[2 * i])), f1 = __expf(tot - (pre + cs[2 * i + 1])); pk[i] = cvt_pk_bf16(bf2f(KL[(16 * sg + 2 * i) * 136 + dk]) * f0, bf2f(KL[(16 * sg + 2 * i + 1) * 136 + dk]) * f1); }
                  u32x4 w0, w1; w0.x = pk[0]; w0.y = pk[1]; w0.z = pk[2]; w0.w = pk[3]; w1.x = pk[4]; w1.y = pk[5]; w1.z = pk[6]; w1.w = pk[7];
                  u32x4* dst = (u32x4*)(KTT + ((size_t)item * 128 + dk) * 64 + 16 * sg); dst[0] = w0; dst[1] = w1; }
                __syncthreads();
            }
        }
        GRID_BAR();
        {
            LAS bf16* SB = (LAS bf16*)(lds + 8192);
            LAS float* OT = (LAS float*)(lds + 43008);
            LAS bf16* VTS = (LAS bf16*)(lds + 77824);
            LAS bf16* QS = (LAS bf16*)(lds + 96256);
            const int fr = lane & 15, fq = lane >> 4, mi = wave >> 1, ni = wave & 1;
            struct GlaRegs { bf16x8 af[2]; u32x4 q[2]; u32x4 vt; f32x4 dec; };
            const bool split = (G == 256);
            for (int rep = 0; rep < REP_P2; ++rep)
            if (!split || !(vcu & 1))
            for (int it = split ? (vcu >> 1) : vcu; it < 128; it += split ? 128 : G) {
                const int b = it >> 4, h = (it >> 2) & 3, vs = it & 3;
                f32x4 Sacc[4];
#pragma unroll
                for (int n = 0; n < 4; ++n) Sacc[n] = (f32x4){0.f, 0.f, 0.f, 0.f};
                GlaRegs R[3];
#define GLA_LOAD(X, cc) do { const int item_ = (b * 32 + (cc)) * 4 + h; const size_t t0_ = (size_t)b * SEQ + 64 * (cc); \
                    _Pragma("unroll") for (int ks = 0; ks < 2; ++ks) X.af[ks] = *(const bf16x8*)(KTT + ((size_t)item_ * 128 + 16 * wave + fr) * 64 + 32 * ks + 8 * fq); \
                    X.vt = *(const u32x4*)(VTT + ((size_t)item_ * 256 + vs * 64 + 8 * wave + (lane >> 3)) * 64 + 8 * (lane & 7)); \
                    _Pragma("unroll") for (int i = 0; i < 2; ++i) X.q[i] = *(const u32x4*)(P + (t0_ + 8 * wave + (lane >> 3)) * NP + PC_Q + h * 128 + 8 * (lane & 7) + 64 * i); \
                    X.dec = *(const f32x4*)(DECB + item_ * 128 + 16 * wave + 4 * fq); } while (0)
#define GLA_PUT_VT(X, cc) do { *(LAS u32x4*)(VTS + ((cc) & 1) * (64 * 72) + (8 * wave + (lane >> 3)) * 72 + 8 * (lane & 7)) = X.vt; } while (0)
                GLA_LOAD(R[0], 0); GLA_LOAD(R[1], 1); GLA_LOAD(R[2], 2);
                GLA_PUT_VT(R[0], 0);
                __syncthreads();
                for (int c0 = 0; c0 < 32; c0 += 3) {
#pragma unroll
                    for (int u = 0; u < 3; ++u) {
                        const int c = c0 + u; if (c >= 32) break;
                        const size_t t0 = (size_t)b * SEQ + 64 * c;
                        LAS bf16* SBc = SB + (c & 1) * (64 * 136); LAS bf16* QSc = QS + (c & 1) * (64 * 136); const LAS bf16* VTc = VTS + (c & 1) * (64 * 72);
#pragma unroll
                        for (int n = 0; n < 4; ++n) Sacc[n] *= R[u].dec;
#pragma unroll
                        for (int ks = 0; ks < 2; ++ks)
#pragma unroll
                            for (int n = 0; n < 4; ++n) { const bf16x8 bvf = *(const LAS bf16x8*)(VTc + (16 * n + fr) * 72 + 32 * ks + 8 * fq); Sacc[n] = __builtin_amdgcn_mfma_f32_16x16x32_bf16(R[u].af[ks], bvf, Sacc[n], 0, 0, 0); }
#pragma unroll
                        for (int n = 0; n < 4; ++n) { u32x2 w; w.x = cvt_pk_bf16(Sacc[n][0], Sacc[n][1]); w.y = cvt_pk_bf16(Sacc[n][2], Sacc[n][3]); *(LAS u32x2*)(SBc + (16 * n + fr) * 136 + 16 * wave + 4 * fq) = w; }
#pragma unroll
                        for (int i = 0; i < 2; ++i) *(LAS u32x4*)(QSc + (8 * wave + (lane >> 3)) * 136 + 8 * (lane & 7) + 64 * i) = R[u].q[i];
                        if (c + 1 < 32) GLA_PUT_VT(R[(u + 1) % 3], c + 1);
                        if (c + 3 < 32) GLA_LOAD(R[u], c + 3);
                        __syncthreads();
                        f32x4 oa[2] = {(f32x4){0.f, 0.f, 0.f, 0.f}, (f32x4){0.f, 0.f, 0.f, 0.f}};
#pragma unroll
                        for (int kk = 0; kk < 4; ++kk) { const bf16x8 qf = *(const LAS bf16x8*)(QSc + (16 * mi + fr) * 136 + 32 * kk + 8 * fq);
#pragma unroll
                            for (int n2 = 0; n2 < 2; ++n2) { const bf16x8 sf = *(const LAS bf16x8*)(SBc + (16 * (2 * ni + n2) + fr) * 136 + 32 * kk + 8 * fq); oa[n2] = __builtin_amdgcn_mfma_f32_16x16x32_bf16(qf, sf, oa[n2], 0, 0, 0); } }
                        LAS float* OTc = OT + (c & 1) * (64 * 68);
#pragma unroll
                        for (int n2 = 0; n2 < 2; ++n2)
#pragma unroll
                            for (int j = 0; j < 4; ++j) OTc[(16 * mi + 4 * fq + j) * 68 + 16 * (2 * ni + n2) + fr] = oa[n2][j] * 0.08838834764831845f;
                        if (c > 0) {
                            const LAS f32x4* op = (const LAS f32x4*)(OT + ((c - 1) & 1) * (64 * 68) + (8 * wave + (lane >> 3)) * 68 + 8 * (lane & 7)); const f32x4 ov0 = op[0], ov1 = op[1];
                            u32x4 ow; ow.x = cvt_pk_bf16(ov0[0], ov0[1]); ow.y = cvt_pk_bf16(ov0[2], ov0[3]); ow.z = cvt_pk_bf16(ov1[0], ov1[1]); ow.w = cvt_pk_bf16(ov1[2], ov1[3]);
                            *(u32x4*)(Ob + (t0 - 64 + 8 * wave + (lane >> 3)) * 1024 + h * 256 + vs * 64 + 8 * (lane & 7)) = ow; }
                    }
                }
                __syncthreads();
                { const size_t t0 = (size_t)b * SEQ + 64 * 31; const LAS f32x4* op = (const LAS f32x4*)(OT + (31 & 1) * (64 * 68) + (8 * wave + (lane >> 3)) * 68 + 8 * (lane & 7)); const f32x4 ov0 = op[0], ov1 = op[1];
                  u32x4 ow; ow.x = cvt_pk_bf16(ov0[0], ov0[1]); ow.y = cvt_pk_bf16(ov0[2], ov0[3]); ow.z = cvt_pk_bf16(ov1[0], ov1[1]); ow.w = cvt_pk_bf16(ov1[2], ov1[3]);
                  *(u32x4*)(Ob + (t0 + 8 * wave + (lane >> 3)) * 1024 + h * 256 + vs * 64 + 8 * (lane & 7)) = ow; }
                __syncthreads();
#undef GLA_LOAD
#undef GLA_PUT_VT
            }
            if (!split || (vcu & 1)) { const int hw = split ? (vcu >> 1) * NWAVES + wave : gw, nhw = split ? 128 * NWAVES : NGW;
            for (int wi = hw; wi < 2048; wi += nhw) {
                const int tb = wi >> 1, hf = wi & 1, c0 = 512 * hf + 8 * lane; const int t0 = 16 * tb;
                float w0[8], w1[8], w2[8], cb[8];
#pragma unroll
                for (int j = 0; j < 8; ++j) { w0[j] = a.conv_w[c0 + j]; w1[j] = a.conv_w[1024 + c0 + j]; w2[j] = a.conv_w[2048 + c0 + j]; cb[j] = a.conv_b[c0 + j]; }
                float y2[8], y1[8];
#pragma unroll
                for (int j = 0; j < 8; ++j) { y2[j] = 0.f; y1[j] = 0.f; }
                if ((t0 % SEQ) != 0) {
                    const bf16* pr = P + (size_t)(t0 - 2) * NP + c0; const u32x4 c2 = *(const u32x4*)(pr + PC_UC), x2 = *(const u32x4*)(pr + PC_UX), c1 = *(const u32x4*)(pr + NP + PC_UC), x1 = *(const u32x4*)(pr + NP + PC_UX);
                    y2[0] = bf_lo(c2.x) * bf_lo(x2.x); y2[1] = bf_hi(c2.x) * bf_hi(x2.x); y2[2] = bf_lo(c2.y) * bf_lo(x2.y); y2[3] = bf_hi(c2.y) * bf_hi(x2.y); y2[4] = bf_lo(c2.z) * bf_lo(x2.z); y2[5] = bf_hi(c2.z) * bf_hi(x2.z); y2[6] = bf_lo(c2.w) * bf_lo(x2.w); y2[7] = bf_hi(c2.w) * bf_hi(x2.w);
                    y1[0] = bf_lo(c1.x) * bf_lo(x1.x); y1[1] = bf_hi(c1.x) * bf_hi(x1.x); y1[2] = bf_lo(c1.y) * bf_lo(x1.y); y1[3] = bf_hi(c1.y) * bf_hi(x1.y); y1[4] = bf_lo(c1.z) * bf_lo(x1.z); y1[5] = bf_hi(c1.z) * bf_hi(x1.z); y1[6] = bf_lo(c1.w) * bf_lo(x1.w); y1[7] = bf_hi(c1.w) * bf_hi(x1.w);
                }
#pragma unroll 4
                for (int t = 0; t < 16; ++t) {
                    const bf16* pr = P + (size_t)(t0 + t) * NP + c0; const u32x4 uc = *(const u32x4*)(pr + PC_UC), ub = *(const u32x4*)(pr + PC_UB), ux = *(const u32x4*)(pr + PC_UX);
                    float y0[8], bb[8];
                    y0[0] = bf_lo(uc.x) * bf_lo(ux.x); y0[1] = bf_hi(uc.x) * bf_hi(ux.x); y0[2] = bf_lo(uc.y) * bf_lo(ux.y); y0[3] = bf_hi(uc.y) * bf_hi(ux.y); y0[4] = bf_lo(uc.z) * bf_lo(ux.z); y0[5] = bf_hi(uc.z) * bf_hi(ux.z); y0[6] = bf_lo(uc.w) * bf_lo(ux.w); y0[7] = bf_hi(uc.w) * bf_hi(ux.w);
                    bb[0] = bf_lo(ub.x); bb[1] = bf_hi(ub.x); bb[2] = bf_lo(ub.y); bb[3] = bf_hi(ub.y); bb[4] = bf_lo(ub.z); bb[5] = bf_hi(ub.z); bb[6] = bf_lo(ub.w); bb[7] = bf_hi(ub.w);
                    float z[8];
#pragma unroll
                    for (int j = 0; j < 8; ++j) { z[j] = bb[j] * (cb[j] + w0[j] * y2[j] + w1[j] * y1[j] + w2[j] * y0[j]); y2[j] = y1[j]; y1[j] = y0[j]; }
                    u32x4 w; w.x = cvt_pk_bf16(z[0], z[1]); w.y = cvt_pk_bf16(z[2], z[3]); w.z = cvt_pk_bf16(z[4], z[5]); w.w = cvt_pk_bf16(z[6], z[7]);
                    *(u32x4*)(ZA + (size_t)(t0 + t) * 1024 + c0) = w;
                }
            }
            { LAS float* scr = (LAS float*)(lds + wave * 16896);
              for (int it = hw; it < 16 * 64; it += nhw) { const int kb = it / 64, nb = it % 64; tr_item(a.w_br_a, DM, 64 * kb, 32 * nb, WA, 1024, 32 * nb, scr, lane); }
              for (int it = hw; it < 16 * 64; it += nhw) { const int kb = it / 64, nb = it % 64; tr_item(a.w_br_b, DM, 64 * kb, 32 * nb, WB, 1024, 32 * nb, scr, lane); }
              for (int it = hw; it < 32 * 64; it += nhw) { const int kb = it / 64, nb = it % 64; tr_item(a.w_out, DM, 64 * kb, 32 * nb, WO, DM, 32 * nb, scr, lane); } }
            }
#if DBG_STAGE >= 3
            moe_convert_queue(ctl + CW_Q3, NQ_MOE - NQ_TAIL - NQ_SCAN, NQ_MOE - NQ_TAIL, a.w_gate_up, a.w_down, WGU8, WD8, lane);
#endif
        }
        if (BOTH(2)) GRID_BAR();
    }

    if (IN(3)) {
        {
            f32x4 gg[4];
#pragma unroll
            for (int j = 0; j < 4; ++j) gg[j] = *((const f32x4*)(a.gla_norm_g + 16 * lane) + j);
            for (int m = gw; m < NTOK; m += NGW) {
                const u32x4* op = (const u32x4*)(Ob + (size_t)m * 1024 + 16 * lane); const u32x4 ob0 = op[0], ob1 = op[1]; f32x4 o[4]; float s = 0.f;
                o[0] = (f32x4){bf_lo(ob0.x), bf_hi(ob0.x), bf_lo(ob0.y), bf_hi(ob0.y)}; o[1] = (f32x4){bf_lo(ob0.z), bf_hi(ob0.z), bf_lo(ob0.w), bf_hi(ob0.w)};
                o[2] = (f32x4){bf_lo(ob1.x), bf_hi(ob1.x), bf_lo(ob1.y), bf_hi(ob1.y)}; o[3] = (f32x4){bf_lo(ob1.z), bf_hi(ob1.z), bf_lo(ob1.w), bf_hi(ob1.w)};
#pragma unroll
                for (int j = 0; j < 4; ++j) { s += (o[j].x * o[j].x + o[j].y * o[j].y) + (o[j].z * o[j].z + o[j].w * o[j].w); }
                s += __shfl_xor(s, 1); s += __shfl_xor(s, 2); s += __shfl_xor(s, 4); s += __shfl_xor(s, 8);
                const float rs = 1.0f / sqrtf(s * (1.0f / 256.0f) + EPS);
                const u32x4* rp = (const u32x4*)(P + (size_t)m * NP + PC_R + 16 * lane); const u32x4 r0 = rp[0], r1 = rp[1];
                float rr[16];
                rr[0] = bf_lo(r0.x); rr[1] = bf_hi(r0.x); rr[2] = bf_lo(r0.y); rr[3] = bf_hi(r0.y); rr[4] = bf_lo(r0.z); rr[5] = bf_hi(r0.z); rr[6] = bf_lo(r0.w); rr[7] = bf_hi(r0.w);
                rr[8] = bf_lo(r1.x); rr[9] = bf_hi(r1.x); rr[10] = bf_lo(r1.y); rr[11] = bf_hi(r1.y); rr[12] = bf_lo(r1.z); rr[13] = bf_hi(r1.z); rr[14] = bf_lo(r1.w); rr[15] = bf_hi(r1.w);
                float z[16];
#pragma unroll
                for (int j = 0; j < 4; ++j)
#pragma unroll
                    for (int q = 0; q < 4; ++q) { const float r = rr[4 * j + q]; z[4 * j + q] = o[j][q] * rs * gg[j][q] * (r * fast_sigmoid(r)); }
                u32x4 w0, w1; w0.x = cvt_pk_bf16(z[0], z[1]); w0.y = cvt_pk_bf16(z[2], z[3]); w0.z = cvt_pk_bf16(z[4], z[5]); w0.w = cvt_pk_bf16(z[6], z[7]);
                w1.x = cvt_pk_bf16(z[8], z[9]); w1.y = cvt_pk_bf16(z[10], z[11]); w1.z = cvt_pk_bf16(z[12], z[13]); w1.w = cvt_pk_bf16(z[14], z[15]);
                u32x4* zp = (u32x4*)(ZB + (size_t)m * 1024 + 16 * lane); zp[0] = w0; zp[1] = w1;
            }
        }
        if (BOTH(3)) GRID_BAR();
    }

    if (IN(4)) {
        { pg8::Gemm g{ZA, WA, 2048, ZB, WB, nullptr}; pg8::StaticOrder S; S.init(NTOK / 256, DM / 256, G, bx); pg8::EpiGate2 E{G8, MIX}; pg8::gemm_phase<false, 2, false>(lds, g, S, E); }
        if (BOTH(4)) GRID_BAR();
    }

    if (IN(6)) {
        pg8::Gemm g{MIX, WO, 2 * DM, nullptr, nullptr, nullptr}; pg8::StaticOrder S; S.init(NTOK / 256, DM / 256, G, bx); pg8::EpiResF32 E{a.x, X1};
        pg8::gemm_phase<false, 1, false>(lds, g, S, E);
        if (BOTH(6)) GRID_BAR();
    }
#endif

#if DBG_STAGE >= 3
    if (IN(7)) {
        for (int i = gw * 64 + lane; i < MAXSLOT; i += NGW * 64) slot_tok[i] = 0;
        LAS float* comb = (LAS float*)(lds);
        LAS float* lgb = (LAS float*)(lds + 16384);
        LAS int* hist = (LAS int*)(lds + 40960);
        const int r16 = lane & 15, kq = lane >> 4, gi = wave & 3, kh = wave >> 2;
        for (int rg0 = 0; rg0 < 1024; rg0 += 4 * G) {
            const int rg = rg0 + gi * G + vcu; const bool active = rg < 1024;
            const size_t row = (size_t)(active ? rg : 0) * 16 + r16;
            const f32x4* xp = (const f32x4*)(X1 + row * DM + 8 * kq); const f32x4* gp = (const f32x4*)(a.norm_ffn_g + 8 * kq);
            unsigned* hp = (unsigned*)(H8 + row * DM + 8 * kq);
            f32x4 acc0 = (f32x4){0.f, 0.f, 0.f, 0.f}, acc1 = (f32x4){0.f, 0.f, 0.f, 0.f}; float ssq = 0.f;
            for (int h = 0; h < 2; ++h) {
                { const u32x4* src = (const u32x4*)WRF + (size_t)h * 8192 + tid; LAS u32x4* dst = (LAS u32x4*)lds + tid;
#pragma unroll
                  for (int i = 0; i < 16; ++i) dst[512 * i] = src[512 * i]; }
                __syncthreads();
                if (active) {
                    const LAS f32x4* wl = (const LAS f32x4*)lds + (size_t)(2 * 32 * kh) * 64 + lane;
                    const int jb = 64 * h + 32 * kh;
#pragma unroll 4
                    for (int jj = 0; jj < 32; ++jj) { const int j = jb + jj;
                        const int ko = 8 * (j >> 1) + (j & 1);
                        const f32x4 av = xp[ko], gv = gp[ko], b0 = wl[(2 * jj) * 64], b1 = wl[(2 * jj + 1) * 64];
                        ssq += (av.x * av.x + av.y * av.y) + (av.z * av.z + av.w * av.w);
                        hp[ko] = pk4_fp8(av.x * gv.x * 16.0f, av.y * gv.y * 16.0f, av.z * gv.z * 16.0f, av.w * gv.w * 16.0f);
                        acc0 = __builtin_amdgcn_mfma_f32_16x16x4f32(av.x, b0.x, acc0, 0, 0, 0); acc1 = __builtin_amdgcn_mfma_f32_16x16x4f32(av.x, b1.x, acc1, 0, 0, 0);
                        acc0 = __builtin_amdgcn_mfma_f32_16x16x4f32(av.y, b0.y, acc0, 0, 0, 0); acc1 = __builtin_amdgcn_mfma_f32_16x16x4f32(av.y, b1.y, acc1, 0, 0, 0);
                        acc0 = __builtin_amdgcn_mfma_f32_16x16x4f32(av.z, b0.z, acc0, 0, 0, 0); acc1 = __builtin_amdgcn_mfma_f32_16x16x4f32(av.z, b1.z, acc1, 0, 0, 0);
                        acc0 = __builtin_amdgcn_mfma_f32_16x16x4f32(av.w, b0.w, acc0, 0, 0, 0); acc1 = __builtin_amdgcn_mfma_f32_16x16x4f32(av.w, b1.w, acc1, 0, 0, 0); }
                }
                __syncthreads();
            }
            ssq += __shfl_xor(ssq, 16); ssq += __shfl_xor(ssq, 32);
            if (kh == 1) { LAS float* c = comb + (gi * 64 + lane) * 12;
#pragma unroll
                for (int j = 0; j < 4; ++j) { c[j] = acc0[j]; c[4 + j] = acc1[j]; }
                c[8] = ssq; }
            if (tid < 64) hist[tid] = 0;
            __syncthreads();
            int te[4] = {0, 0, 0, 0}, lr[4] = {0, 0, 0, 0}; float tw[4] = {0.f, 0.f, 0.f, 0.f}; float rs = 0.f;
            if (active && kh == 0) {
                const LAS float* c = comb + (gi * 64 + lane) * 12;
#pragma unroll
                for (int j = 0; j < 4; ++j) { acc0[j] += c[j]; acc1[j] += c[4 + j]; }
                ssq += c[8];
                rs = 1.0f / sqrtf(ssq * (1.0f / DM) + EPS);
                LAS float* lg = lgb + gi * (16 * 36);
#pragma unroll
                for (int j = 0; j < 4; ++j) { lg[(4 * kq + j) * 36 + r16] = acc0[j]; lg[(4 * kq + j) * 36 + 16 + r16] = acc1[j]; }
                LDS_WAIT(); asm volatile("" ::: "memory");
                if (lane < 16) {
                    float l[32];
#pragma unroll
                    for (int n = 0; n < 32; ++n) l[n] = lg[lane * 36 + n] * rs + a.b_router[n];
                    float tv[4];
#pragma unroll
                    for (int k = 0; k < 4; ++k) { float bv = -3.0e38f; int bi = 0;
#pragma unroll
                        for (int n = 0; n < 32; ++n) if (l[n] > bv) { bv = l[n]; bi = n; }
                        tv[k] = bv; te[k] = bi;
#pragma unroll
                        for (int n = 0; n < 32; ++n) l[n] = (n == bi) ? -3.0e38f : l[n]; }
                    float den = 0.f;
#pragma unroll
                    for (int k = 0; k < 4; ++k) { tw[k] = expf(tv[k] - tv[0]); den += tw[k]; }
                    const float inv = 1.0f / den;
#pragma unroll
                    for (int k = 0; k < 4; ++k) { tw[k] *= inv; lr[k] = __hip_atomic_fetch_add(&hist[te[k]], 1, __ATOMIC_RELAXED, __HIP_MEMORY_SCOPE_WORKGROUP); }
                }
            }
            __syncthreads();
            if (tid < 32) { const int c = hist[tid]; hist[32 + tid] = c ? (int)__hip_atomic_fetch_add(ctl + CW_CNT + 64 * tid, (unsigned)c, RLX_AGENT) : 0; }
            __syncthreads();
            if (active && kh == 0 && lane < 16) { const size_t orow = (size_t)rg * 16 + lane;
#pragma unroll
                for (int k = 0; k < 4; ++k) { tk_e[orow * 4 + k] = te[k]; tk_rank[orow * 4 + k] = hist[32 + te[k]] + lr[k]; tk_w[orow * 4 + k] = tw[k]; }
                rs_tok[orow] = rs; }
            __syncthreads();
        }
        if (BOTH(7)) GRID_BAR();
    }

    if (IN(8)) {
        if (tid == 0) { int ps = 0, mt = 0;
            for (int e = 0; e < NE; ++e) { const int c = (int)__hip_atomic_load(ctl + CW_CNT + 64 * e, RLX_AGENT); pstart[e] = ps; const int nt = (c + 255) >> 8; for (int i = 0; i < nt; ++i) tile_e[mt + i] = e; mt += nt; ps += nt << 8; }
            pstart[NE] = ps; MISC[16] = (unsigned)mt; }
        __syncthreads();
        for (int p0 = gw * 64; p0 < NTOK * 4; p0 += NGW * 64) { const int p = p0 + lane;
            const int tok = p >> 2; const int e = tk_e[p], rk = tk_rank[p]; const int slot = pstart[e] + rk;
            { tk_slot[p] = slot; slot_w[slot] = tk_w[p]; slot_rs[slot] = rs_tok[tok]; slot_tok[slot] = tok; }
        }
        if (BOTH(8)) GRID_BAR();
    }

    if (IN(9)) {
        const int MT = (int)MISC[16];
        LAS int* tokt = (LAS int*)(lds + TOKT_OFF);
        const int ng9 = (G == 256) ? NG9 : G;
        if (bx < ng9) {
        pg8::GroupedOrder S; S.init(MT, 16, ng9, bx); S.tile_e = tile_e;
        { pg8::Unit u; for (int i = 0; i < TOKT_UNITS && S.next(i, u); ++i) if (tid < 256) tokt[i * 256 + tid] = slot_tok[u.pm * 256 + tid]; }
        __syncthreads();
        pg8::Gemm g{H8, WGU8, DM, nullptr, nullptr, tokt}; pg8::EpiSwiglu8 E{a.b_gate_up, slot_rs, ACT8};
        pg8::gemm_phase<true, 1, true>(lds, g, S, E);
        }
        moe_convert_queue(ctl + CW_Q2, NQ_MOE - NQ_TAIL, NQ_MOE, a.w_gate_up, a.w_down, WGU8, WD8, lane);
        if (BOTH(9)) GRID_BAR();
    }
    if (IN(10)) {
        const int MT = (int)MISC[16];
        pg8::Gemm g{ACT8, WD8, DFF, nullptr, nullptr, nullptr}; pg8::GroupedOrder S; S.init(MT, 8, G, bx); S.tile_e = tile_e; pg8::EpiDown8 E{a.b_down, slot_w, YS8};
        pg8::gemm_phase<true, 1, false>(lds, g, S, E);
        if (BOTH(10)) GRID_BAR();
    }
#endif

    if (IN(11)) {
        f32x4 gv[8];
#pragma unroll
        for (int j = 0; j < 8; ++j) gv[j] = *((const f32x4*)a.norm_final_g + lane + 64 * j);
        for (int m = gw; m < NTOK; m += NGW) {
#if DBG_STAGE >= 1
            const f32x4* xr = (const f32x4*)(X1 + (size_t)m * DM) + lane;
#else
            const f32x4* xr = (const f32x4*)(a.x + (size_t)m * DM) + lane;
#endif
            f32x4 v[8];
#pragma unroll
            for (int j = 0; j < 8; ++j) v[j] = xr[64 * j];
#if DBG_STAGE >= 3
#pragma unroll
            for (int k = 0; k < 4; ++k) { const int slot = tk_slot[m * 4 + k]; const unsigned* yp = (const unsigned*)(YS8 + (size_t)slot * DM) + lane;
#pragma unroll
                for (int j = 0; j < 8; ++j) { const int w = (int)yp[64 * j]; const f32x2 lo = __builtin_amdgcn_cvt_pk_f32_fp8(w, false), hi = __builtin_amdgcn_cvt_pk_f32_fp8(w, true);
                    v[j].x += lo.x * (1.0f / 64.0f); v[j].y += lo.y * (1.0f / 64.0f); v[j].z += hi.x * (1.0f / 64.0f); v[j].w += hi.y * (1.0f / 64.0f); } }
#endif
            float s = 0.f;
#pragma unroll
            for (int j = 0; j < 8; ++j) s += (v[j].x * v[j].x + v[j].y * v[j].y) + (v[j].z * v[j].z + v[j].w * v[j].w);
            const float rs = 1.0f / sqrtf(wave_sum(s) * (1.0f / DM) + EPS);
            f32x4* o = (f32x4*)(a.out + (size_t)m * DM) + lane;
#pragma unroll
            for (int j = 0; j < 8; ++j) o[64 * j] = v[j] * rs * gv[j];
        }
    }
#undef IN
#undef BOTH
#undef GRID_BAR
}

extern "C" void kernel_launch(void* const* d_in, const int* in_sizes, int n_in, void* d_out, int out_size, void* d_ws, size_t ws_size, hipStream_t stream) {
    static int grid = 0;
    if (grid == 0) {
        if (n_in != 19 || in_sizes[0] != NTOK * DM || out_size != NTOK * DM || ws_size < WS_END) { fprintf(stderr, "kernel_launch: unexpected shapes (n_in %d, in0 %d, out %d, ws %zu); nothing launched\n", n_in, n_in > 0 ? in_sizes[0] : -1, out_size, ws_size); grid = -1; return; }
        int dev = 0, cus = 0, per_cu = 0;
        if (hipGetDevice(&dev) != hipSuccess || hipDeviceGetAttribute(&cus, hipDeviceAttributeMultiprocessorCount, dev) != hipSuccess) { grid = -1; return; }
        if (hipFuncSetAttribute((const void*)mega_fwd, hipFuncAttributeMaxDynamicSharedMemorySize, LDS_BYTES) != hipSuccess) { fprintf(stderr, "kernel_launch: hipFuncSetAttribute failed\n"); grid = -1; return; }
        if (hipOccupancyMaxActiveBlocksPerMultiprocessor(&per_cu, (const void*)mega_fwd, NWAVES * 64, LDS_BYTES) != hipSuccess || per_cu < 1) { fprintf(stderr, "kernel_launch: occupancy query reports %d blocks per CU\n", per_cu); per_cu = 1; }
        (void)hipGetLastError();
        grid = cus;
    }
    if (grid < 0) return;
    if (hipMemsetAsync((char*)d_ws + WS_CTL, 0, CTL_ZERO_BYTES, stream) != hipSuccess) { fprintf(stderr, "kernel_launch: memset failed\n"); return; }
    Args a{};
    a.x = (const float*)d_in[0]; a.norm_mix_g = (const float*)d_in[1]; a.w_in = (const float*)d_in[2]; a.conv_w = (const float*)d_in[3]; a.conv_b = (const float*)d_in[4]; a.w_a2 = (const float*)d_in[5];
    a.b_a = (const float*)d_in[6]; a.gla_norm_g = (const float*)d_in[7]; a.w_br_a = (const float*)d_in[8]; a.w_br_b = (const float*)d_in[9]; a.w_out = (const float*)d_in[10]; a.norm_ffn_g = (const float*)d_in[11];
    a.w_router = (const float*)d_in[12]; a.b_router = (const float*)d_in[13]; a.w_gate_up = (const float*)d_in[14]; a.b_gate_up = (const float*)d_in[15]; a.w_down = (const float*)d_in[16]; a.b_down = (const float*)d_in[17];
    a.norm_final_g = (const float*)d_in[18]; a.out = (float*)d_out; a.ws = (unsigned char*)d_ws; a.ph_lo = 0; a.ph_hi = 12;
    hipLaunchKernelGGL(mega_fwd, dim3(grid), dim3(NWAVES * 64), LDS_BYTES, stream, a);
    const hipError_t le = hipPeekAtLastError();
    if (le != hipSuccess) fprintf(stderr, "kernel_launch: launch failed: %s\n", hipGetErrorName(le));
}
```

```cpp
#include <hip/hip_runtime.h>
#include <cstdio>
#include <cstdint>

#ifndef DBG_STAGE
#define DBG_STAGE 3
#endif

#ifndef REP_P0
#define REP_P0 1
#endif
#ifndef REP_P2
#define REP_P2 1
#endif
#define LAS __attribute__((address_space(3)))
#define GAS __attribute__((address_space(1)))
typedef unsigned short bf16;
typedef short bf16x8 __attribute__((ext_vector_type(8)));
typedef float f32x4 __attribute__((ext_vector_type(4)));
typedef float f32x2 __attribute__((ext_vector_type(2)));
typedef unsigned u32x4 __attribute__((ext_vector_type(4)));
typedef unsigned u32x2 __attribute__((ext_vector_type(2)));

constexpr int NTOK = 16384, DM = 2048, SEQ = 2048, NBATCH = 8;
constexpr int NP = 10496;
constexpr int PC_UC = 0, PC_UB = 1024, PC_UX = 2048, PC_Q = 3072, PC_K = 3584, PC_V = 4096, PC_R = 5120, PC_AL = 6144, PC_GA = 6400, PC_GB = 8448;
constexpr int SRC_AL = 6144;
constexpr int DIN = 10256;
constexpr int NE = 32, TOPK = 4, DFF = 2048;
constexpr int MAXSLOT = NTOK * TOPK + NE * 256;
constexpr int MAXMT = MAXSLOT / 256;
constexpr float EPS = 1e-6f;

constexpr size_t MiB = 1u << 20;
constexpr size_t WS_CTL = 0, CTL_ZERO_BYTES = 1 * MiB;
constexpr size_t WS_WRF = 1 * MiB;
constexpr size_t WS_TK = 2 * MiB;
constexpr size_t WS_SLOT = 4 * MiB;
constexpr size_t WS_WIN = 8 * MiB;
constexpr size_t WS_WA = 50 * MiB;
constexpr size_t WS_WB = 54 * MiB;
constexpr size_t WS_WO = 58 * MiB;
constexpr size_t WS_WGU = 66 * MiB;
constexpr size_t WS_WD = 578 * MiB;
constexpr size_t WS_H = 834 * MiB;
constexpr size_t WS_P = 898 * MiB;
constexpr size_t WS_ZA = 1226 * MiB;
constexpr size_t WS_ZB = 1258 * MiB;
constexpr size_t WS_O = 1290 * MiB;
constexpr size_t WS_YA = 1354 * MiB;
constexpr size_t WS_MIX = 1418 * MiB;
constexpr size_t WS_X1 = 1482 * MiB;
constexpr size_t WS_XB = 1610 * MiB;
constexpr size_t WS_ACT = 1898 * MiB;
constexpr size_t WS_YS = 2186 * MiB;
constexpr size_t WS_KTT = 2474 * MiB;
constexpr size_t WS_DEC = 2490 * MiB;
constexpr size_t WS_VTT = 2492 * MiB;
constexpr size_t WS_WIN8 = 2524 * MiB;
constexpr size_t WS_HQ8 = 2532 * MiB;
constexpr size_t WS_END = 2564 * MiB;
constexpr int CW_BAR = 4096;
constexpr int CW_Q3 = 8320;
constexpr int CW_Q2 = 8256;
constexpr int CW_Q = 8192;
constexpr int NGEMM = 208, QBATCH = 8;
constexpr int CW_CNT = 16384;

constexpr int RING_BYTES = 131072;
constexpr int TOKT_OFF = 131072, TOKT_UNITS = 30;
constexpr int LDSCTL_OFF = 161792;
constexpr int MISC_OFF = LDSCTL_OFF;
constexpr int TILEE_OFF = LDSCTL_OFF + 128;
constexpr int PSTART_OFF = TILEE_OFF + 4 * 320;
constexpr int LDS_BYTES = 163840;
constexpr int NWAVES = 8;

#define LDS_WAIT() asm volatile("s_waitcnt lgkmcnt(0)" ::: "memory")
#define VM_WAIT() asm volatile("s_waitcnt vmcnt(0)" ::: "memory")
#define RLX_AGENT __ATOMIC_RELAXED, __HIP_MEMORY_SCOPE_AGENT

typedef __bf16 bf16x2_t __attribute__((ext_vector_type(2)));
__device__ __forceinline__ unsigned cvt_pk_bf16(float lo, float hi) { f32x2 v = {lo, hi}; bf16x2_t b = __builtin_convertvector(v, bf16x2_t); return __builtin_bit_cast(unsigned, b); }
__device__ __forceinline__ float clamp448(float x) { return __builtin_amdgcn_fmed3f(x, -448.0f, 448.0f); }
__device__ __forceinline__ unsigned pk4_fp8(float a, float b, float c, float d) {
    int w = 0; w = __builtin_amdgcn_cvt_pk_fp8_f32(clamp448(a), clamp448(b), w, false); w = __builtin_amdgcn_cvt_pk_fp8_f32(clamp448(c), clamp448(d), w, true); return (unsigned)w; }
__device__ __forceinline__ float bf_lo(unsigned w) { return __uint_as_float(w << 16); }
__device__ __forceinline__ float bf_hi(unsigned w) { return __uint_as_float(w & 0xffff0000u); }
__device__ __forceinline__ float bf2f(bf16 b) { return __uint_as_float(((unsigned)b) << 16); }
__device__ __forceinline__ float fast_sigmoid(float x) { return __builtin_amdgcn_rcpf(1.0f + __builtin_amdgcn_exp2f(-1.44269504089f * x)); }
__device__ __forceinline__ float wave_sum(float v) {
#pragma unroll
    for (int o = 1; o < 64; o <<= 1) v += __shfl_xor(v, o);
    return v;
}

namespace pg8 {
constexpr int BM = 256, BK = 64, HALF = 128, HTB = HALF * BK * 2, STAGE_BYTES = 8 * HTB, NXCD = 8, WGM = 8;
__host__ __device__ __forceinline__ int lds_byte(int r, int c) { const int st = (r >> 4) * 2 + (c >> 5), rr = r & 15, cc = c & 31, ob = rr * 64 + cc * 2; return st * 1024 + (ob ^ (((ob >> 9) & 1) << 5)); }
__host__ __device__ __forceinline__ void stage_rc(int b, int& R, int& C) { const int st = b / 1024, sb = b % 1024, swz = sb ^ (((sb >> 9) & 1) << 5); R = (st >> 1) * 16 + swz / 64; C = (st & 1) * 32 + (swz % 64) / 2; }
__host__ __device__ __forceinline__ int perm32(int rho) { const int n = rho >> 4, i = rho & 15; return 8 * (i >> 2) + 4 * n + (i & 3); }

struct Unit { int pm, pn, pb, e; };
struct Gemm { const void* A; const void* Bt; int ldb; const void* A2; const void* Bt2; const LAS int* tokt; };

struct StaticOrder {
    int nM, nN, nwg, G, c, wgm;
    __device__ void init(int nM_, int nN_, int G_, int c_, int wgm_ = WGM) { nM = nM_; nN = nN_; nwg = nM * nN; G = G_; c = c_; wgm = wgm_; }
    __device__ __forceinline__ bool tile(int i, int& pm, int& pn) const {
        const long L = (long)i * G + c; if (L >= nwg) return false;
        int wgid = (int)L; { const int q = nwg / NXCD, r = nwg % NXCD, xcd = wgid % NXCD, off = wgid / NXCD; wgid = (xcd < r ? xcd * (q + 1) : r * (q + 1) + (xcd - r) * q) + off; }
        const int nig = wgm * nN, gid = wgid / nig, fm = gid * wgm, gsz = (nM - fm) < wgm ? (nM - fm) : wgm;
        pm = fm + ((wgid % nig) % gsz); pn = (wgid % nig) / gsz; return true;
    }
    __device__ __forceinline__ bool next(int i, Unit& u) const { if (!tile(i, u.pm, u.pn)) return false; u.pb = u.pn; u.e = 0; return true; }
};
struct GroupedOrder : StaticOrder {
    const LAS int* tile_e;
    __device__ __forceinline__ bool next(int i, Unit& u) const { if (!tile(i, u.pm, u.pn)) return false; u.e = tile_e[u.pm]; u.pb = u.e * nN + u.pn; return true; }
};

struct EpiPlainBf16 {
    static constexpr bool HASPRE = false; struct Pre {};
    static constexpr bool PERM = true;
    bf16* O; int ldc; int colbase; float scale;
    __device__ __forceinline__ void operator()(const f32x4 (&acc)[2][2][4][2], const Unit& u, int wr, int wc, int fr, int fq) const {
        const int row0 = u.pm * BM + wr * 64 + fr, col0 = colbase + u.pn * BM + wc * 32 + 8 * fq;
#pragma unroll
        for (int ai = 0; ai < 2; ++ai)
#pragma unroll
            for (int m = 0; m < 4; ++m) { bf16* rowp = O + (size_t)(row0 + ai * HALF + m * 16) * ldc + col0;
#pragma unroll
                for (int bj = 0; bj < 2; ++bj) { const f32x4 v0 = acc[ai][bj][m][0] * scale, v1 = acc[ai][bj][m][1] * scale;
                    u32x4 w; w.x = cvt_pk_bf16(v0[0], v0[1]); w.y = cvt_pk_bf16(v0[2], v0[3]); w.z = cvt_pk_bf16(v1[0], v1[1]); w.w = cvt_pk_bf16(v1[2], v1[3]);
                    *(u32x4*)(rowp + bj * HALF) = w; } }
    }
};
struct EpiPlainFp8 {
    static constexpr bool HASPRE = false; struct Pre {};
    static constexpr bool PERM = true;
    unsigned char* O8; int ldc; float scale;
    __device__ __forceinline__ void operator()(const f32x4 (&acc)[2][2][4][2], const Unit& u, int wr, int wc, int fr, int fq) const {
        const int row0 = u.pm * BM + wr * 64 + fr, col0 = u.pn * BM + wc * 32 + 8 * fq;
#pragma unroll
        for (int ai = 0; ai < 2; ++ai)
#pragma unroll
            for (int m = 0; m < 4; ++m) { unsigned char* rowp = O8 + (size_t)(row0 + ai * HALF + m * 16) * ldc + col0;
#pragma unroll
                for (int bj = 0; bj < 2; ++bj) { const f32x4 v0 = acc[ai][bj][m][0] * scale, v1 = acc[ai][bj][m][1] * scale;
                    u32x2 w; w.x = pk4_fp8(v0[0], v0[1], v0[2], v0[3]); w.y = pk4_fp8(v1[0], v1[1], v1[2], v1[3]);
                    *(u32x2*)(rowp + bj * HALF) = w; } }
    }
};
struct EpiGate2 {
    static constexpr bool HASPRE = false; struct Pre {};
    static constexpr bool PERM = true;
    const unsigned char* G8; bf16* O;
    __device__ __forceinline__ void mid(f32x4 (&acc)[2][2][4][2], const Unit& u, int wr, int wc, int fr, int fq) const {
        int opq = 0; asm volatile("" : "+v"(opq));
        const int row0 = u.pm * BM + wr * 64 + fr + opq, col0 = u.pn * BM + wc * 32 + 8 * fq;
        u32x2 ga[2][2], gb[2][2];
#define EG2_LOAD(buf, g_) do { const size_t row_ = (size_t)(row0 + ((g_) >> 2) * HALF + ((g_) & 3) * 16); _Pragma("unroll") for (int bj = 0; bj < 2; ++bj) { const int col_ = col0 + bj * HALF; \
            ga[buf][bj] = *(const u32x2*)(G8 + row_ * 4096 + col_); gb[buf][bj] = *(const u32x2*)(G8 + row_ * 4096 + 2048 + col_); } } while (0)
        EG2_LOAD(0, 0);
#pragma unroll
        for (int g = 0; g < 8; ++g) { const int ai = g >> 2, m = g & 3, cb = g & 1;
            if (g + 1 < 8) { if (cb) EG2_LOAD(0, g + 1); else EG2_LOAD(1, g + 1); }
            asm volatile("" ::: "memory");
#pragma unroll
            for (int bj = 0; bj < 2; ++bj) {
#pragma unroll
                for (int q = 0; q < 4; ++q) {
                    const int gaw_ = (int)(q < 2 ? ga[cb][bj].x : ga[cb][bj].y), gbw_ = (int)(q < 2 ? gb[cb][bj].x : gb[cb][bj].y);
                    const f32x2 a2 = (q & 1) ? __builtin_amdgcn_cvt_pk_f32_fp8(gaw_, true) : __builtin_amdgcn_cvt_pk_f32_fp8(gaw_, false), b2 = (q & 1) ? __builtin_amdgcn_cvt_pk_f32_fp8(gbw_, true) : __builtin_amdgcn_cvt_pk_f32_fp8(gbw_, false);
                    const float r0 = (1.0f + __builtin_amdgcn_exp2f(-0.0901684400556f * b2.x)) * __builtin_amdgcn_rcpf(1.0f + __builtin_amdgcn_exp2f(-0.0901684400556f * a2.x));
                    const float r1 = (1.0f + __builtin_amdgcn_exp2f(-0.0901684400556f * b2.y)) * __builtin_amdgcn_rcpf(1.0f + __builtin_amdgcn_exp2f(-0.0901684400556f * a2.y));
                    acc[ai][bj][m][q >> 1][2 * (q & 1)] *= r0; acc[ai][bj][m][q >> 1][2 * (q & 1) + 1] *= r1; } } }
#undef EG2_LOAD
    }
    __device__ __forceinline__ void operator()(const f32x4 (&acc)[2][2][4][2], const Unit& u, int wr, int wc, int fr, int fq) const {
        const int row0 = u.pm * BM + wr * 64 + fr, col0 = u.pn * BM + wc * 32 + 8 * fq;
#pragma unroll
        for (int ai = 0; ai < 2; ++ai)
#pragma unroll
            for (int m = 0; m < 4; ++m) { const size_t row = (size_t)(row0 + ai * HALF + m * 16);
#pragma unroll
                for (int bj = 0; bj < 2; ++bj) { const int col = col0 + bj * HALF;
                    const u32x2 g = *(const u32x2*)(G8 + row * 4096 + 2048 + col);
                    f32x4 v0 = acc[ai][bj][m][0], v1 = acc[ai][bj][m][1];
                    { const f32x2 g0 = __builtin_amdgcn_cvt_pk_f32_fp8((int)g.x, false), g1 = __builtin_amdgcn_cvt_pk_f32_fp8((int)g.x, true), g2 = __builtin_amdgcn_cvt_pk_f32_fp8((int)g.y, false), g3 = __builtin_amdgcn_cvt_pk_f32_fp8((int)g.y, true);
                      v0[0] *= fast_sigmoid(0.0625f * g0.x); v0[1] *= fast_sigmoid(0.0625f * g0.y); v0[2] *= fast_sigmoid(0.0625f * g1.x); v0[3] *= fast_sigmoid(0.0625f * g1.y);
                      v1[0] *= fast_sigmoid(0.0625f * g2.x); v1[1] *= fast_sigmoid(0.0625f * g2.y); v1[2] *= fast_sigmoid(0.0625f * g3.x); v1[3] *= fast_sigmoid(0.0625f * g3.y); }
                    u32x4 w; w.x = cvt_pk_bf16(v0[0], v0[1]); w.y = cvt_pk_bf16(v0[2], v0[3]); w.z = cvt_pk_bf16(v1[0], v1[1]); w.w = cvt_pk_bf16(v1[2], v1[3]);
                    *(u32x4*)(O + row * DM + col) = w; } }
    }
};
struct EpiResF32 {
    static constexpr bool HASPRE = false; struct Pre {};
    static constexpr bool PERM = false;
    const float* base; float* C;
    __device__ __forceinline__ void operator()(const f32x4 (&acc)[2][2][4][2], const Unit& u, int wr, int wc, int fr, int fq) const {
        const int row0 = u.pm * BM + wr * 64 + fr, col0 = u.pn * BM + wc * 32 + 4 * fq;
#pragma unroll
        for (int ai = 0; ai < 2; ++ai)
#pragma unroll
            for (int m = 0; m < 4; ++m) { const size_t off = (size_t)(row0 + ai * HALF + m * 16) * DM + col0;
#pragma unroll
                for (int bj = 0; bj < 2; ++bj)
#pragma unroll
                    for (int n = 0; n < 2; ++n) { const f32x4 b = *(const f32x4*)(base + off + bj * HALF + n * 16); *(f32x4*)(C + off + bj * HALF + n * 16) = acc[ai][bj][m][n] + b; } }
    }
};
struct EpiSwiglu8 {
    static constexpr bool PERM = true;
    static constexpr bool HASPRE = true;
    struct Pre { f32x4 bg0, bg1, bu0, bu1; float rs[4]; };
    const float* bgu; const float* slot_rs; unsigned char* ACT8;
    __device__ __forceinline__ void prefetch(Pre& p, const Unit& u, int wr, int wc, int fr, int fq) const {
        const int row0 = u.pm * BM + wr * 64 + fr, cl = u.pn * HALF + wc * 32 + 8 * fq;
        const float* bg = bgu + (size_t)u.e * (2 * DFF) + cl;
        p.bg0 = *(const f32x4*)(bg); p.bg1 = *(const f32x4*)(bg + 4); p.bu0 = *(const f32x4*)(bg + DFF) * 4.0f + 4.0f; p.bu1 = *(const f32x4*)(bg + DFF + 4) * 4.0f + 4.0f;
#pragma unroll
        for (int m = 0; m < 4; ++m) p.rs[m] = slot_rs[(size_t)(row0 + m * 16)];
    }
    __device__ __forceinline__ void operator()(const f32x4 (&acc)[2][2][4][2], const Unit& u, int wr, int wc, int fr, int fq, const Pre& p) const {
        const int row0 = u.pm * BM + wr * 64 + fr, cl = u.pn * HALF + wc * 32 + 8 * fq;
        const f32x4 bg0 = p.bg0, bg1 = p.bg1, bu0 = p.bu0, bu1 = p.bu1;
        float rs1[4];
#pragma unroll
        for (int m = 0; m < 4; ++m) rs1[m] = slot_rs[(size_t)(row0 + HALF + m * 16)];
#pragma unroll
        for (int ai = 0; ai < 2; ++ai)
#pragma unroll
            for (int m = 0; m < 4; ++m) { const size_t row = (size_t)(row0 + ai * HALF + m * 16); const float rs = (ai ? rs1[m] : p.rs[m]) * (1.0f / 16384.0f);
                const float rs4 = 4.0f * rs;
                const f32x4 g0 = acc[ai][0][m][0] * rs + bg0, g1 = acc[ai][0][m][1] * rs + bg1, u0 = acc[ai][1][m][0] * rs4 + bu0, u1 = acc[ai][1][m][1] * rs4 + bu1;
                float o[8];
#pragma unroll
                for (int j = 0; j < 4; ++j) {
                    float g = fminf(g0[j], 7.0f), up = __builtin_amdgcn_fmed3f(u0[j], -24.0f, 32.0f);
                    o[j] = up * (g * __builtin_amdgcn_rcpf(1.0f + __builtin_amdgcn_exp2f(-2.45546696f * g)));
                    g = fminf(g1[j], 7.0f); up = __builtin_amdgcn_fmed3f(u1[j], -24.0f, 32.0f);
                    o[4 + j] = up * (g * __builtin_amdgcn_rcpf(1.0f + __builtin_amdgcn_exp2f(-2.45546696f * g))); }
                u32x2 w; { int t_ = 0; t_ = __builtin_amdgcn_cvt_pk_fp8_f32(o[0], o[1], t_, false); t_ = __builtin_amdgcn_cvt_pk_fp8_f32(o[2], o[3], t_, true); w.x = (unsigned)t_;
                           t_ = 0; t_ = __builtin_amdgcn_cvt_pk_fp8_f32(o[4], o[5], t_, false); t_ = __builtin_amdgcn_cvt_pk_fp8_f32(o[6], o[7], t_, true); w.y = (unsigned)t_; }
                *(u32x2*)(ACT8 + row * DFF + cl) = w; }
    }
};
struct EpiDown8 {
    static constexpr bool PERM = true;
    static constexpr bool HASPRE = true;
    struct Pre { f32x4 bv[2][2]; float sw[8]; };
    const float* bd; const float* slot_w; unsigned char* YS8;
    __device__ __forceinline__ void prefetch(Pre& p, const Unit& u, int wr, int wc, int fr, int fq) const {
        const int row0 = u.pm * BM + wr * 64 + fr, col0 = u.pn * BM + wc * 32 + 8 * fq;
        const float* bp = bd + (size_t)u.e * DM + col0;
#pragma unroll
        for (int bj = 0; bj < 2; ++bj)
#pragma unroll
            for (int n = 0; n < 2; ++n) p.bv[bj][n] = *(const f32x4*)(bp + bj * HALF + 4 * n);
#pragma unroll
        for (int ai = 0; ai < 2; ++ai)
#pragma unroll
            for (int m = 0; m < 4; ++m) p.sw[ai * 4 + m] = slot_w[(size_t)(row0 + ai * HALF + m * 16)];
    }
    __device__ __forceinline__ void operator()(const f32x4 (&acc)[2][2][4][2], const Unit& u, int wr, int wc, int fr, int fq, const Pre& p) const {
        const int row0 = u.pm * BM + wr * 64 + fr, col0 = u.pn * BM + wc * 32 + 8 * fq;
#pragma unroll
        for (int ai = 0; ai < 2; ++ai)
#pragma unroll
            for (int m = 0; m < 4; ++m) { const size_t row = (size_t)(row0 + ai * HALF + m * 16); const float sw = p.sw[ai * 4 + m] * 64.0f;
#pragma unroll
                for (int bj = 0; bj < 2; ++bj) { const f32x4 v0 = (acc[ai][bj][m][0] * (1.0f / 4096.0f) + p.bv[bj][0]) * sw, v1 = (acc[ai][bj][m][1] * (1.0f / 4096.0f) + p.bv[bj][1]) * sw;
                    u32x2 w; w.x = pk4_fp8(v0[0], v0[1], v0[2], v0[3]); w.y = pk4_fp8(v1[0], v1[1], v1[2], v1[3]);
                    *(u32x2*)(YS8 + row * DM + col0 + bj * HALF) = w; } }
    }
};

typedef int v4i_t __attribute__((ext_vector_type(4)));
typedef int v8i_t __attribute__((ext_vector_type(8)));
template <bool F8, int NSEG, bool GATHER, class Epi, class Sched>
__device__ __forceinline__ void gemm_phase(LAS unsigned char* lds, const Gemm g, const Sched& S, const Epi& E) {
    const int tid = threadIdx.x, wid = __builtin_amdgcn_readfirstlane(tid >> 6), lane = tid & 63, wr = wid >> 2, wc = wid & 3, fr = lane & 15, fq = lane >> 4;
    const int ldb = g.ldb, nt = ldb / 128;
    unsigned voffA[2], voffB[2];
#pragma unroll
    for (int i = 0; i < 2; ++i) { int R, C; stage_rc(tid * 16 + i * 8192, R, C); const int Rb = Epi::PERM ? ((R & ~31) + perm32(R & 31)) : R;
        voffA[i] = (unsigned)(R * ldb + C * 2); voffB[i] = (unsigned)(Rb * ldb + C * 2); }
    const size_t kstep = (size_t)128;
    const size_t hstep = (size_t)HALF * ldb;
    const size_t tstep = 2 * hstep;
    const unsigned ldsw = (unsigned)wid * 1024u;
    const int aoff = lds_byte(wr * 64 + fr, fq * 8), boff = lds_byte(wc * 32 + fr, fq * 8);
#define PG8_SA(b, h) (((b) * 2 + (h)) * HTB)
#define PG8_SB(b, h) ((4 + (b) * 2 + (h)) * HTB)
#define PG8_STAGE(bufoff, gbase, voff) do { _Pragma("unroll") for (int _i = 0; _i < 2; ++_i) \
        __builtin_amdgcn_global_load_lds((const unsigned*)((const char*)(gbase) + (voff)[_i]), (LAS unsigned*)(lds + (bufoff) + ldsw + _i * 8192), 16, 0, 0); } while (0)
#define PG8_STAGE_A(bufoff, gbase, h, nx) do { if constexpr (GATHER) { unsigned vv_[2]; vv_[0] = (nx) ? offAn[h][0] : offA[h][0]; vv_[1] = (nx) ? offAn[h][1] : offA[h][1]; PG8_STAGE(bufoff, gbase, vv_); } \
        else { PG8_STAGE(bufoff, (gbase) + ((h) ? hstep : (size_t)0), voffA); } } while (0)
#define PG8_LDA(dst, b, h) do { _Pragma("unroll") for (int m = 0; m < 4; ++m) _Pragma("unroll") for (int k = 0; k < 2; ++k) dst[m][k] = *(const LAS bf16x8*)(lds + PG8_SA(b, h) + aoff + m * 2048 + k * 1024); } while (0)
#define PG8_LDB(dst, b, h) do { _Pragma("unroll") for (int n = 0; n < 2; ++n) _Pragma("unroll") for (int k = 0; k < 2; ++k) dst[n][k] = *(const LAS bf16x8*)(lds + PG8_SB(b, h) + boff + n * 2048 + k * 1024); } while (0)
#define PG8_MMA(ai, bj, At, Bt) do { __builtin_amdgcn_s_setprio(1); if constexpr (F8) { asm volatile("s_nop 1"); _Pragma("unroll") for (int m = 0; m < 4; ++m) _Pragma("unroll") for (int n = 0; n < 2; ++n) \
        { const v8i_t b8_ = __builtin_shufflevector(__builtin_bit_cast(v4i_t, Bt[n][0]), __builtin_bit_cast(v4i_t, Bt[n][1]), 0, 1, 2, 3, 4, 5, 6, 7); \
          const v8i_t a8_ = __builtin_shufflevector(__builtin_bit_cast(v4i_t, At[m][0]), __builtin_bit_cast(v4i_t, At[m][1]), 0, 1, 2, 3, 4, 5, 6, 7); \
          asm volatile("v_mfma_scale_f32_16x16x128_f8f6f4 %0, %1, %2, %0, %3, %3 op_sel_hi:[0,0,0]" : "+v"(acc[ai][bj][m][n]) : "v"(b8_), "v"(a8_), "v"(sc8)); } } \
      else { _Pragma("unroll") for (int m = 0; m < 4; ++m) _Pragma("unroll") for (int n = 0; n < 2; ++n) _Pragma("unroll") for (int k = 0; k < 2; ++k) \
        acc[ai][bj][m][n] = __builtin_amdgcn_mfma_f32_16x16x32_bf16(Bt[n][k], At[m][k], acc[ai][bj][m][n], 0, 0, 0); } __builtin_amdgcn_s_setprio(0); } while (0)
#define PG8_WAIT_V(n) asm volatile("s_waitcnt vmcnt(" #n ")" ::: "memory")
#define PG8_WAIT_L(n) asm volatile("s_waitcnt lgkmcnt(" #n ")" ::: "memory")
#define PG8_BAR __builtin_amdgcn_s_barrier()
#define PG8_SCHED __builtin_amdgcn_sched_barrier(0)
    Unit cur, nxt; int ui = 0;
    if (!S.next(0, cur)) return;
    typename Epi::Pre pre; if constexpr (Epi::HASPRE) E.prefetch(pre, cur, wr, wc, fr, fq);
    int sc8 = 0; if constexpr (F8) { asm volatile("v_mov_b32 %0, 0x7f7f7f7f\n\ts_nop 1" : "=v"(sc8)); }
    f32x4 acc[2][2][4][2];
#pragma unroll
    for (int a = 0; a < 2; ++a)
#pragma unroll
        for (int b = 0; b < 2; ++b)
#pragma unroll
            for (int m = 0; m < 4; ++m)
#pragma unroll
                for (int n = 0; n < 2; ++n) acc[a][b][m][n] = (f32x4){0.f, 0.f, 0.f, 0.f};
    bf16x8 At[4][2], B0[2][2], B1[2][2];
    const char* cA = (const char*)g.A + (GATHER ? (size_t)0 : (size_t)cur.pm * tstep); const char* cB = (const char*)g.Bt + (size_t)cur.pb * tstep;
    constexpr bool DUAL = (NSEG == 2);
    unsigned offA[2][2] = {{0u, 0u}, {0u, 0u}}, offAn[2][2] = {{0u, 0u}, {0u, 0u}};
    int gR0 = 0, gC2 = 0; if constexpr (GATHER) { int R, C; stage_rc(tid * 16, R, C); gR0 = R; gC2 = C * 2;
#pragma unroll
        for (int h = 0; h < 2; ++h)
#pragma unroll
            for (int i = 0; i < 2; ++i) offA[h][i] = (unsigned)(g.tokt[128 * h + gR0 + 64 * i] * ldb + gC2);
        asm volatile("s_waitcnt lgkmcnt(0)" ::: "memory"); }
    PG8_STAGE(PG8_SB(0, 0), cB, voffB); PG8_STAGE_A(PG8_SA(0, 0), cA, 0, false); PG8_STAGE(PG8_SB(0, 1), cB + hstep, voffB); PG8_STAGE_A(PG8_SA(0, 1), cA, 1, false);
    if (wr == 1) PG8_BAR;
    PG8_WAIT_V(4); PG8_BAR;
    PG8_STAGE(PG8_SB(1, 0), cB + kstep, voffB); PG8_STAGE_A(PG8_SA(1, 0), cA + kstep, 0, false); PG8_STAGE(PG8_SB(1, 1), cB + hstep + kstep, voffB);
    PG8_WAIT_V(6); PG8_BAR;
    for (;;) {
        const bool has_next = S.next(ui + 1, nxt);
        if constexpr (GATHER) { if (has_next) {
#pragma unroll
            for (int h = 0; h < 2; ++h)
#pragma unroll
                for (int i = 0; i < 2; ++i) offAn[h][i] = (unsigned)(g.tokt[(ui + 1) * 256 + 128 * h + gR0 + 64 * i] * ldb + gC2); }
            asm volatile("s_waitcnt lgkmcnt(0)" ::: "memory"); }
        const char* nA = (has_next && !GATHER) ? (const char*)g.A + (size_t)nxt.pm * tstep : cA; const char* nB = has_next ? (const char*)g.Bt + (size_t)nxt.pb * tstep : cB;
        for (int t = 0; t < NSEG * nt; t += 2) {
            const bool last = (t == NSEG * nt - 2); const bool nx = last && has_next;
            const bool seg2 = DUAL && (t >= nt), cross = DUAL && (t == nt - 2);
            const char* sA_ = seg2 ? (const char*)g.A2 + (size_t)cur.pm * tstep - (size_t)nt * kstep : cA; const char* sB_ = seg2 ? (const char*)g.Bt2 + (size_t)cur.pb * tstep - (size_t)nt * kstep : cB;
            if constexpr (DUAL) { if (t == nt) E.mid(acc, cur, wr, wc, fr, fq); }
            const char* a1 = sA_ + (size_t)(t + 1) * kstep;
            const char* a2 = last ? nA : cross ? (const char*)g.A2 + (size_t)cur.pm * tstep : sA_ + (size_t)(t + 2) * kstep; const char* b2 = last ? nB : cross ? (const char*)g.Bt2 + (size_t)cur.pb * tstep : sB_ + (size_t)(t + 2) * kstep;
            const char* a3 = a2 + kstep; const char* b3 = b2 + kstep;
            PG8_LDB(B0, 0, 0); PG8_SCHED; PG8_LDA(At, 0, 0); PG8_STAGE_A(PG8_SA(1, 1), a1, 1, false);
            PG8_WAIT_L(8); PG8_BAR; PG8_WAIT_L(0); PG8_MMA(0, 0, At, B0); PG8_BAR; PG8_SCHED;
            PG8_LDB(B1, 0, 1); PG8_STAGE(PG8_SB(0, 0), b2, voffB);
            PG8_BAR; PG8_WAIT_L(0); PG8_MMA(0, 1, At, B1); PG8_BAR;
            PG8_LDA(At, 0, 1); PG8_STAGE_A(PG8_SA(0, 0), a2, 0, nx);
            PG8_BAR; PG8_WAIT_L(0); PG8_MMA(1, 0, At, B0); PG8_BAR; PG8_SCHED;
            PG8_STAGE(PG8_SB(0, 1), b2 + hstep, voffB);
            PG8_WAIT_V(6); PG8_BAR; PG8_MMA(1, 1, At, B1); PG8_BAR;
            PG8_LDB(B0, 1, 0); PG8_SCHED; PG8_LDA(At, 1, 0); PG8_STAGE_A(PG8_SA(0, 1), a2, 1, nx);
            PG8_WAIT_L(8); PG8_BAR; PG8_WAIT_L(0); PG8_MMA(0, 0, At, B0); PG8_BAR; PG8_SCHED;
            PG8_LDB(B1, 1, 1); PG8_STAGE(PG8_SB(1, 0), b3, voffB);
            PG8_BAR; PG8_WAIT_L(0); PG8_MMA(0, 1, At, B1); PG8_BAR;
            PG8_LDA(At, 1, 1); PG8_STAGE_A(PG8_SA(1, 0), a3, 0, nx);
            PG8_BAR; PG8_WAIT_L(0); PG8_MMA(1, 0, At, B0); PG8_BAR; PG8_SCHED;
            PG8_STAGE(PG8_SB(1, 1), b3 + hstep, voffB);
            PG8_WAIT_V(6); PG8_BAR; PG8_MMA(1, 1, At, B1); PG8_BAR;
        }
        if constexpr (F8) { asm volatile("s_nop 15\n\ts_nop 15" : "+v"(acc[1][1][0][0]), "+v"(acc[1][1][0][1]), "+v"(acc[1][1][1][0]), "+v"(acc[1][1][1][1]), "+v"(acc[1][1][2][0]), "+v"(acc[1][1][2][1]), "+v"(acc[1][1][3][0]), "+v"(acc[1][1][3][1])); }
        if constexpr (Epi::HASPRE) E(acc, cur, wr, wc, fr, fq, pre); else E(acc, cur, wr, wc, fr, fq);
        if (!has_next) break;
#pragma unroll
        for (int a = 0; a < 2; ++a)
#pragma unroll
            for (int b = 0; b < 2; ++b)
#pragma unroll
                for (int m = 0; m < 4; ++m)
#pragma unroll
                    for (int n = 0; n < 2; ++n) acc[a][b][m][n] = (f32x4){0.f, 0.f, 0.f, 0.f};
        cur = nxt; cA = nA; cB = nB; ++ui;
        if constexpr (Epi::HASPRE) E.prefetch(pre, cur, wr, wc, fr, fq);
        if constexpr (GATHER) {
#pragma unroll
            for (int h = 0; h < 2; ++h)
#pragma unroll
                for (int i = 0; i < 2; ++i) offA[h][i] = offAn[h][i]; }
    }
    PG8_WAIT_V(0);
    if (wr == 0) PG8_BAR;
    PG8_BAR;
#undef PG8_SA
#undef PG8_SB
#undef PG8_STAGE
#undef PG8_STAGE_A
#undef PG8_LDA
#undef PG8_LDB
#undef PG8_MMA
#undef PG8_WAIT_V
#undef PG8_WAIT_L
#undef PG8_BAR
#undef PG8_SCHED
}
}

#define XB_TMO      128
#define XB_XCNT(j)  (256  + 64 * (j))
#define XB_XSUB(j)  (1280 + 64 * (j))
#define XB_XGEN(j)  (2304 + 64 * (j))
#define XB_TOP      3328
#define XB_TOPGEN   3392
#define XCD_BAR_WORDS 3456
#define XB_SPIN_CAP (1u << 18)

__device__ __forceinline__ unsigned xb_ld(unsigned* p)              { return __hip_atomic_load(p, __ATOMIC_RELAXED, __HIP_MEMORY_SCOPE_AGENT); }
__device__ __forceinline__ unsigned xb_add(unsigned* p, unsigned v) { return __hip_atomic_fetch_add(p, v, __ATOMIC_RELAXED, __HIP_MEMORY_SCOPE_AGENT); }
__device__ __forceinline__ unsigned xb_xcc_id() { return (unsigned)__builtin_amdgcn_s_getreg((3 << 11) | 20) & 0xFu; }
#define XB_SPIN(cond, bar) do { unsigned _sp = 0; while (cond) { __builtin_amdgcn_s_sleep(1); \
    if ((++_sp & 255u) == 0u) { if (xb_ld(&(bar)[XB_TMO])) break; if (_sp > XB_SPIN_CAP) { atomicAdd(&(bar)[XB_TMO], 1u); break; } } } } while (0)

struct XcdBarrier { unsigned* bar; unsigned x; volatile LAS unsigned* st; };

__device__ __forceinline__ XcdBarrier xcd_barrier_post(unsigned* bar, volatile LAS unsigned* st) {
    XcdBarrier b; b.bar = bar; b.x = xb_xcc_id(); b.st = st;
    if (threadIdx.x == 0) (void)xb_add(&bar[XB_XCNT(b.x)], 1u);
    return b;
}
__device__ __forceinline__ void xcd_barrier_complete(unsigned* bar, unsigned x, unsigned& nloc, unsigned& nx) {
    const unsigned G = gridDim.x * gridDim.y * gridDim.z;
    unsigned sum, cnt, mine, sp = 0u;
    for (;;) {
        sum = 0u; cnt = 0u; mine = 0u;
#pragma unroll
        for (unsigned j = 0; j < 16; ++j) { const unsigned c = xb_ld(&bar[XB_XCNT(j)]); sum += c; cnt += (c > 0u) ? 1u : 0u; mine = (j == x) ? c : mine; }
        if (sum == G) break;
        __builtin_amdgcn_s_sleep(1);
        if ((++sp & 255u) == 0u) { if (xb_ld(&bar[XB_TMO])) break; if (sp > XB_SPIN_CAP) { atomicAdd(&bar[XB_TMO], 1u); break; } }
    }
    nloc = mine > 0u ? mine : 1u; nx = cnt > 0u ? cnt : 1u;
}
__device__ __forceinline__ void xcd_barrier(const XcdBarrier& b) {
    asm volatile("s_waitcnt vmcnt(0)" ::: "memory");
    __syncthreads();
    if (threadIdx.x == 0) {
        unsigned* bar = b.bar;
        __builtin_amdgcn_s_waitcnt(0);
        unsigned nloc = b.st[0], nx = b.st[1];
        if (nloc == 0u) { xcd_barrier_complete(bar, b.x, nloc, nx); b.st[0] = nloc; b.st[1] = nx; }
        const unsigned old = xb_add(&bar[XB_XSUB(b.x)], 1u);
        const unsigned gen = old / nloc;
        if (old + 1u == (gen + 1u) * nloc) {
            __builtin_amdgcn_fence(__ATOMIC_RELEASE, "agent");
            asm volatile("s_waitcnt vmcnt(0)" ::: "memory");
            const unsigned og = xb_add(&bar[XB_TOP], 1u);
            const unsigned tg = og / nx;
            if (og + 1u == (tg + 1u) * nx) xb_add(&bar[XB_TOPGEN], 1u);
            else XB_SPIN(xb_ld(&bar[XB_TOPGEN]) == tg, bar);
            __builtin_amdgcn_fence(__ATOMIC_ACQUIRE, "agent");
            xb_add(&bar[XB_XGEN(b.x)], 1u);
            asm volatile("s_waitcnt vmcnt(0)" ::: "memory");
        } else {
            XB_SPIN(xb_ld(&bar[XB_XGEN(b.x)]) == gen, bar);
            __builtin_amdgcn_fence(__ATOMIC_ACQUIRE, "agent");
            asm volatile("s_waitcnt vmcnt(0)" ::: "memory");
        }
    }
    __syncthreads();
}

struct Args {
    const float* x; const float* norm_mix_g; const float* w_in; const float* conv_w; const float* conv_b; const float* w_a2; const float* b_a; const float* gla_norm_g;
    const float* w_br_a; const float* w_br_b; const float* w_out; const float* norm_ffn_g; const float* w_router; const float* b_router; const float* w_gate_up; const float* b_gate_up;
    const float* w_down; const float* b_down; const float* norm_final_g; float* out; unsigned char* ws; int ph_lo, ph_hi;
};

__device__ __forceinline__ void tr_item(const float* W, size_t ldw, int k0, int sn0, bf16* WT, int K, size_t drow0, LAS float* scr, int lane) {
#pragma unroll 8
    for (int i = 0; i < 32; ++i) { const int kk = 2 * i + (lane >> 5); scr[kk * 33 + (lane & 31)] = __builtin_nontemporal_load(W + (size_t)(k0 + kk) * ldw + sn0 + (lane & 31)); }
    LDS_WAIT(); asm volatile("" ::: "memory");
    const int c = lane & 7;
#pragma unroll
    for (int j = 0; j < 4; ++j) { const int n = (lane >> 3) + 8 * j; const LAS float* s = scr + (8 * c) * 33 + n;
        u32x4 o; o.x = cvt_pk_bf16(s[0 * 33], s[1 * 33]); o.y = cvt_pk_bf16(s[2 * 33], s[3 * 33]); o.z = cvt_pk_bf16(s[4 * 33], s[5 * 33]); o.w = cvt_pk_bf16(s[6 * 33], s[7 * 33]);
        *(u32x4*)(WT + (drow0 + n) * K + k0 + 8 * c) = o; }
    LDS_WAIT(); asm volatile("" ::: "memory");
}

struct TrItem { const float* W; size_t ldw; unsigned char* dst; int Kb; };
__device__ __forceinline__ void tr8_load(const TrItem& t, f32x4 (&r)[16]) {
#pragma unroll
    for (int i = 0; i < 16; ++i) r[i] = __builtin_nontemporal_load((const f32x4*)(t.W + (size_t)i * t.ldw));
}
__device__ __forceinline__ void tr8_store(const TrItem& t, const f32x4 (&r)[16], float scale) {
#pragma unroll
    for (int q = 0; q < 4; ++q) { u32x4 o;
        o.x = pk4_fp8(r[0][q] * scale, r[1][q] * scale, r[2][q] * scale, r[3][q] * scale); o.y = pk4_fp8(r[4][q] * scale, r[5][q] * scale, r[6][q] * scale, r[7][q] * scale);
        o.z = pk4_fp8(r[8][q] * scale, r[9][q] * scale, r[10][q] * scale, r[11][q] * scale); o.w = pk4_fp8(r[12][q] * scale, r[13][q] * scale, r[14][q] * scale, r[15][q] * scale);
        __builtin_nontemporal_store(o, (u32x4*)(t.dst + (size_t)q * t.Kb)); }
}
__device__ __forceinline__ TrItem moe_item(int it, const float* w_gate_up, const float* w_down, unsigned char* WGU8, unsigned char* WD8, int lane) {
    constexpr int NQ_GU = NE * 16 * 128; const int kr = lane >> 3, c4 = lane & 7; TrItem t;
    if (it < NQ_GU) { const int e = it / (16 * 128), r = it % (16 * 128), kb = r / 128, nb = r % 128; const int n0 = 32 * nb, isup = n0 / DFF, j = n0 % DFF;
        t.ldw = 2 * DFF; t.Kb = DM; t.W = w_gate_up + (size_t)e * DM * 2 * DFF + (size_t)(128 * kb + 16 * kr) * (2 * DFF) + n0 + 4 * c4;
        t.dst = WGU8 + ((size_t)e * 4096 + 256 * (j / 128) + 128 * isup + (j % 128) + 4 * c4) * DM + 128 * kb + 16 * kr; }
    else { const int i2 = it - NQ_GU; const int e = i2 / (16 * 64), r = i2 % (16 * 64), kb = r / 64, nb = r % 64;
        t.ldw = DM; t.Kb = DFF; t.W = w_down + (size_t)e * DFF * DM + (size_t)(128 * kb + 16 * kr) * DM + 32 * nb + 4 * c4;
        t.dst = WD8 + ((size_t)e * DM + 32 * nb + 4 * c4) * DFF + 128 * kb + 16 * kr; }
    return t;
}

constexpr int NQ_MOE = NE * 16 * 128 + NE * 16 * 64;
constexpr int NG9 = 232;
constexpr int NQ_SCAN = 0;
constexpr int NQ_TAIL = 32768;
static_assert(QBATCH % 2 == 0 && NQ_MOE % QBATCH == 0 && NQ_TAIL % QBATCH == 0, "queue batches");
__device__ __forceinline__ void moe_convert_queue(unsigned* head, int first, int last, const float* w_gate_up, const float* w_down, unsigned char* WGU8, unsigned char* WD8, int lane) {
    int nbase = 0; if (lane == 0) nbase = (int)__hip_atomic_fetch_add(head, (unsigned)QBATCH, RLX_AGENT);
    for (;;) {
        const int base = first + __builtin_amdgcn_readfirstlane(nbase);
        if (base >= last) break;
        if (lane == 0) nbase = (int)__hip_atomic_fetch_add(head, (unsigned)QBATCH, RLX_AGENT);
        f32x4 ra[16], rb[16];
        TrItem ta = moe_item(base, w_gate_up, w_down, WGU8, WD8, lane), tb;
        tr8_load(ta, ra);
#pragma unroll
        for (int j = 0; j < QBATCH; j += 2) {
            tb = moe_item(base + j + 1, w_gate_up, w_down, WGU8, WD8, lane); tr8_load(tb, rb);
            tr8_store(ta, ra, 1024.0f);
            if (j + 2 < QBATCH) { ta = moe_item(base + j + 2, w_gate_up, w_down, WGU8, WD8, lane); tr8_load(ta, ra); }
            tr8_store(tb, rb, 1024.0f);
        }
    }
}

__global__ void __launch_bounds__(NWAVES * 64, 2) mega_fwd(Args a) {
    extern __shared__ __attribute__((aligned(16))) unsigned char lds_raw[];
    LAS unsigned char* lds = (LAS unsigned char*)lds_raw;
    volatile LAS unsigned* MISC = (volatile LAS unsigned*)(lds + MISC_OFF);
    LAS int* tile_e = (LAS int*)(lds + TILEE_OFF);
    LAS int* pstart = (LAS int*)(lds + PSTART_OFF);
    const int tid = threadIdx.x, lane = tid & 63, wave = __builtin_amdgcn_readfirstlane(tid >> 6);
    const int G = gridDim.x; const int bx = blockIdx.x; const int vcu = (G % 8 == 0) ? (bx % 8) * (G / 8) + bx / 8 : bx;
    const int gw = vcu * NWAVES + wave, NGW = G * NWAVES;
    unsigned char* ws = a.ws;
    unsigned* ctl = (unsigned*)(ws + WS_CTL);
    float* WRF = (float*)(ws + WS_WRF);
    int* tk_e = (int*)(ws + WS_TK); int* tk_rank = tk_e + NTOK * 4; float* tk_w = (float*)(tk_rank + NTOK * 4); int* tk_slot = (int*)(tk_w + NTOK * 4); float* rs_tok = (float*)(tk_slot + NTOK * 4);
    float* slot_w = (float*)(ws + WS_SLOT); float* slot_rs = slot_w + MAXSLOT; int* slot_tok = (int*)(slot_rs + MAXSLOT);
    bf16* WIN = (bf16*)(ws + WS_WIN); bf16* WA = (bf16*)(ws + WS_WA); bf16* WB = (bf16*)(ws + WS_WB); bf16* WO = (bf16*)(ws + WS_WO); unsigned char* WGU8 = ws + WS_WGU; unsigned char* WD8 = ws + WS_WD;
    bf16* Hb = (bf16*)(ws + WS_H); bf16* P = (bf16*)(ws + WS_P); bf16* ZA = (bf16*)(ws + WS_ZA); bf16* ZB = (bf16*)(ws + WS_ZB); bf16* Ob = (bf16*)(ws + WS_O);
    bf16* YA = (bf16*)(ws + WS_YA); bf16* MIX = (bf16*)(ws + WS_MIX); float* X1 = (float*)(ws + WS_X1); unsigned char* G8 = ws + WS_XB; unsigned char* ACT8 = ws + WS_ACT; unsigned char* YS8 = ws + WS_YS; unsigned char* H8 = ws + WS_H; unsigned char* WIN8 = ws + WS_WIN8; unsigned char* HQ8 = ws + WS_HQ8;

    for (int u = tid; u < (LDS_BYTES - LDSCTL_OFF) / 4; u += NWAVES * 64) ((LAS unsigned*)(lds + LDSCTL_OFF))[u] = 0u;
    __syncthreads();
    XcdBarrier bar = xcd_barrier_post(ctl + CW_BAR, MISC + 8);
    const int lo = a.ph_lo, hi = a.ph_hi;
#define IN(k) (lo <= (k) && (k) < hi)
#define BOTH(k) (IN(k) && IN((k) + 1))
#define GRID_BAR() xcd_barrier(bar)

    if (IN(0)) {
      for (int rep = 0; rep < REP_P0; ++rep) {
        {
            f32x4 gv[8];
#pragma unroll
            for (int j = 0; j < 8; ++j) gv[j] = *((const f32x4*)a.norm_mix_g + lane + 64 * j);
            for (int m = gw; m < NTOK; m += NGW) {
                const f32x4* xr = (const f32x4*)(a.x + (size_t)m * DM) + lane; f32x4 v[8]; float s = 0.f;
#pragma unroll
                for (int j = 0; j < 8; ++j) { v[j] = __builtin_nontemporal_load(xr + 64 * j);     s += (v[j].x * v[j].x + v[j].y * v[j].y) + (v[j].z * v[j].z + v[j].w * v[j].w); }
                const float rs = 1.0f / sqrtf(wave_sum(s) * (1.0f / DM) + EPS);
                u32x2* o8 = (u32x2*)(Hb + (size_t)m * DM) + lane;
                unsigned* q8 = (unsigned*)(HQ8 + (size_t)m * DM) + lane;
#pragma unroll
                for (int j = 0; j < 8; ++j) { const float h0 = v[j].x * rs * gv[j].x, h1 = v[j].y * rs * gv[j].y, h2 = v[j].z * rs * gv[j].z, h3 = v[j].w * rs * gv[j].w;
                    u32x2 w; w.x = cvt_pk_bf16(h0, h1); w.y = cvt_pk_bf16(h2, h3); o8[64 * j] = w; q8[64 * j] = pk4_fp8(8.0f * h0, 8.0f * h1, 8.0f * h2, 8.0f * h3); }
            }
        }
#if DBG_STAGE >= 1
        {
            LAS float* scr = (LAS float*)(lds + wave * 16896);
            for (int it = gw; it < 192 * 32; it += NGW) { const int kb = it / 192, db = it % 192; const int d0 = 32 * db; tr_item(a.w_in, DIN, 64 * kb, d0, WIN, DM, d0, scr, lane); }
            for (int it = gw; it < 16 * 128; it += NGW) { const int kb = it / 128, nb = it % 128; const int kr = lane >> 3, c4 = lane & 7; TrItem t; t.ldw = DIN; t.Kb = DM;
                t.W = a.w_in + (size_t)(128 * kb + 16 * kr) * DIN + 6160 + 32 * nb + 4 * c4; t.dst = WIN8 + ((size_t)32 * nb + 4 * c4) * DM + 128 * kb + 16 * kr;
                f32x4 r8[16]; tr8_load(t, r8); tr8_store(t, r8, 512.0f); }
            for (int i = gw * 64 + lane; i < 256 * DM; i += NGW * 64) { const int r = i / DM, k = i % DM; WIN[(size_t)(PC_AL + r) * DM + k] = r < 16 ? (bf16)(cvt_pk_bf16(a.w_in[(size_t)k * DIN + SRC_AL + r], 0.f) & 0xffffu) : (bf16)0; }
#if DBG_STAGE >= 3
            for (int i = gw * 64 + lane; i < 128 * 2 * 64 * 4; i += NGW * 64) { const int ii = i & 3, l = (i >> 2) & 63, t = (i >> 8) & 1, j = i >> 9; const int k = 32 * (j >> 1) + 8 * (l >> 4) + 4 * (j & 1) + ii;
                WRF[i] = a.norm_ffn_g[k] * a.w_router[(size_t)k * NE + 16 * t + (l & 15)]; }
#endif
        }
#endif
      }
        if (BOTH(0)) GRID_BAR();
    }

#if DBG_STAGE >= 1
    if (IN(1)) {
        const int ngemm = (G == 256) ? NGEMM : G;
        if (bx < ngemm) {
            { pg8::Gemm g{Hb, WIN, 2 * DM, nullptr, nullptr, nullptr}; pg8::StaticOrder S; S.init(NTOK / 256, 25, ngemm, bx, 4); pg8::EpiPlainBf16 E{P, NP, 0, 1.0f}; pg8::gemm_phase<false, 1, false>(lds, g, S, E); }
            { pg8::Gemm g{HQ8, WIN8, DM, nullptr, nullptr, nullptr}; pg8::StaticOrder S; S.init(NTOK / 256, 16, ngemm, bx, 4); pg8::EpiPlainFp8 E{G8, 4096, 16.0f / 4096.0f}; pg8::gemm_phase<true, 1, false>(lds, g, S, E); }
        }
#if DBG_STAGE >= 3
        moe_convert_queue(ctl + CW_Q, 0, NQ_MOE - NQ_TAIL - NQ_SCAN, a.w_gate_up, a.w_down, WGU8, WD8, lane);
#endif
        if (BOTH(1)) GRID_BAR();
    }

    if (IN(2)) {
        bf16* KTT = (bf16*)(ws + WS_KTT);
        float* DECB = (float*)(ws + WS_DEC);
        bf16* VTT = (bf16*)(ws + WS_VTT);
        {
            LAS float* AL = (LAS float*)(lds);
            LAS float* CUMG = (LAS float*)(lds + 4096);
            LAS bf16* KL = (LAS bf16*)(lds + 8192);
            LAS unsigned char* VT = lds + 32768;
            for (int item = vcu; item < 1024; item += G) {
                const int b = item >> 7, c = (item >> 2) & 31, h = item & 3;
                const size_t t0 = (size_t)b * SEQ + 64 * c;
                const int dk = tid & 127, sg = tid >> 7;
                float wa2[16];
#pragma unroll
                for (int j = 0; j < 16; ++j) wa2[j] = a.w_a2[j * 512 + h * 128 + dk];
                const float ba = a.b_a[h * 128 + dk];
                if (tid < 128) { const int s = tid >> 1, hf = tid & 1; const u32x4 w = *(const u32x4*)(P + (t0 + s) * NP + PC_AL + 8 * hf);
                    LAS float* d = AL + s * 16 + 8 * hf; d[0] = bf_lo(w.x); d[1] = bf_hi(w.x); d[2] = bf_lo(w.y); d[3] = bf_hi(w.y); d[4] = bf_lo(w.z); d[5] = bf_hi(w.z); d[6] = bf_lo(w.w); d[7] = bf_hi(w.w); }
#pragma unroll
                for (int i = 0; i < 2; ++i) { const int p = tid + 512 * i, row = p >> 4, c16 = p & 15; *(LAS u32x4*)(KL + row * 136 + c16 * 8) = *(const u32x4*)(P + (t0 + row) * NP + PC_K + h * 128 + c16 * 8); }
                if (tid < 256) { const int vb = tid & 31, sb = tid >> 5; u32x4 Lr[8];
#pragma unroll
                  for (int i = 0; i < 8; ++i) Lr[i] = *(const u32x4*)(P + (t0 + 8 * sb + i) * NP + PC_V + h * 256 + 8 * vb);
#pragma unroll
                  for (int j = 0; j < 8; ++j) { const unsigned sel = (j & 1) ? 0x07060302u : 0x05040100u; u32x4 w;
                      w.x = __builtin_amdgcn_perm(Lr[1][j >> 1], Lr[0][j >> 1], sel); w.y = __builtin_amdgcn_perm(Lr[3][j >> 1], Lr[2][j >> 1], sel);
                      w.z = __builtin_amdgcn_perm(Lr[5][j >> 1], Lr[4][j >> 1], sel); w.w = __builtin_amdgcn_perm(Lr[7][j >> 1], Lr[6][j >> 1], sel);
                      *(LAS u32x4*)(VT + (8 * vb + j) * 128 + ((sb ^ (vb & 7)) << 4)) = w; } }
                __syncthreads();
#pragma unroll
                for (int i = 0; i < 4; ++i) { const int q = tid + 512 * i, v = q >> 3, slot = q & 7; *(u32x4*)(VTT + ((size_t)item * 256 + v) * 64 + 8 * (slot ^ ((v >> 3) & 7))) = *(const LAS u32x4*)(VT + q * 16); }
                float cs[16]; float run = 0.f;
#pragma unroll
                for (int i = 0; i < 16; ++i) { const LAS float* al = AL + (16 * sg + i) * 16; float z = ba;
#pragma unroll
                    for (int j = 0; j < 16; ++j) z += al[j] * wa2[j];
                    const float la = -(fmaxf(-z, 0.f) + __logf(1.0f + __expf(-fabsf(z)))) * (1.0f / 16.0f); run += la; cs[i] = run; }
                CUMG[sg * 128 + dk] = run;
                __syncthreads();
                float pre = 0.f, tot = 0.f;
#pragma unroll
                for (int gq = 0; gq < 4; ++gq) { const float v = CUMG[gq * 128 + dk]; tot += v; if (gq < sg) pre += v; }
                if (sg == 0) DECB[item * 128 + dk] = __expf(tot);
                { unsigned pk[8];
#pragma unroll
                  for (int i = 0; i < 8; ++i) { const float f0 = __expf(tot - (pre + cs[2 * i])), f1 = __expf(tot - (pre + cs[2 * i + 1])); pk[i] = cvt_pk_bf16(bf2f(KL[(16 * sg + 2 * i) * 136 + dk]) * f0, bf2f(KL[(16 * sg + 2 * i + 1) * 136 + dk]) * f1); }
                  u32x4 w0, w1; w0.x = pk[0]; w0.y = pk[1]; w0.z = pk[2]; w0.w = pk[3]; w1.x = pk[4]; w1.y = pk[5]; w1.z = pk[6]; w1.w = pk[7];
                  u32x4* dst = (u32x4*)(KTT + ((size_t)item * 128 + dk) * 64 + 16 * sg); dst[0] = w0; dst[1] = w1; }
                __syncthreads();
            }
        }
        GRID_BAR();
        {
            LAS bf16* SB = (LAS bf16*)(lds + 8192);
            LAS float* OT = (LAS float*)(lds + 43008);
            LAS bf16* VTS = (LAS bf16*)(lds + 77824);
            LAS bf16* QS = (LAS bf16*)(lds + 96256);
            const int fr = lane & 15, fq = lane >> 4, mi = wave >> 1, ni = wave & 1;
            struct GlaRegs { bf16x8 af[2]; u32x4 q[2]; u32x4 vt; f32x4 dec; };
            const bool split = (G == 256);
            for (int rep = 0; rep < REP_P2; ++rep)
            if (!split || !(vcu & 1))
            for (int it = split ? (vcu >> 1) : vcu; it < 128; it += split ? 128 : G) {
                const int b = it >> 4, h = (it >> 2) & 3, vs = it & 3;
                f32x4 Sacc[4];
#pragma unroll
                for (int n = 0; n < 4; ++n) Sacc[n] = (f32x4){0.f, 0.f, 0.f, 0.f};
                GlaRegs R[3];
#define GLA_LOAD(X, cc) do { const int item_ = (b * 32 + (cc)) * 4 + h; const size_t t0_ = (size_t)b * SEQ + 64 * (cc); \
                    _Pragma("unroll") for (int ks = 0; ks < 2; ++ks) X.af[ks] = *(const bf16x8*)(KTT + ((size_t)item_ * 128 + 16 * wave + fr) * 64 + 32 * ks + 8 * fq); \
                    X.vt = *(const u32x4*)(VTT + ((size_t)item_ * 256 + vs * 64 + 8 * wave + (lane >> 3)) * 64 + 8 * (lane & 7)); \
                    _Pragma("unroll") for (int i = 0; i < 2; ++i) X.q[i] = *(const u32x4*)(P + (t0_ + 8 * wave + (lane >> 3)) * NP + PC_Q + h * 128 + 8 * (lane & 7) + 64 * i); \
                    X.dec = *(const f32x4*)(DECB + item_ * 128 + 16 * wave + 4 * fq); } while (0)
#define GLA_PUT_VT(X, cc) do { *(LAS u32x4*)(VTS + ((cc) & 1) * (64 * 72) + (8 * wave + (lane >> 3)) * 72 + 8 * (lane & 7)) = X.vt; } while (0)
                GLA_LOAD(R[0], 0); GLA_LOAD(R[1], 1); GLA_LOAD(R[2], 2);
                GLA_PUT_VT(R[0], 0);
                __syncthreads();
                for (int c0 = 0; c0 < 32; c0 += 3) {
#pragma unroll
                    for (int u = 0; u < 3; ++u) {
                        const int c = c0 + u; if (c >= 32) break;
                        const size_t t0 = (size_t)b * SEQ + 64 * c;
                        LAS bf16* SBc = SB + (c & 1) * (64 * 136); LAS bf16* QSc = QS + (c & 1) * (64 * 136); const LAS bf16* VTc = VTS + (c & 1) * (64 * 72);
#pragma unroll
                        for (int n = 0; n < 4; ++n) Sacc[n] *= R[u].dec;
                        { bf16x8 bvf[2][4];
#pragma unroll
                          for (int ks = 0; ks < 2; ++ks)
#pragma unroll
                              for (int n = 0; n < 4; ++n) bvf[ks][n] = *(const LAS bf16x8*)(VTc + (16 * n + fr) * 72 + 32 * ks + 8 * fq);
#pragma unroll
                          for (int ks = 0; ks < 2; ++ks)
#pragma unroll
                              for (int n = 0; n < 4; ++n) Sacc[n] = __builtin_amdgcn_mfma_f32_16x16x32_bf16(R[u].af[ks], bvf[ks][n], Sacc[n], 0, 0, 0); }
#pragma unroll
                        for (int n = 0; n < 4; ++n) { u32x2 w; w.x = cvt_pk_bf16(Sacc[n][0], Sacc[n][1]); w.y = cvt_pk_bf16(Sacc[n][2], Sacc[n][3]); *(LAS u32x2*)(SBc + (16 * n + fr) * 136 + 16 * wave + 4 * fq) = w; }
#pragma unroll
                        for (int i = 0; i < 2; ++i) *(LAS u32x4*)(QSc + (8 * wave + (lane >> 3)) * 136 + 8 * (lane & 7) + 64 * i) = R[u].q[i];
                        if (c + 1 < 32) GLA_PUT_VT(R[(u + 1) % 3], c + 1);
                        if (c + 3 < 32) GLA_LOAD(R[u], c + 3);
                        __syncthreads();
                        f32x4 oa[2] = {(f32x4){0.f, 0.f, 0.f, 0.f}, (f32x4){0.f, 0.f, 0.f, 0.f}};
                        { bf16x8 qf[4], sf[4][2];
#pragma unroll
                          for (int kk = 0; kk < 4; ++kk) { qf[kk] = *(const LAS bf16x8*)(QSc + (16 * mi + fr) * 136 + 32 * kk + 8 * fq);
#pragma unroll
                              for (int n2 = 0; n2 < 2; ++n2) sf[kk][n2] = *(const LAS bf16x8*)(SBc + (16 * (2 * ni + n2) + fr) * 136 + 32 * kk + 8 * fq); }
#pragma unroll
                          for (int kk = 0; kk < 4; ++kk)
#pragma unroll
                              for (int n2 = 0; n2 < 2; ++n2) oa[n2] = __builtin_amdgcn_mfma_f32_16x16x32_bf16(qf[kk], sf[kk][n2], oa[n2], 0, 0, 0); }
                        LAS float* OTc = OT + (c & 1) * (64 * 68);
#pragma unroll
                        for (int n2 = 0; n2 < 2; ++n2)
#pragma unroll
                            for (int j = 0; j < 4; ++j) OTc[(16 * mi + 4 * fq + j) * 68 + 16 * (2 * ni + n2) + fr] = oa[n2][j] * 0.08838834764831845f;
                        if (c > 0) {
                            const LAS f32x4* op = (const LAS f32x4*)(OT + ((c - 1) & 1) * (64 * 68) + (8 * wave + (lane >> 3)) * 68 + 8 * (lane & 7)); const f32x4 ov0 = op[0], ov1 = op[1];
                            u32x4 ow; ow.x = cvt_pk_bf16(ov0[0], ov0[1]); ow.y = cvt_pk_bf16(ov0[2], ov0[3]); ow.z = cvt_pk_bf16(ov1[0], ov1[1]); ow.w = cvt_pk_bf16(ov1[2], ov1[3]);
                            *(u32x4*)(Ob + (t0 - 64 + 8 * wave + (lane >> 3)) * 1024 + h * 256 + vs * 64 + 8 * (lane & 7)) = ow; }
                    }
                }
                __syncthreads();
                { const size_t t0 = (size_t)b * SEQ + 64 * 31; const LAS f32x4* op = (const LAS f32x4*)(OT + (31 & 1) * (64 * 68) + (8 * wave + (lane >> 3)) * 68 + 8 * (lane & 7)); const f32x4 ov0 = op[0], ov1 = op[1];
                  u32x4 ow; ow.x = cvt_pk_bf16(ov0[0], ov0[1]); ow.y = cvt_pk_bf16(ov0[2], ov0[3]); ow.z = cvt_pk_bf16(ov1[0], ov1[1]); ow.w = cvt_pk_bf16(ov1[2], ov1[3]);
                  *(u32x4*)(Ob + (t0 + 8 * wave + (lane >> 3)) * 1024 + h * 256 + vs * 64 + 8 * (lane & 7)) = ow; }
                __syncthreads();
#undef GLA_LOAD
#undef GLA_PUT_VT
            }
            if (!split || (vcu & 1)) { const int hw = split ? (vcu >> 1) * NWAVES + wave : gw, nhw = split ? 128 * NWAVES : NGW;
            for (int wi = hw; wi < 2048; wi += nhw) {
                const int tb = wi >> 1, hf = wi & 1, c0 = 512 * hf + 8 * lane; const int t0 = 16 * tb;
                float w0[8], w1[8], w2[8], cb[8];
#pragma unroll
                for (int j = 0; j < 8; ++j) { w0[j] = a.conv_w[c0 + j]; w1[j] = a.conv_w[1024 + c0 + j]; w2[j] = a.conv_w[2048 + c0 + j]; cb[j] = a.conv_b[c0 + j]; }
                float y2[8], y1[8];
#pragma unroll
                for (int j = 0; j < 8; ++j) { y2[j] = 0.f; y1[j] = 0.f; }
                if ((t0 % SEQ) != 0) {
                    const bf16* pr = P + (size_t)(t0 - 2) * NP + c0; const u32x4 c2 = *(const u32x4*)(pr + PC_UC), x2 = *(const u32x4*)(pr + PC_UX), c1 = *(const u32x4*)(pr + NP + PC_UC), x1 = *(const u32x4*)(pr + NP + PC_UX);
                    y2[0] = bf_lo(c2.x) * bf_lo(x2.x); y2[1] = bf_hi(c2.x) * bf_hi(x2.x); y2[2] = bf_lo(c2.y) * bf_lo(x2.y); y2[3] = bf_hi(c2.y) * bf_hi(x2.y); y2[4] = bf_lo(c2.z) * bf_lo(x2.z); y2[5] = bf_hi(c2.z) * bf_hi(x2.z); y2[6] = bf_lo(c2.w) * bf_lo(x2.w); y2[7] = bf_hi(c2.w) * bf_hi(x2.w);
                    y1[0] = bf_lo(c1.x) * bf_lo(x1.x); y1[1] = bf_hi(c1.x) * bf_hi(x1.x); y1[2] = bf_lo(c1.y) * bf_lo(x1.y); y1[3] = bf_hi(c1.y) * bf_hi(x1.y); y1[4] = bf_lo(c1.z) * bf_lo(x1.z); y1[5] = bf_hi(c1.z) * bf_hi(x1.z); y1[6] = bf_lo(c1.w) * bf_lo(x1.w); y1[7] = bf_hi(c1.w) * bf_hi(x1.w);
                }
#pragma unroll 4
                for (int t = 0; t < 16; ++t) {
                    const bf16* pr = P + (size_t)(t0 + t) * NP + c0; const u32x4 uc = *(const u32x4*)(pr + PC_UC), ub = *(const u32x4*)(pr + PC_UB), ux = *(const u32x4*)(pr + PC_UX);
                    float y0[8], bb[8];
                    y0[0] = bf_lo(uc.x) * bf_lo(ux.x); y0[1] = bf_hi(uc.x) * bf_hi(ux.x); y0[2] = bf_lo(uc.y) * bf_lo(ux.y); y0[3] = bf_hi(uc.y) * bf_hi(ux.y); y0[4] = bf_lo(uc.z) * bf_lo(ux.z); y0[5] = bf_hi(uc.z) * bf_hi(ux.z); y0[6] = bf_lo(uc.w) * bf_lo(ux.w); y0[7] = bf_hi(uc.w) * bf_hi(ux.w);
                    bb[0] = bf_lo(ub.x); bb[1] = bf_hi(ub.x); bb[2] = bf_lo(ub.y); bb[3] = bf_hi(ub.y); bb[4] = bf_lo(ub.z); bb[5] = bf_hi(ub.z); bb[6] = bf_lo(ub.w); bb[7] = bf_hi(ub.w);
                    float z[8];
#pragma unroll
                    for (int j = 0; j < 8; ++j) { z[j] = bb[j] * (cb[j] + w0[j] * y2[j] + w1[j] * y1[j] + w2[j] * y0[j]); y2[j] = y1[j]; y1[j] = y0[j]; }
                    u32x4 w; w.x = cvt_pk_bf16(z[0], z[1]); w.y = cvt_pk_bf16(z[2], z[3]); w.z = cvt_pk_bf16(z[4], z[5]); w.w = cvt_pk_bf16(z[6], z[7]);
                    *(u32x4*)(ZA + (size_t)(t0 + t) * 1024 + c0) = w;
                }
            }
            { LAS float* scr = (LAS float*)(lds + wave * 16896);
              for (int it = hw; it < 16 * 64; it += nhw) { const int kb = it / 64, nb = it % 64; tr_item(a.w_br_a, DM, 64 * kb, 32 * nb, WA, 1024, 32 * nb, scr, lane); }
              for (int it = hw; it < 16 * 64; it += nhw) { const int kb = it / 64, nb = it % 64; tr_item(a.w_br_b, DM, 64 * kb, 32 * nb, WB, 1024, 32 * nb, scr, lane); }
              for (int it = hw; it < 32 * 64; it += nhw) { const int kb = it / 64, nb = it % 64; tr_item(a.w_out, DM, 64 * kb, 32 * nb, WO, DM, 32 * nb, scr, lane); } }
            }
#if DBG_STAGE >= 3
            moe_convert_queue(ctl + CW_Q3, NQ_MOE - NQ_TAIL - NQ_SCAN, NQ_MOE - NQ_TAIL, a.w_gate_up, a.w_down, WGU8, WD8, lane);
#endif
        }
        if (BOTH(2)) GRID_BAR();
    }

    if (IN(3)) {
        {
            f32x4 gg[4];
#pragma unroll
            for (int j = 0; j < 4; ++j) gg[j] = *((const f32x4*)(a.gla_norm_g + 16 * lane) + j);
            for (int m = gw; m < NTOK; m += NGW) {
                const u32x4* op = (const u32x4*)(Ob + (size_t)m * 1024 + 16 * lane); const u32x4 ob0 = op[0], ob1 = op[1]; f32x4 o[4]; float s = 0.f;
                o[0] = (f32x4){bf_lo(ob0.x), bf_hi(ob0.x), bf_lo(ob0.y), bf_hi(ob0.y)}; o[1] = (f32x4){bf_lo(ob0.z), bf_hi(ob0.z), bf_lo(ob0.w), bf_hi(ob0.w)};
                o[2] = (f32x4){bf_lo(ob1.x), bf_hi(ob1.x), bf_lo(ob1.y), bf_hi(ob1.y)}; o[3] = (f32x4){bf_lo(ob1.z), bf_hi(ob1.z), bf_lo(ob1.w), bf_hi(ob1.w)};
#pragma unroll
                for (int j = 0; j < 4; ++j) { s += (o[j].x * o[j].x + o[j].y * o[j].y) + (o[j].z * o[j].z + o[j].w * o[j].w); }
                s += __shfl_xor(s, 1); s += __shfl_xor(s, 2); s += __shfl_xor(s, 4); s += __shfl_xor(s, 8);
                const float rs = 1.0f / sqrtf(s * (1.0f / 256.0f) + EPS);
                const u32x4* rp = (const u32x4*)(P + (size_t)m * NP + PC_R + 16 * lane); const u32x4 r0 = rp[0], r1 = rp[1];
                float rr[16];
                rr[0] = bf_lo(r0.x); rr[1] = bf_hi(r0.x); rr[2] = bf_lo(r0.y); rr[3] = bf_hi(r0.y); rr[4] = bf_lo(r0.z); rr[5] = bf_hi(r0.z); rr[6] = bf_lo(r0.w); rr[7] = bf_hi(r0.w);
                rr[8] = bf_lo(r1.x); rr[9] = bf_hi(r1.x); rr[10] = bf_lo(r1.y); rr[11] = bf_hi(r1.y); rr[12] = bf_lo(r1.z); rr[13] = bf_hi(r1.z); rr[14] = bf_lo(r1.w); rr[15] = bf_hi(r1.w);
                float z[16];
#pragma unroll
                for (int j = 0; j < 4; ++j)
#pragma unroll
                    for (int q = 0; q < 4; ++q) { const float r = rr[4 * j + q]; z[4 * j + q] = o[j][q] * rs * gg[j][q] * (r * fast_sigmoid(r)); }
                u32x4 w0, w1; w0.x = cvt_pk_bf16(z[0], z[1]); w0.y = cvt_pk_bf16(z[2], z[3]); w0.z = cvt_pk_bf16(z[4], z[5]); w0.w = cvt_pk_bf16(z[6], z[7]);
                w1.x = cvt_pk_bf16(z[8], z[9]); w1.y = cvt_pk_bf16(z[10], z[11]); w1.z = cvt_pk_bf16(z[12], z[13]); w1.w = cvt_pk_bf16(z[14], z[15]);
                u32x4* zp = (u32x4*)(ZB + (size_t)m * 1024 + 16 * lane); zp[0] = w0; zp[1] = w1;
            }
        }
        if (BOTH(3)) GRID_BAR();
    }

    if (IN(4)) {
        { pg8::Gemm g{ZA, WA, 2048, ZB, WB, nullptr}; pg8::StaticOrder S; S.init(NTOK / 256, DM / 256, G, bx); pg8::EpiGate2 E{G8, MIX}; pg8::gemm_phase<false, 2, false>(lds, g, S, E); }
        if (BOTH(4)) GRID_BAR();
    }

    if (IN(6)) {
        pg8::Gemm g{MIX, WO, 2 * DM, nullptr, nullptr, nullptr}; pg8::StaticOrder S; S.init(NTOK / 256, DM / 256, G, bx); pg8::EpiResF32 E{a.x, X1};
        pg8::gemm_phase<false, 1, false>(lds, g, S, E);
        if (BOTH(6)) GRID_BAR();
    }
#endif

#if DBG_STAGE >= 3
    if (IN(7)) {
        for (int i = gw * 64 + lane; i < MAXSLOT; i += NGW * 64) slot_tok[i] = 0;
        LAS float* comb = (LAS float*)(lds);
        LAS float* lgb = (LAS float*)(lds + 16384);
        LAS int* hist = (LAS int*)(lds + 40960);
        const int r16 = lane & 15, kq = lane >> 4, gi = wave & 3, kh = wave >> 2;
        for (int rg0 = 0; rg0 < 1024; rg0 += 4 * G) {
            const int rg = rg0 + gi * G + vcu; const bool active = rg < 1024;
            const size_t row = (size_t)(active ? rg : 0) * 16 + r16;
            const f32x4* xp = (const f32x4*)(X1 + row * DM + 8 * kq); const f32x4* gp = (const f32x4*)(a.norm_ffn_g + 8 * kq);
            unsigned* hp = (unsigned*)(H8 + row * DM + 8 * kq);
            f32x4 acc0 = (f32x4){0.f, 0.f, 0.f, 0.f}, acc1 = (f32x4){0.f, 0.f, 0.f, 0.f}; float ssq = 0.f;
            for (int h = 0; h < 2; ++h) {
                { const u32x4* src = (const u32x4*)WRF + (size_t)h * 8192 + tid; LAS u32x4* dst = (LAS u32x4*)lds + tid;
#pragma unroll
                  for (int i = 0; i < 16; ++i) dst[512 * i] = src[512 * i]; }
                __syncthreads();
                if (active) {
                    const LAS f32x4* wl = (const LAS f32x4*)lds + (size_t)(2 * 32 * kh) * 64 + lane;
                    const int jb = 64 * h + 32 * kh;
#pragma unroll 4
                    for (int jj = 0; jj < 32; ++jj) { const int j = jb + jj;
                        const int ko = 8 * (j >> 1) + (j & 1);
                        const f32x4 av = xp[ko], gv = gp[ko], b0 = wl[(2 * jj) * 64], b1 = wl[(2 * jj + 1) * 64];
                        ssq += (av.x * av.x + av.y * av.y) + (av.z * av.z + av.w * av.w);
                        hp[ko] = pk4_fp8(av.x * gv.x * 16.0f, av.y * gv.y * 16.0f, av.z * gv.z * 16.0f, av.w * gv.w * 16.0f);
                        acc0 = __builtin_amdgcn_mfma_f32_16x16x4f32(av.x, b0.x, acc0, 0, 0, 0); acc1 = __builtin_amdgcn_mfma_f32_16x16x4f32(av.x, b1.x, acc1, 0, 0, 0);
                        acc0 = __builtin_amdgcn_mfma_f32_16x16x4f32(av.y, b0.y, acc0, 0, 0, 0); acc1 = __builtin_amdgcn_mfma_f32_16x16x4f32(av.y, b1.y, acc1, 0, 0, 0);
                        acc0 = __builtin_amdgcn_mfma_f32_16x16x4f32(av.z, b0.z, acc0, 0, 0, 0); acc1 = __builtin_amdgcn_mfma_f32_16x16x4f32(av.z, b1.z, acc1, 0, 0, 0);
                        acc0 = __builtin_amdgcn_mfma_f32_16x16x4f32(av.w, b0.w, acc0, 0, 0, 0); acc1 = __builtin_amdgcn_mfma_f32_16x16x4f32(av.w, b1.w, acc1, 0, 0, 0); }
                }
                __syncthreads();
            }
            ssq += __shfl_xor(ssq, 16); ssq += __shfl_xor(ssq, 32);
            if (kh == 1) { LAS float* c = comb + (gi * 64 + lane) * 12;
#pragma unroll
                for (int j = 0; j < 4; ++j) { c[j] = acc0[j]; c[4 + j] = acc1[j]; }
                c[8] = ssq; }
            if (tid < 64) hist[tid] = 0;
            __syncthreads();
            int te[4] = {0, 0, 0, 0}, lr[4] = {0, 0, 0, 0}; float tw[4] = {0.f, 0.f, 0.f, 0.f}; float rs = 0.f;
            if (active && kh == 0) {
                const LAS float* c = comb + (gi * 64 + lane) * 12;
#pragma unroll
                for (int j = 0; j < 4; ++j) { acc0[j] += c[j]; acc1[j] += c[4 + j]; }
                ssq += c[8];
                rs = 1.0f / sqrtf(ssq * (1.0f / DM) + EPS);
                LAS float* lg = lgb + gi * (16 * 36);
#pragma unroll
                for (int j = 0; j < 4; ++j) { lg[(4 * kq + j) * 36 + r16] = acc0[j]; lg[(4 * kq + j) * 36 + 16 + r16] = acc1[j]; }
                LDS_WAIT(); asm volatile("" ::: "memory");
                if (lane < 16) {
                    float l[32];
#pragma unroll
                    for (int n = 0; n < 32; ++n) l[n] = lg[lane * 36 + n] * rs + a.b_router[n];
                    float tv[4];
#pragma unroll
                    for (int k = 0; k < 4; ++k) { float bv = -3.0e38f; int bi = 0;
#pragma unroll
                        for (int n = 0; n < 32; ++n) if (l[n] > bv) { bv = l[n]; bi = n; }
                        tv[k] = bv; te[k] = bi;
#pragma unroll
                        for (int n = 0; n < 32; ++n) l[n] = (n == bi) ? -3.0e38f : l[n]; }
                    float den = 0.f;
#pragma unroll
                    for (int k = 0; k < 4; ++k) { tw[k] = expf(tv[k] - tv[0]); den += tw[k]; }
                    const float inv = 1.0f / den;
#pragma unroll
                    for (int k = 0; k < 4; ++k) { tw[k] *= inv; lr[k] = __hip_atomic_fetch_add(&hist[te[k]], 1, __ATOMIC_RELAXED, __HIP_MEMORY_SCOPE_WORKGROUP); }
                }
            }
            __syncthreads();
            if (tid < 32) { const int c = hist[tid]; hist[32 + tid] = c ? (int)__hip_atomic_fetch_add(ctl + CW_CNT + 64 * tid, (unsigned)c, RLX_AGENT) : 0; }
            __syncthreads();
            if (active && kh == 0 && lane < 16) { const size_t orow = (size_t)rg * 16 + lane;
#pragma unroll
                for (int k = 0; k < 4; ++k) { tk_e[orow * 4 + k] = te[k]; tk_rank[orow * 4 + k] = hist[32 + te[k]] + lr[k]; tk_w[orow * 4 + k] = tw[k]; }
                rs_tok[orow] = rs; }
            __syncthreads();
        }
        if (BOTH(7)) GRID_BAR();
    }

    if (IN(8)) {
        if (tid == 0) { int ps = 0, mt = 0;
            for (int e = 0; e < NE; ++e) { const int c = (int)__hip_atomic_load(ctl + CW_CNT + 64 * e, RLX_AGENT); pstart[e] = ps; const int nt = (c + 255) >> 8; for (int i = 0; i < nt; ++i) tile_e[mt + i] = e; mt += nt; ps += nt << 8; }
            pstart[NE] = ps; MISC[16] = (unsigned)mt; }
        __syncthreads();
        for (int p0 = gw * 64; p0 < NTOK * 4; p0 += NGW * 64) { const int p = p0 + lane;
            const int tok = p >> 2; const int e = tk_e[p], rk = tk_rank[p]; const int slot = pstart[e] + rk;
            { tk_slot[p] = slot; slot_w[slot] = tk_w[p]; slot_rs[slot] = rs_tok[tok]; slot_tok[slot] = tok; }
        }
        if (BOTH(8)) GRID_BAR();
    }

    if (IN(9)) {
        const int MT = (int)MISC[16];
        LAS int* tokt = (LAS int*)(lds + TOKT_OFF);
        const int ng9 = (G == 256) ? NG9 : G;
        if (bx < ng9) {
        pg8::GroupedOrder S; S.init(MT, 16, ng9, bx); S.tile_e = tile_e;
        { pg8::Unit u; for (int i = 0; i < TOKT_UNITS && S.next(i, u); ++i) if (tid < 256) tokt[i * 256 + tid] = slot_tok[u.pm * 256 + tid]; }
        __syncthreads();
        pg8::Gemm g{H8, WGU8, DM, nullptr, nullptr, tokt}; pg8::EpiSwiglu8 E{a.b_gate_up, slot_rs, ACT8};
        pg8::gemm_phase<true, 1, true>(lds, g, S, E);
        }
        moe_convert_queue(ctl + CW_Q2, NQ_MOE - NQ_TAIL, NQ_MOE, a.w_gate_up, a.w_down, WGU8, WD8, lane);
        if (BOTH(9)) GRID_BAR();
    }
    if (IN(10)) {
        const int MT = (int)MISC[16];
        pg8::Gemm g{ACT8, WD8, DFF, nullptr, nullptr, nullptr}; pg8::GroupedOrder S; S.init(MT, 8, G, bx); S.tile_e = tile_e; pg8::EpiDown8 E{a.b_down, slot_w, YS8};
        pg8::gemm_phase<true, 1, false>(lds, g, S, E);
        if (BOTH(10)) GRID_BAR();
    }
#endif

    if (IN(11)) {
        f32x4 gv[8];
#pragma unroll
        for (int j = 0; j < 8; ++j) gv[j] = *((const f32x4*)a.norm_final_g + lane + 64 * j);
        for (int m = gw; m < NTOK; m += NGW) {
#if DBG_STAGE >= 1
            const f32x4* xr = (const f32x4*)(X1 + (size_t)m * DM) + lane;
#else
            const f32x4* xr = (const f32x4*)(a.x + (size_t)m * DM) + lane;
#endif
            f32x4 v[8];
#pragma unroll
            for (int j = 0; j < 8; ++j) v[j] = xr[64 * j];
#if DBG_STAGE >= 3
#pragma unroll
            for (int k = 0; k < 4; ++k) { const int slot = tk_slot[m * 4 + k]; const unsigned* yp = (const unsigned*)(YS8 + (size_t)slot * DM) + lane;
#pragma unroll
                for (int j = 0; j < 8; ++j) { const int w = (int)yp[64 * j]; const f32x2 lo = __builtin_amdgcn_cvt_pk_f32_fp8(w, false), hi = __builtin_amdgcn_cvt_pk_f32_fp8(w, true);
                    v[j].x += lo.x * (1.0f / 64.0f); v[j].y += lo.y * (1.0f / 64.0f); v[j].z += hi.x * (1.0f / 64.0f); v[j].w += hi.y * (1.0f / 64.0f); } }
#endif
            float s = 0.f;
#pragma unroll
            for (int j = 0; j < 8; ++j) s += (v[j].x * v[j].x + v[j].y * v[j].y) + (v[j].z * v[j].z + v[j].w * v[j].w);
            const float rs = 1.0f / sqrtf(wave_sum(s) * (1.0f / DM) + EPS);
            f32x4* o = (f32x4*)(a.out + (size_t)m * DM) + lane;
#pragma unroll
            for (int j = 0; j < 8; ++j) o[64 * j] = v[j] * rs * gv[j];
        }
    }
#undef IN
#undef BOTH
#undef GRID_BAR
}

extern "C" void kernel_launch(void* const* d_in, const int* in_sizes, int n_in, void* d_out, int out_size, void* d_ws, size_t ws_size, hipStream_t stream) {
    static int grid = 0;
    if (grid == 0) {
        if (n_in != 19 || in_sizes[0] != NTOK * DM || out_size != NTOK * DM || ws_size < WS_END) { fprintf(stderr, "kernel_launch: unexpected shapes (n_in %d, in0 %d, out %d, ws %zu); nothing launched\n", n_in, n_in > 0 ? in_sizes[0] : -1, out_size, ws_size); grid = -1; return; }
        int dev = 0, cus = 0, per_cu = 0;
        if (hipGetDevice(&dev) != hipSuccess || hipDeviceGetAttribute(&cus, hipDeviceAttributeMultiprocessorCount, dev) != hipSuccess) { grid = -1; return; }
        if (hipFuncSetAttribute((const void*)mega_fwd, hipFuncAttributeMaxDynamicSharedMemorySize, LDS_BYTES) != hipSuccess) { fprintf(stderr, "kernel_launch: hipFuncSetAttribute failed\n"); grid = -1; return; }
        if (hipOccupancyMaxActiveBlocksPerMultiprocessor(&per_cu, (const void*)mega_fwd, NWAVES * 64, LDS_BYTES) != hipSuccess || per_cu < 1) { fprintf(stderr, "kernel_launch: occupancy query reports %d blocks per CU\n", per_cu); per_cu = 1; }
        (void)hipGetLastError();
        grid = cus;
    }
    if (grid < 0) return;
    if (hipMemsetAsync((char*)d_ws + WS_CTL, 0, CTL_ZERO_BYTES, stream) != hipSuccess) { fprintf(stderr, "kernel_launch: memset failed\n"); return; }
    Args a{};
    a.x = (const float*)d_in[0]; a.norm_mix_g = (const float*)d_in[1]; a.w_in = (const float*)d_in[2]; a.conv_w = (const float*)d_in[3]; a.conv_b = (const float*)d_in[4]; a.w_a2 = (const float*)d_in[5];
    a.b_a = (const float*)d_in[6]; a.gla_norm_g = (const float*)d_in[7]; a.w_br_a = (const float*)d_in[8]; a.w_br_b = (const float*)d_in[9]; a.w_out = (const float*)d_in[10]; a.norm_ffn_g = (const float*)d_in[11];
    a.w_router = (const float*)d_in[12]; a.b_router = (const float*)d_in[13]; a.w_gate_up = (const float*)d_in[14]; a.b_gate_up = (const float*)d_in[15]; a.w_down = (const float*)d_in[16]; a.b_down = (const float*)d_in[17];
    a.norm_final_g = (const float*)d_in[18]; a.out = (float*)d_out; a.ws = (unsigned char*)d_ws; a.ph_lo = 0; a.ph_hi = 12;
    hipLaunchKernelGGL(mega_fwd, dim3(grid), dim3(NWAVES * 64), LDS_BYTES, stream, a);
    const hipError_t le = hipPeekAtLastError();
    if (le != hipSuccess) fprintf(stderr, "kernel_launch: launch failed: %s\n", hipGetErrorName(le));
}
```
